# Optimizing an MI355X kernel written in HIP

```python
import math
import jax
import jax.numpy as jnp
from jax import lax
import numpy as np

D_MODEL = 1024
BATCH = 4
SEQ = 8192
DEPTH = 2

GRID_W = 64
CTX_LEN = 256

MLA_HEADS = 8
MLA_NOPE = 64
MLA_ROPE = 32
MLA_V = 64
MLA_Q_RANK = 384
MLA_KV_RANK = 256
MLA_WIDTH = MLA_HEADS * MLA_V
ROPE_BASE = 10000.0
Q_BLOCK = 128

SSD_HEADS = 8
SSD_HEAD_DIM = 64
SSD_WIDTH = SSD_HEADS * SSD_HEAD_DIM
SSD_GROUPS = 2
SSD_STATE = 64
SSD_CONV = 3
SSD_CHUNK = 128
SSD_CONV_DIM = SSD_WIDTH + 2 * SSD_GROUPS * SSD_STATE

MIX_SPLITS = (MLA_Q_RANK, MLA_KV_RANK, MLA_ROPE, MLA_WIDTH, SSD_WIDTH, SSD_CONV_DIM, 2 * SSD_HEADS)
MIX_IN = sum(MIX_SPLITS)
MIX_OUT = MLA_WIDTH + SSD_WIDTH

POOL_WINDOWS = (2, 4, 8, 16)
POOL_GROUPS = len(POOL_WINDOWS)
POOL_WIDTH = D_MODEL
POOL_GROUP_DIM = POOL_WIDTH // POOL_GROUPS

RMS_EPS = 1e-6

kernel_name = "hybrid_mla_ssd_pool_diffusion_block"


def _rmsnorm(x, w):
    xf = x.astype(jnp.float32)
    y = xf * lax.rsqrt(jnp.mean(xf * xf, axis=-1, keepdims=True) + RMS_EPS)
    return (y * w.astype(jnp.float32)).astype(x.dtype)


def _split(t, sizes):
    idx = np.cumsum(sizes)[:-1].tolist()
    return jnp.split(t, idx, axis=-1)


def _ident(t):
    return t


def _flip(t):
    return jnp.flip(t, axis=1)


def _axial_rope_tables(n):
    rows = n // GRID_W
    row = jnp.repeat(jnp.arange(rows, dtype=jnp.float32), GRID_W)
    col = jnp.tile(jnp.arange(GRID_W, dtype=jnp.float32), rows)
    axis_dim = MLA_ROPE // 2
    inv_freq = 1.0 / (ROPE_BASE ** (jnp.arange(0, axis_dim, 2, dtype=jnp.float32) / axis_dim))
    ang = jnp.concatenate([row[:, None] * inv_freq, col[:, None] * inv_freq], axis=-1)
    return jnp.cos(ang), jnp.sin(ang)


def _rope(t, cos, sin):
    half = t.shape[-1] // 2
    t1, t2 = t[..., :half], t[..., half:]
    out = jnp.concatenate([t1 * cos - t2 * sin, t2 * cos + t1 * sin], axis=-1)
    return out.astype(t.dtype)


def _mla_q(q_a, q_norm, w_uq):
    b, n, _ = q_a.shape
    q = (_rmsnorm(q_a, q_norm) @ w_uq).reshape(b, n, MLA_HEADS, MLA_NOPE + MLA_ROPE)
    return q[..., :MLA_NOPE], q[..., MLA_NOPE:]


def _mla_kv(kv_a, kv_norm, w_ukv):
    b, n, _ = kv_a.shape
    kv = (_rmsnorm(kv_a, kv_norm) @ w_ukv).reshape(b, n, MLA_HEADS, MLA_NOPE + MLA_V)
    return kv[..., :MLA_NOPE], kv[..., MLA_NOPE:]


def _block_attention(q_nope, q_pe, k_nope, k_pe, v):
    b, n, H, _ = q_nope.shape
    nb = n // Q_BLOCK
    scale = (MLA_NOPE + MLA_ROPE) ** -0.5

    def one_block(args):
        qn, qp = args
        s = jnp.einsum("bqhd,bkhd->bhqk", qn, k_nope) + jnp.einsum("bqhr,bkr->bhqk", qp, k_pe)
        p = jax.nn.softmax(s.astype(jnp.float32) * scale, axis=-1).astype(v.dtype)
        return jnp.einsum("bhqk,bkhd->bqhd", p, v)

    qn_b = q_nope.reshape(b, nb, Q_BLOCK, H, MLA_NOPE).transpose(1, 0, 2, 3, 4)
    qp_b = q_pe.reshape(b, nb, Q_BLOCK, H, MLA_ROPE).transpose(1, 0, 2, 3, 4)
    out = lax.map(one_block, (qn_b, qp_b))
    return out.transpose(1, 0, 2, 3, 4).reshape(b, n, H * MLA_V)


def _centred_dwconv(u, w, bias):
    n = u.shape[1]
    pad = SSD_CONV // 2
    up = jnp.pad(u, ((0, 0), (pad, pad), (0, 0)))
    out = bias
    for k in range(SSD_CONV):
        out = out + up[:, k:k + n] * w[k]
    return out


def _ssd_inputs(xbc, dt_raw, conv_w, conv_b, dt_bias):
    b, n, _ = xbc.shape
    u = jax.nn.silu(_centred_dwconv(xbc, conv_w, conv_b))
    xs, bs, cs = _split(u, (SSD_WIDTH, SSD_GROUPS * SSD_STATE, SSD_GROUPS * SSD_STATE))
    dt = jax.nn.softplus(dt_raw.astype(jnp.float32).reshape(b, n, 2, SSD_HEADS) + dt_bias.astype(jnp.float32))
    return (xs.reshape(b, n, SSD_HEADS, SSD_HEAD_DIM),
            bs.reshape(b, n, SSD_GROUPS, SSD_STATE),
            cs.reshape(b, n, SSD_GROUPS, SSD_STATE),
            dt)


def _segsum(a_cs):
    T = a_cs.shape[-1]
    diff = a_cs[..., :, None] - a_cs[..., None, :]
    return jnp.where(jnp.tril(jnp.ones((T, T), dtype=bool)), diff, -jnp.inf)


def _ssd_prepare(x, dt, A, B):
    b, L, H, P = x.shape
    G, N = B.shape[2], B.shape[3]
    R = H // G
    nc = L // SSD_CHUNK
    xd = (x.astype(jnp.float32) * dt[..., None]).reshape(b, nc, SSD_CHUNK, G, R, P)
    a = (dt * A).reshape(b, nc, SSD_CHUNK, G, R).transpose(0, 3, 4, 1, 2)
    a_cs = jnp.cumsum(a, axis=-1)
    bc = B.astype(jnp.float32).reshape(b, nc, SSD_CHUNK, G, N)
    return xd, a_cs, bc


def _ssd_pass_states(xd, a_cs, bc, h0):
    decay_to_end = jnp.exp(a_cs[..., -1:] - a_cs)
    states = jnp.einsum("bcsgn,bgrcs,bcsgrp->cbgrpn", bc, decay_to_end, xd)
    chunk_decay = jnp.exp(a_cs[..., -1]).transpose(3, 0, 1, 2)

    def step(h, inp):
        s, dec = inp
        return h * dec[..., None, None] + s, h

    return lax.scan(step, h0, (states, chunk_decay))


def _ssd_final_state(x, dt, A, B, h0):
    xd, a_cs, bc = _ssd_prepare(x, dt, A, B)
    h_final, _ = _ssd_pass_states(xd, a_cs, bc, h0)
    return h_final


def _ssd_scan(x, dt, A, B, C, h0):
    xd, a_cs, bc = _ssd_prepare(x, dt, A, B)
    h_final, h_in = _ssd_pass_states(xd, a_cs, bc, h0)
    b, nc = xd.shape[0], xd.shape[1]
    cc = C.astype(jnp.float32).reshape(b, nc, SSD_CHUNK, C.shape[2], C.shape[3])
    l_mat = jnp.exp(_segsum(a_cs))
    cb = jnp.einsum("bclgn,bcsgn->bgcls", cc, bc)
    y_diag = jnp.einsum("bgcls,bgrcls,bcsgrp->bclgrp", cb, l_mat, xd)
    y_off = jnp.einsum("bclgn,cbgrpn,bgrcl->bclgrp", cc, h_in, jnp.exp(a_cs))
    return (y_diag + y_off).reshape(x.shape), h_final


def _merge_branches(attn, gate_a, y_ssd, z, ssd_norm, w_out):
    b, n, _ = attn.shape
    y = y_ssd.reshape(b, n, SSD_WIDTH) * jax.nn.silu(z.astype(jnp.float32))
    ssd_out = _rmsnorm(y, ssd_norm).astype(attn.dtype)
    return jnp.concatenate([attn * jax.nn.silu(gate_a), ssd_out], axis=-1) @ w_out


def _mixing_sublayer(h_lat, h_ctx, need_ctx_out, cos, sin, w_in, q_norm, w_uq, kv_norm, w_ukv,
                     conv_w, conv_b, a_log, dt_bias, d_skip, ssd_norm, w_out):
    q_a_l, kv_a_l, kpe_l, ga_l, z_l, xbc_l, dtr_l = _split(h_lat @ w_in, MIX_SPLITS)
    q_a_c, kv_a_c, kpe_c, ga_c, z_c, xbc_c, dtr_c = _split(h_ctx @ w_in, MIX_SPLITS)

    kn_c, v_c = _mla_kv(kv_a_c, kv_norm, w_ukv)
    kn_l, v_l = _mla_kv(kv_a_l, kv_norm, w_ukv)
    qn_l, qp_l = _mla_q(q_a_l, q_norm, w_uq)
    qp_l = _rope(qp_l, cos[:, None, :], sin[:, None, :])
    kpe_l = _rope(kpe_l, cos, sin)
    attn_l = _block_attention(qn_l, qp_l,
                              jnp.concatenate([kn_c, kn_l], axis=1),
                              jnp.concatenate([kpe_c, kpe_l], axis=1),
                              jnp.concatenate([v_c, v_l], axis=1))

    xs_l, b_l, c_l, dt_l = _ssd_inputs(xbc_l, dtr_l, conv_w, conv_b, dt_bias)
    xs_c, b_c, c_c, dt_c = _ssd_inputs(xbc_c, dtr_c, conv_w, conv_b, dt_bias)
    bsz = h_lat.shape[0]
    h0 = jnp.zeros((bsz, SSD_GROUPS, SSD_HEADS // SSD_GROUPS, SSD_HEAD_DIM, SSD_STATE), jnp.float32)
    y_l, y_c = [], []
    for d in range(2):
        fl = _flip if d == 1 else _ident
        A = -jnp.exp(a_log[d].astype(jnp.float32))
        skip = d_skip[d].astype(jnp.float32)[:, None]
        if need_ctx_out:
            yc, hc = _ssd_scan(fl(xs_c), fl(dt_c[:, :, d]), A, fl(b_c), fl(c_c), h0)
            y_c.append(fl(yc) + skip * xs_c)
        else:
            hc = _ssd_final_state(fl(xs_c), fl(dt_c[:, :, d]), A, fl(b_c), h0)
        yl, _ = _ssd_scan(fl(xs_l), fl(dt_l[:, :, d]), A, fl(b_l), fl(c_l), hc)
        y_l.append(fl(yl) + skip * xs_l)

    out_l = _merge_branches(attn_l, ga_l, y_l[0] + y_l[1], z_l, ssd_norm, w_out)
    if not need_ctx_out:
        return out_l, None
    qn_c, qp_c = _mla_q(q_a_c, q_norm, w_uq)
    attn_c = _block_attention(qn_c, qp_c, kn_c, kpe_c, v_c)
    out_c = _merge_branches(attn_c, ga_c, y_c[0] + y_c[1], z_c, ssd_norm, w_out)
    return out_l, out_c


def _multiscale_pool(u, lin, scale):
    b, n, _ = u.shape
    uf = u.astype(jnp.float32).reshape(b, n, POOL_GROUPS, POOL_GROUP_DIM)
    csum = jnp.pad(jnp.cumsum(uf, axis=1), ((0, 0), (1, 0), (0, 0), (0, 0)))
    t = jnp.arange(n)
    diffs = []
    for g, w in enumerate(POOL_WINDOWS):
        lo = jnp.maximum(t - w // 2, 0)
        hi = jnp.minimum(t + (w - w // 2 - 1), n - 1)
        cg = csum[:, :, g]
        mean = (cg[:, hi + 1] - cg[:, lo]) / (hi - lo + 1).astype(jnp.float32)[:, None]
        diffs.append(mean - uf[:, :, g])
    m = jnp.stack(diffs, axis=2).astype(u.dtype)
    y = jnp.einsum("bngc,gcd->bngd", m, lin).reshape(b, n, POOL_WIDTH)
    return y * scale


def _pool_sublayer(h, w_in, pool_lin, pool_scale, w_out):
    u, g = _split(h @ w_in, (POOL_WIDTH, POOL_WIDTH))
    return (_multiscale_pool(u, pool_lin, pool_scale) * jax.nn.silu(g)) @ w_out


def setup_inputs(seed: int = 0) -> dict:
    key = jax.random.key(seed)
    keys = list(jax.random.split(key, 32))
    f32 = jnp.float32
    ne, no = (DEPTH + 1) // 2, DEPTH // 2

    def nrm(k, shape, scale):
        return jax.random.normal(k, shape, f32) * scale

    def gain(k, shape):
        return 1.0 + 0.02 * jax.random.normal(k, shape, f32)

    dt0 = jnp.exp(jax.random.uniform(keys[14], (ne, 2, SSD_HEADS), f32, math.log(1e-3), math.log(1e-1)))
    return {
        "x": nrm(keys[0], (BATCH, SEQ, D_MODEL), 1.0),
        "c": nrm(keys[1], (BATCH, D_MODEL), 1.0),
        "ctx": nrm(keys[2], (BATCH, CTX_LEN, D_MODEL), 1.0),
        "c_ctx": nrm(keys[3], (D_MODEL,), 1.0),
        "mod_w": nrm(keys[4], (DEPTH, D_MODEL, 3 * D_MODEL), D_MODEL ** -0.5),
        "mod_b": nrm(keys[5], (DEPTH, 3 * D_MODEL), 0.02),
        "norm_w": gain(keys[6], (DEPTH, D_MODEL)),
        "w_in_mix": nrm(keys[7], (ne, D_MODEL, MIX_IN), D_MODEL ** -0.5),
        "q_norm": gain(keys[8], (ne, MLA_Q_RANK)),
        "w_uq": nrm(keys[9], (ne, MLA_Q_RANK, MLA_HEADS * (MLA_NOPE + MLA_ROPE)), MLA_Q_RANK ** -0.5),
        "kv_norm": gain(keys[10], (ne, MLA_KV_RANK)),
        "w_ukv": nrm(keys[11], (ne, MLA_KV_RANK, MLA_HEADS * (MLA_NOPE + MLA_V)), MLA_KV_RANK ** -0.5),
        "conv_w": nrm(keys[12], (ne, SSD_CONV, SSD_CONV_DIM), SSD_CONV ** -0.5),
        "conv_b": nrm(keys[13], (ne, SSD_CONV_DIM), 0.02),
        "a_log": jnp.log(jax.random.uniform(keys[15], (ne, 2, SSD_HEADS), f32, 1.0, 16.0)),
        "dt_bias": dt0 + jnp.log(-jnp.expm1(-dt0)),
        "d_skip": 1.0 + 0.1 * jax.random.normal(keys[16], (ne, 2, SSD_HEADS), f32),
        "ssd_norm": gain(keys[17], (ne, SSD_WIDTH)),
        "w_out_mix": nrm(keys[18], (ne, MIX_OUT, D_MODEL), MIX_OUT ** -0.5),
        "w_in_pool": nrm(keys[19], (no, D_MODEL, 2 * POOL_WIDTH), D_MODEL ** -0.5),
        "pool_lin": nrm(keys[20], (no, POOL_GROUPS, POOL_GROUP_DIM, POOL_GROUP_DIM), POOL_GROUP_DIM ** -0.5),
        "pool_scale": 1.0 + 0.1 * jax.random.normal(keys[21], (no, POOL_WIDTH), f32),
        "w_out_pool": nrm(keys[22], (no, POOL_WIDTH, D_MODEL), POOL_WIDTH ** -0.5),
        "final_norm": gain(keys[23], (D_MODEL,)),
    }


def reference(x, c, ctx, c_ctx, mod_w, mod_b, norm_w, w_in_mix, q_norm, w_uq, kv_norm, w_ukv,
              conv_w, conv_b, a_log, dt_bias, d_skip, ssd_norm, w_out_mix, w_in_pool, pool_lin,
              pool_scale, w_out_pool, final_norm):
    n = x.shape[1]
    cos, sin = _axial_rope_tables(n)
    last_mix = ((DEPTH - 1) // 2) * 2
    silu_c = jax.nn.silu(c)
    silu_cc = jax.nn.silu(c_ctx)
    for i in range(DEPTH):
        j = i // 2
        need_ctx_out = i < last_mix
        shift, scale, gate = jnp.split((silu_c @ mod_w[i] + mod_b[i])[:, None, :], 3, axis=-1)
        h = _rmsnorm(x, norm_w[i]) * (1 + scale) + shift
        if i % 2 == 0 or need_ctx_out:
            shift_c, scale_c, gate_c = jnp.split(silu_cc @ mod_w[i] + mod_b[i], 3, axis=-1)
            h_c = _rmsnorm(ctx, norm_w[i]) * (1 + scale_c) + shift_c
        if i % 2 == 0:
            o, o_c = _mixing_sublayer(h, h_c, need_ctx_out, cos, sin, w_in_mix[j], q_norm[j], w_uq[j],
                                      kv_norm[j], w_ukv[j], conv_w[j], conv_b[j], a_log[j], dt_bias[j],
                                      d_skip[j], ssd_norm[j], w_out_mix[j])
        else:
            o = _pool_sublayer(h, w_in_pool[j], pool_lin[j], pool_scale[j], w_out_pool[j])
            o_c = _pool_sublayer(h_c, w_in_pool[j], pool_lin[j], pool_scale[j], w_out_pool[j]) if need_ctx_out else None
        x = x + gate * o
        if need_ctx_out:
            ctx = ctx + gate_c * o_c
    return _rmsnorm(x, final_norm)
```

```cpp
#include <hip/hip_runtime.h>
#include <cstdint>
#include <cstdio>

typedef unsigned short bf16_t;
#define LAS __attribute__((address_space(3)))
__device__ __forceinline__ float bf2f(bf16_t v) { return __uint_as_float(((unsigned)v) << 16); }
typedef float f32x2_c __attribute__((ext_vector_type(2))); typedef __bf16 bf16x2_c __attribute__((ext_vector_type(2)));
__device__ __forceinline__ unsigned pk2f(float lo, float hi) { f32x2_c v = {lo, hi}; return __builtin_bit_cast(unsigned, __builtin_convertvector(v, bf16x2_c)); }
__device__ __forceinline__ bf16_t f2bf(float f) { return (bf16_t)(pk2f(f, 0.f) & 0xffffu); }
__device__ __forceinline__ float siluf(float x) { return x * __builtin_amdgcn_rcpf(1.f + __expf(-x)); }
__device__ __forceinline__ float softplusf(float x) { return fmaxf(x, 0.f) + log1pf(__expf(-fabsf(x))); }

constexpr int NB = 4, SEQ = 8192, DM = 1024, CTXL = 256, NKEY = SEQ + CTXL;
constexpr int ML = NB * SEQ, MC = NB * CTXL, MT = ML + MC;
constexpr int PN = 2560;
constexpr int C_QA = 0, C_KVA = 384, C_KPE = 640, C_GA = 672, C_Z = 1184, C_XBC = 1696, C_DT = 2464;
constexpr float RMS_EPS = 1e-6f;
constexpr float QSCALE = 0.10206207261596575f * 1.4426950408889634f;
constexpr int NT = 512;

constexpr size_t MiB = 1u << 20;
constexpr size_t WS_CTL = 0, CTL_ZERO_BYTES = 128 * 1024;
constexpr size_t WS_MODV = 1 * MiB;
constexpr size_t WS_COS = 3 * MiB, WS_SIN = 3 * MiB + 512 * 1024;
constexpr size_t WS_WT1 = 4 * MiB;
constexpr size_t WS_WTQ = 9 * MiB;
constexpr size_t WS_WTKV = 10 * MiB;
constexpr size_t WS_WTO = 11 * MiB;
constexpr size_t WS_WTP = 13 * MiB;
constexpr size_t WS_WTL = 17 * MiB;
constexpr size_t WS_WTOP = 18 * MiB;
constexpr size_t WS_H = 20 * MiB;
constexpr size_t WS_PROJ = 86 * MiB;
constexpr size_t WS_SS = 251 * MiB;
constexpr size_t WS_DT = 254 * MiB;
constexpr size_t WS_Q = 257 * MiB;
constexpr size_t WS_K = 305 * MiB;
constexpr size_t WS_V = 355 * MiB;
constexpr size_t WS_U = 388 * MiB;
constexpr size_t WS_DTS = 438 * MiB;
constexpr size_t WS_SST = 441 * MiB;
constexpr size_t WS_CD = 1 * MiB + 512 * 1024;
constexpr size_t WS_END = 507 * MiB;
constexpr int CW_PANEL = 16384;
constexpr size_t WS_XB = 2 * MiB;
constexpr int CW_BAR = 4096;

constexpr int RING_BYTES = 131072, LDSCTL_OFF = RING_BYTES, MISC_OFF = LDSCTL_OFF + 320, LDS_BYTES = 147456;


extern __shared__ __attribute__((aligned(16))) unsigned char g_lds[];
constexpr int WIDTAB_OFF = LDSCTL_OFF + 64;
__device__ __forceinline__ int lane_id_() { return (int)__builtin_amdgcn_mbcnt_hi(~0u, __builtin_amdgcn_mbcnt_lo(~0u, 0u)); }
__device__ __forceinline__ int hw_slot_() { return (int)(__builtin_amdgcn_s_getreg((5 << 11) | 4) & 0x3Fu); }
__device__ __forceinline__ int wave_id_() { return __builtin_amdgcn_readfirstlane(((volatile LAS int*)((LAS unsigned char*)g_lds + WIDTAB_OFF))[hw_slot_()]); }
#define TIDX (wave_id_() * 64 + lane_id_())

#define XB_TMO      128
#define XB_XCNT(j)  (256  + 64 * (j))
#define XB_XSUB(j)  (1280 + 64 * (j))
#define XB_XGEN(j)  (2304 + 64 * (j))
#define XB_TOP      3328
#define XB_TOPGEN   3392
#define XCD_BAR_WORDS 3456
#define XB_SPIN_CAP (1u << 18)
__device__ __forceinline__ unsigned xb_ld(unsigned* p)              { return __hip_atomic_load(p, __ATOMIC_RELAXED, __HIP_MEMORY_SCOPE_AGENT); }
__device__ __forceinline__ unsigned xb_add(unsigned* p, unsigned v) { return __hip_atomic_fetch_add(p, v, __ATOMIC_RELAXED, __HIP_MEMORY_SCOPE_AGENT); }
__device__ __forceinline__ unsigned xb_xcc_id() { return (unsigned)__builtin_amdgcn_s_getreg((3 << 11) | 20) & 0xFu; }
#define XB_SPIN(cond, bar) do { unsigned _sp = 0; while (cond) { __builtin_amdgcn_s_sleep(1); \
    if ((++_sp & 255u) == 0u) { if (xb_ld(&(bar)[XB_TMO])) break; if (_sp > XB_SPIN_CAP) { atomicAdd(&(bar)[XB_TMO], 1u); break; } } } } while (0)
struct XcdBarrier { unsigned* bar; unsigned x; volatile LAS unsigned* st; };
__device__ __forceinline__ XcdBarrier xcd_barrier_post(unsigned* bar, volatile LAS unsigned* st) {
    XcdBarrier b; b.bar = bar; b.x = xb_xcc_id(); b.st = st;
    if (TIDX == 0) (void)xb_add(&bar[XB_XCNT(b.x)], 1u);
    return b;
}
__device__ __forceinline__ void xcd_barrier_complete(unsigned* bar, unsigned x, unsigned& nloc, unsigned& nx) {
    const unsigned G = gridDim.x * gridDim.y * gridDim.z;
    unsigned sum, cnt, mine, sp = 0u;
    for (;;) {
        sum = 0u; cnt = 0u; mine = 0u;
#pragma unroll
        for (unsigned j = 0; j < 16; ++j) { const unsigned c = xb_ld(&bar[XB_XCNT(j)]); sum += c; cnt += (c > 0u) ? 1u : 0u; mine = (j == x) ? c : mine; }
        if (sum == G) break;
        __builtin_amdgcn_s_sleep(1);
        if ((++sp & 255u) == 0u) { if (xb_ld(&bar[XB_TMO])) break; if (sp > XB_SPIN_CAP) { atomicAdd(&bar[XB_TMO], 1u); break; } }
    }
    nloc = mine > 0u ? mine : 1u; nx = cnt > 0u ? cnt : 1u;
}
__device__ __forceinline__ void xcd_barrier(const XcdBarrier& b) {
    asm volatile("s_waitcnt vmcnt(0)" ::: "memory");
    __syncthreads();
    if (TIDX == 0) {
        unsigned* bar = b.bar;
        __builtin_amdgcn_s_waitcnt(0);
        unsigned nloc = b.st[0], nx = b.st[1];
        if (nloc == 0u) { xcd_barrier_complete(bar, b.x, nloc, nx); b.st[0] = nloc; b.st[1] = nx; }
        const unsigned old = xb_add(&bar[XB_XSUB(b.x)], 1u);
        const unsigned gen = old / nloc;
        if (old + 1u == (gen + 1u) * nloc) {
            __builtin_amdgcn_fence(__ATOMIC_RELEASE, "agent");
            asm volatile("s_waitcnt vmcnt(0)" ::: "memory");
            const unsigned og = xb_add(&bar[XB_TOP], 1u);
            const unsigned tg = og / nx;
            if (og + 1u == (tg + 1u) * nx) xb_add(&bar[XB_TOPGEN], 1u);
            else XB_SPIN(xb_ld(&bar[XB_TOPGEN]) == tg, bar);
            __builtin_amdgcn_fence(__ATOMIC_ACQUIRE, "agent");
            xb_add(&bar[XB_XGEN(b.x)], 1u);
            asm volatile("s_waitcnt vmcnt(0)" ::: "memory");
        } else {
            XB_SPIN(xb_ld(&bar[XB_XGEN(b.x)]) == gen, bar);
            __builtin_amdgcn_fence(__ATOMIC_ACQUIRE, "agent");
            asm volatile("s_waitcnt vmcnt(0)" ::: "memory");
        }
    }
    __syncthreads();
}

__device__ __forceinline__ void row_info(int row, int& b, int& t, bool& isctx) {
    if (row < ML) { b = row / SEQ; t = row % SEQ; isctx = false; } else { int rc = row - ML; b = rc / CTXL; t = rc % CTXL; isctx = true; }
}
__device__ __forceinline__ float wave_sum(float v) {
#define WS_SWZ(x, k) __int_as_float(__builtin_amdgcn_ds_swizzle(__float_as_int(x), 0x1F | ((k) << 10)))
    v += WS_SWZ(v, 1); v += WS_SWZ(v, 2); v += WS_SWZ(v, 4); v += WS_SWZ(v, 8); v += WS_SWZ(v, 16);
#undef WS_SWZ
    auto rr = __builtin_amdgcn_permlane32_swap(__float_as_uint(v), __float_as_uint(v), false, false);
    return __uint_as_float(rr[0]) + __uint_as_float(rr[1]);
}
typedef float f32x4 __attribute__((ext_vector_type(4)));
#define GSTRIDE(idx, n) for (long idx = (long)blockIdx.x * NT + TIDX; idx < (long)(n); idx += (long)gridDim.x * NT)

namespace pg8 {
#define PG8_LAS __attribute__((address_space(3)))
typedef unsigned short bf16_t;
typedef short bf16x8 __attribute__((ext_vector_type(8)));
typedef float f32x4 __attribute__((ext_vector_type(4)));
typedef unsigned u32x4 __attribute__((ext_vector_type(4)));
constexpr int BM = 256, BK = 64, HALF = 128, HTB = HALF * BK * 2  , STAGE_BYTES = 8 * HTB, NXCD = 8, WGM = 8;

__host__ __device__ __forceinline__ int lds_byte(int r, int c) { const int st = (r >> 4) * 2 + (c >> 5), rr = r & 15, cc = c & 31, ob = rr * 64 + cc * 2; return st * 1024 + (ob ^ (((ob >> 9) & 1) << 5)); }
__host__ __device__ __forceinline__ void stage_rc(int b, int& R, int& C) { const int st = b / 1024, sb = b % 1024, swz = sb ^ (((sb >> 9) & 1) << 5); R = (st >> 1) * 16 + swz / 64; C = (st & 1) * 32 + (swz % 64) / 2; }
__host__ __device__ __forceinline__ int perm32(int rho) { const int n = rho >> 4, i = rho & 15; return 8 * (i >> 2) + 4 * n + (i & 3); }

struct Unit { int pm, pn; };
struct Gemm { const bf16_t* A; const bf16_t* Bt; int M, N, K, lda, a_pn_off; };

struct StaticOrder {
    int nM, nN, nwg, G, c;
    __host__ __device__ void init(int M, int N, int G_, int c_) { nM = M / BM; nN = N / BM; nwg = nM * nN; G = G_; c = c_; }
    __host__ __device__ bool next(int i, Unit& u) const {
        const long L = (long)i * G + c; if (L >= nwg) return false;
        int wgid = (int)L; { const int q = nwg / NXCD, r = nwg % NXCD, xcd = wgid % NXCD, off = wgid / NXCD; wgid = (xcd < r ? xcd * (q + 1) : r * (q + 1) + (xcd - r) * q) + off; }
        const int nig = WGM * nN, gid = wgid / nig, fm = gid * WGM, gsz = (nM - fm) < WGM ? (nM - fm) : WGM;
        u.pm = fm + ((wgid % nig) % gsz); u.pn = (wgid % nig) / gsz; return true;
    }
    __device__ __forceinline__ void a_ready(const Unit&) const {}
    __device__ __forceinline__ void done(const Unit&) const {}
};

__device__ __forceinline__ unsigned cvt_pk_bf16(float lo, float hi) { unsigned r; asm volatile("v_cvt_pk_bf16_f32 %0, %1, %2" : "=v"(r) : "v"(lo), "v"(hi)); return r; }
typedef float f32x2 __attribute__((ext_vector_type(2)));
__device__ __forceinline__ f32x2 gelu_pk(f32x2 v) {
    const f32x2 av = __builtin_elementwise_abs(v), d = av * 0.2316418882f + 1.0f;
    f32x2 t; t.x = __builtin_amdgcn_rcpf(d.x); t.y = __builtin_amdgcn_rcpf(d.y);
    f32x2 q = t * 0.5307027145f + (-0.7265760135f); q = q * t + 0.7107068705f; q = q * t + (-0.142248368f); q = q * t + 0.127414796f; q = q * t;
    const f32x2 s = (v * v) * (-0.72134752044f);
    f32x2 e; e.x = __builtin_amdgcn_exp2f(s.x); e.y = __builtin_amdgcn_exp2f(s.y);
    const f32x2 m = v * (q * e), r = v - m;
    f32x2 o; o.x = v.x < 0.f ? m.x : r.x; o.y = v.y < 0.f ? m.y : r.y; return o;
}

template <int ACT  > struct EpiBf16 {
    static constexpr bool PERM = true, AFTER_DRAIN = false; static_assert(ACT == 0 || ACT == 1, "EpiBf16: ACT is 0 (none) or 1 (gelu_pk)");
    bf16_t* O; int ldc; const float* bias; int split_cols; size_t split_stride; float scale0;
    __device__ __forceinline__ void operator()(const f32x4 (&acc)[2][2][4][2], const Unit& u, int wr, int wc, int fr, int fq) const {
        const int row0 = u.pm * BM + wr * 64 + fr; int colt = u.pn * BM; bf16_t* base = O;
        float sc = 1.f; if (split_cols) { const int t = colt / split_cols; base += (size_t)t * split_stride; colt -= t * split_cols; if (t == 0) sc = scale0; }
        const int col0 = colt + wc * 32 + 8 * fq, bcol0 = u.pn * BM + wc * 32 + 8 * fq;
        f32x4 bv[2][2];
#pragma unroll
        for (int bj = 0; bj < 2; ++bj)
#pragma unroll
            for (int n = 0; n < 2; ++n) bv[bj][n] = bias ? *(const f32x4*)(bias + bcol0 + bj * HALF + 4 * n) : (f32x4){0.f, 0.f, 0.f, 0.f};
#pragma unroll
        for (int ai = 0; ai < 2; ++ai)
#pragma unroll
            for (int m = 0; m < 4; ++m) { bf16_t* rowp = base + (size_t)(row0 + ai * HALF + m * 16) * ldc + col0;
#pragma unroll
                for (int bj = 0; bj < 2; ++bj) { f32x4 v0 = acc[ai][bj][m][0] + bv[bj][0], v1 = acc[ai][bj][m][1] + bv[bj][1];
                    if (ACT == 1) { f32x2 a = gelu_pk((f32x2){v0[0], v0[1]}), b = gelu_pk((f32x2){v0[2], v0[3]}), c = gelu_pk((f32x2){v1[0], v1[1]}), d = gelu_pk((f32x2){v1[2], v1[3]});
                        v0 = (f32x4){a.x, a.y, b.x, b.y}; v1 = (f32x4){c.x, c.y, d.x, d.y}; }
                    v0 = v0 * sc; v1 = v1 * sc; u32x4 w; w.x = cvt_pk_bf16(v0[0], v0[1]); w.y = cvt_pk_bf16(v0[2], v0[3]); w.z = cvt_pk_bf16(v1[0], v1[1]); w.w = cvt_pk_bf16(v1[2], v1[3]);
                    *(u32x4*)(rowp + bj * HALF) = w; } }
    }
};

struct EpiProjM { static constexpr bool PERM = true, AFTER_DRAIN = false;
    bf16_t* O; float* SS; float* DT;
    __device__ __forceinline__ void operator()(const f32x4 (&acc)[2][2][4][2], const Unit& u, int wr, int wc, int fr, int fq) const {
        const int row0 = u.pm * BM + wr * 64 + fr, colt = u.pn * BM, col0 = colt + wc * 32 + 8 * fq;
#pragma unroll
        for (int ai = 0; ai < 2; ++ai)
#pragma unroll
            for (int m = 0; m < 4; ++m) { const int row = row0 + ai * HALF + m * 16; bf16_t* rowp = O + (size_t)row * 2560 + col0;
#pragma unroll
                for (int bj = 0; bj < 2; ++bj) { const f32x4 v0 = acc[ai][bj][m][0], v1 = acc[ai][bj][m][1];
                    u32x4 w; w.x = cvt_pk_bf16(v0[0], v0[1]); w.y = cvt_pk_bf16(v0[2], v0[3]); w.z = cvt_pk_bf16(v1[0], v1[1]); w.w = cvt_pk_bf16(v1[2], v1[3]);
                    *(u32x4*)(rowp + bj * HALF) = w;
                    const int cs = colt + bj * HALF + wc * 32;
                    if (cs < 640) { float q = (v0[0] * v0[0] + v0[1] * v0[1]) + (v0[2] * v0[2] + v0[3] * v0[3]) + (v1[0] * v1[0] + v1[1] * v1[1]) + (v1[2] * v1[2] + v1[3] * v1[3]);
                        q += __shfl_xor(q, 16); q += __shfl_xor(q, 32); if (fq == 0) SS[(size_t)row * 20 + (cs >> 5)] = q; }
                    if (cs == 2464 && fq < 2) { *(f32x4*)(DT + (size_t)row * 16 + 8 * fq) = v0; *(f32x4*)(DT + (size_t)row * 16 + 8 * fq + 4) = v1; } } }
    }
};

struct EpiQ { static constexpr bool PERM = true, AFTER_DRAIN = false;
    bf16_t* Q; const float* SS; const float* COS; const float* SIN;
    __device__ __forceinline__ void operator()(const f32x4 (&acc)[2][2][4][2], const Unit& u, int wr, int wc, int fr, int fq) const {
        asm volatile("" : "+v"(fr), "+v"(fq));
        const int row0 = u.pm * BM + wr * 64 + fr, colt = u.pn * BM;
#pragma unroll
        for (int ai = 0; ai < 2; ++ai)
#pragma unroll
            for (int m = 0; m < 4; ++m) { const int row = row0 + ai * HALF + m * 16; const int b = row >> 13, t = row & 8191;
                const f32x4 s0 = *(const f32x4*)(SS + (size_t)row * 20), s1 = *(const f32x4*)(SS + (size_t)row * 20 + 4), s2 = *(const f32x4*)(SS + (size_t)row * 20 + 8);
                const float ssq = ((s0[0] + s0[1]) + (s0[2] + s0[3])) + ((s1[0] + s1[1]) + (s1[2] + s1[3])) + ((s2[0] + s2[1]) + (s2[2] + s2[3]));
                const float rstd = rsqrtf(ssq * (1.f / 384.f) + 1e-6f);
#pragma unroll
                for (int bj = 0; bj < 2; ++bj) { const int cs = colt + bj * HALF + wc * 32, c0 = cs + 8 * fq; const int h = c0 / 96, j = c0 - h * 96;
                    float v[8];
#pragma unroll
                    for (int i = 0; i < 4; ++i) { v[i] = acc[ai][bj][m][0][i] * rstd; v[4 + i] = acc[ai][bj][m][1][i] * rstd; }
                    if ((cs % 96) == 64) {
                        const int jj0 = 8 * (fq & 1);
                        const f32x4 c0v = *(const f32x4*)(COS + t * 16 + jj0), c1v = *(const f32x4*)(COS + t * 16 + jj0 + 4), s0v = *(const f32x4*)(SIN + t * 16 + jj0), s1v = *(const f32x4*)(SIN + t * 16 + jj0 + 4);
#pragma unroll
                        for (int i = 0; i < 8; ++i) { const float pv = __shfl_xor(v[i], 32); const float cc = i < 4 ? c0v[i & 3] : c1v[i & 3], sn = i < 4 ? s0v[i & 3] : s1v[i & 3];
                            v[i] = fq < 2 ? v[i] * cc - pv * sn : v[i] * cc + pv * sn; }
                    }
                    u32x4 w; w.x = cvt_pk_bf16(v[0], v[1]); w.y = cvt_pk_bf16(v[2], v[3]); w.z = cvt_pk_bf16(v[4], v[5]); w.w = cvt_pk_bf16(v[6], v[7]);
                    *(u32x4*)(Q + ((size_t)(b * 8 + h) * 8192 + t) * 96 + j) = w; }
                asm volatile("" ::: "memory"); }
    }
};
struct EpiKV { static constexpr bool PERM = true, AFTER_DRAIN = false;
    bf16_t* Kb; bf16_t* Vb; const float* SS;
    __device__ __forceinline__ void operator()(const f32x4 (&acc)[2][2][4][2], const Unit& u, int wr, int wc, int fr, int fq) const {
        asm volatile("" : "+v"(fr), "+v"(fq));
        const int colt = u.pn * BM; int b, key0; if (u.pm < 128) { b = u.pm >> 5; key0 = 256 + (u.pm & 31) * 256; } else { b = u.pm - 128; key0 = 0; }
        float rs[2][4];
#pragma unroll
        for (int ai = 0; ai < 2; ++ai) { f32x4 t[4][2];
#pragma unroll
            for (int m = 0; m < 4; ++m) { const float* sp = SS + (size_t)(u.pm * BM + wr * 64 + fr + ai * HALF + m * 16) * 20 + 12; t[m][0] = *(const f32x4*)sp; t[m][1] = *(const f32x4*)(sp + 4); }
#pragma unroll
            for (int m = 0; m < 4; ++m) { const f32x4 s0 = t[m][0], s1 = t[m][1];
                const float ssq = ((s0[0] + s0[1]) + (s0[2] + s0[3])) + ((s1[0] + s1[1]) + (s1[2] + s1[3]));
                rs[ai][m] = rsqrtf(ssq * (1.f / 256.f) + 1e-6f); }
            asm volatile("" ::: "memory"); }
#pragma unroll
        for (int ai = 0; ai < 2; ++ai)
#pragma unroll
            for (int m = 0; m < 4; ++m) { const int lr = wr * 64 + fr + ai * HALF + m * 16; const int key = key0 + lr;
                const float rstd = rs[ai][m];
#pragma unroll
                for (int bj = 0; bj < 2; ++bj) { const int c0 = colt + bj * HALF + wc * 32 + 8 * fq; const int h = c0 >> 7, j = c0 & 127; const size_t kr = (size_t)(b * 8 + h) * 8448 + key;
                    const f32x4 v0 = acc[ai][bj][m][0] * rstd, v1 = acc[ai][bj][m][1] * rstd;
                    u32x4 w; w.x = cvt_pk_bf16(v0[0], v0[1]); w.y = cvt_pk_bf16(v0[2], v0[3]); w.z = cvt_pk_bf16(v1[0], v1[1]); w.w = cvt_pk_bf16(v1[2], v1[3]);
                    if (wc < 2) *(u32x4*)(Kb + kr * 96 + j) = w; else *(u32x4*)(Vb + kr * 64 + (j - 64)) = w; }
                asm volatile("" ::: "memory"); }
    }
};
struct EpiPL { static constexpr bool PERM = true, AFTER_DRAIN = false;
    bf16_t* T; const bf16_t* UG;
    __device__ __forceinline__ void operator()(const f32x4 (&acc)[2][2][4][2], const Unit& u, int wr, int wc, int fr, int fq) const {
        const int row0 = u.pm * BM + wr * 64 + fr, col0 = u.pn * BM + wc * 32 + 8 * fq;
        u32x4 g8[2][4][2];
#pragma unroll
        for (int ai = 0; ai < 2; ++ai)
#pragma unroll
            for (int m = 0; m < 4; ++m)
#pragma unroll
                for (int bj = 0; bj < 2; ++bj) g8[ai][m][bj] = *(const u32x4*)(UG + (size_t)(row0 + ai * HALF + m * 16) * 2048 + 1024 + col0 + bj * HALF);
#pragma unroll
        for (int ai = 0; ai < 2; ++ai)
#pragma unroll
            for (int m = 0; m < 4; ++m) { const int row = row0 + ai * HALF + m * 16;
#pragma unroll
                for (int bj = 0; bj < 2; ++bj) { const int c0 = col0 + bj * HALF; const u32x4 gq = g8[ai][m][bj];
                    float v[8];
#pragma unroll
                    for (int i = 0; i < 4; ++i) { const float glo = __uint_as_float(gq[i] << 16), ghi = __uint_as_float(gq[i] & 0xffff0000u);
                        const float a0 = i < 2 ? acc[ai][bj][m][0][2 * i] : acc[ai][bj][m][1][2 * i - 4], a1 = i < 2 ? acc[ai][bj][m][0][2 * i + 1] : acc[ai][bj][m][1][2 * i - 3];
                        v[2 * i] = a0 * (glo * __builtin_amdgcn_rcpf(1.f + __expf(-glo))); v[2 * i + 1] = a1 * (ghi * __builtin_amdgcn_rcpf(1.f + __expf(-ghi))); }
                    u32x4 w; w.x = cvt_pk_bf16(v[0], v[1]); w.y = cvt_pk_bf16(v[2], v[3]); w.z = cvt_pk_bf16(v[4], v[5]); w.w = cvt_pk_bf16(v[6], v[7]);
                    *(u32x4*)(T + (size_t)row * 1024 + c0) = w; } }
    }
};
struct EpiResM { static constexpr bool PERM = false, AFTER_DRAIN = false;
    const float* res; const float* gate; float* out; int rows_per_batch; int pad;
    __device__ __forceinline__ void operator()(const f32x4 (&acc)[2][2][4][2], const Unit& u, int wr, int wc, int fr, int fq) const {
        const int row0 = u.pm * BM + wr * 64 + fr, col0 = u.pn * BM + wc * 32 + 4 * fq; const int b = (u.pm * BM) / rows_per_batch;
        f32x4 gv[2][2];
#pragma unroll
        for (int bj = 0; bj < 2; ++bj)
#pragma unroll
            for (int n = 0; n < 2; ++n) gv[bj][n] = *(const f32x4*)(gate + b * 3072 + 2048 + col0 + bj * HALF + n * 16);
#pragma unroll
        for (int ai = 0; ai < 2; ++ai)
#pragma unroll
            for (int m = 0; m < 4; ++m) { const size_t off = (size_t)(row0 + ai * HALF + m * 16) * 1024 + col0;
#pragma unroll
                for (int bj = 0; bj < 2; ++bj)
#pragma unroll
                    for (int n = 0; n < 2; ++n) { const f32x4 r = *(const f32x4*)(res + off + bj * HALF + n * 16); *(f32x4*)(out + off + bj * HALF + n * 16) = r + gv[bj][n] * acc[ai][bj][m][n]; }
                if (m == 3) asm volatile("" ::: "memory"); }
    }
};

struct PanelRms {
    unsigned* xbuf;
    unsigned* cnt;
    int pm_off; float eps;
    __device__ __forceinline__ void run(const f32x4 (&v)[2][2][4][2], const Unit& u, int wr, int wc, int fr, int fq, PG8_LAS unsigned char* lds, int wid, int lane) const { publish(v, u, wr, wc, fr, fq, lds, wid, lane); collect(u, lds, wid, lane); }
    __device__ __forceinline__ void publish(const f32x4 (&v)[2][2][4][2], const Unit& u, int wr, int wc, int fr, int fq, PG8_LAS unsigned char* lds, int wid, int lane) const {
        PG8_LAS float* Pq = (PG8_LAS float*)lds;
        PG8_LAS float* S = (PG8_LAS float*)(lds + 8192);
        const int gpm = u.pm + pm_off;
#pragma unroll
        for (int ai = 0; ai < 2; ++ai)
#pragma unroll
            for (int m = 0; m < 4; ++m) { float q = 0.f;
#pragma unroll
                for (int bj = 0; bj < 2; ++bj)
#pragma unroll
                    for (int n = 0; n < 2; ++n) { const f32x4 x = v[ai][bj][m][n]; q += (x[0] * x[0] + x[1] * x[1]) + (x[2] * x[2] + x[3] * x[3]); }
                q += __shfl_xor(q, 16); q += __shfl_xor(q, 32);
                if (fq == 0) Pq[(ai * HALF + wr * 64 + m * 16 + fr) * 4 + wc] = q; }
        asm volatile("s_waitcnt lgkmcnt(0)" ::: "memory"); __builtin_amdgcn_s_barrier(); asm volatile("" ::: "memory");
        const int row = wid * 32 + (lane & 31);
        if (lane < 32) { const float sq = (Pq[row * 4 + 0] + Pq[row * 4 + 1]) + (Pq[row * 4 + 2] + Pq[row * 4 + 3]);
            __hip_atomic_store(xbuf + ((size_t)(gpm * BM + row) * 4 + u.pn), __float_as_uint(sq), __ATOMIC_RELAXED, __HIP_MEMORY_SCOPE_AGENT); }
        asm volatile("s_waitcnt vmcnt(0)" ::: "memory");
        if (lane == 0) __hip_atomic_fetch_add(cnt + 64 * gpm, 1u, __ATOMIC_RELAXED, __HIP_MEMORY_SCOPE_AGENT);
    }
    __device__ __forceinline__ void collect(const Unit& u, PG8_LAS unsigned char* lds, int wid, int lane) const {
        PG8_LAS float* S = (PG8_LAS float*)(lds + 8192);
        const int gpm = u.pm + pm_off; const int row = wid * 32 + (lane & 31);
        if (wid == 0) {
            for (unsigned sp = 0; sp < (1u << 22); ++sp) {
                if ((unsigned)__builtin_amdgcn_readfirstlane(__hip_atomic_load(cnt + 64 * gpm, __ATOMIC_RELAXED, __HIP_MEMORY_SCOPE_AGENT)) >= 32u) break;
                __builtin_amdgcn_s_sleep(2); }
            __builtin_amdgcn_fence(__ATOMIC_ACQUIRE, "agent");
        }
        asm volatile("s_waitcnt vmcnt(0) lgkmcnt(0)" ::: "memory"); __builtin_amdgcn_s_barrier(); asm volatile("" ::: "memory");
        if (lane < 32) { const unsigned* slot = xbuf + (size_t)(gpm * BM + row) * 4; float tot = 0.f;
#pragma unroll
            for (int t = 0; t < 4; ++t) tot += __uint_as_float(__hip_atomic_load(slot + t, __ATOMIC_RELAXED, __HIP_MEMORY_SCOPE_AGENT));
            S[row] = rsqrtf(tot * (1.f / 1024.f) + eps); }
        asm volatile("s_waitcnt lgkmcnt(0)" ::: "memory"); __builtin_amdgcn_s_barrier(); asm volatile("" ::: "memory");
    }
};
typedef _Float16 h16x4 __attribute__((ext_vector_type(4)));
struct EpiResNorm { static constexpr bool PERM = false, AFTER_DRAIN = true;
    const float* res; const float* gate; _Float16* X1; bf16_t* Hn; const float* nw; const float* modn; PanelRms st; int rows_per_batch; int pad;
    __device__ __forceinline__ void operator()(const f32x4 (&)[2][2][4][2], const Unit&, int, int, int, int) const {}
    __device__ __forceinline__ void fused(f32x4 (&acc)[2][2][4][2], const Unit& u, int wr, int wc, int fr, int fq, PG8_LAS unsigned char* lds, int wid, int lane) const {
        typedef unsigned u32x2v __attribute__((ext_vector_type(2)));
        const PG8_LAS float* S = (const PG8_LAS float*)(lds + 8192);
        const int grow0 = (u.pm + st.pm_off) * BM, col0 = u.pn * BM + wc * 32 + 4 * fq; const int b = grow0 / rows_per_batch;
#pragma unroll
        for (int bj = 0; bj < 2; ++bj)
#pragma unroll
            for (int n = 0; n < 2; ++n) { const f32x4 gv = *(const f32x4*)(gate + b * 3072 + 2048 + col0 + bj * HALF + n * 16);
#pragma unroll
                for (int ai = 0; ai < 2; ++ai)
#pragma unroll
                    for (int m = 0; m < 4; ++m) acc[ai][bj][m][n] *= gv; }
#pragma unroll
        for (int ai = 0; ai < 2; ++ai)
#pragma unroll
            for (int m = 0; m < 4; ++m) { const size_t off = (size_t)(grow0 + ai * HALF + wr * 64 + m * 16 + fr) * 1024 + col0;
#pragma unroll
                for (int bj = 0; bj < 2; ++bj)
#pragma unroll
                    for (int n = 0; n < 2; ++n) acc[ai][bj][m][n] += __builtin_nontemporal_load((const f32x4*)(res + off + bj * HALF + n * 16));
                asm volatile("" : "+v"(acc[ai][0][m][0]), "+v"(acc[ai][0][m][1]), "+v"(acc[ai][1][m][0]), "+v"(acc[ai][1][m][1]));
                if (m == 3) asm volatile("" ::: "memory"); }
        f32x4 gn[2][2], shn[2][2];
#pragma unroll
        for (int bj = 0; bj < 2; ++bj)
#pragma unroll
            for (int n = 0; n < 2; ++n) { const int c = col0 + bj * HALF + n * 16;
                gn[bj][n] = *(const f32x4*)(nw + c) * (*(const f32x4*)(modn + b * 3072 + 1024 + c) + 1.f); shn[bj][n] = *(const f32x4*)(modn + b * 3072 + c); }
        st.publish(acc, u, wr, wc, fr, fq, lds, wid, lane);
#pragma unroll
        for (int ai = 0; ai < 2; ++ai)
#pragma unroll
            for (int m = 0; m < 4; ++m) { const size_t off = (size_t)(grow0 + ai * HALF + wr * 64 + m * 16 + fr) * 1024 + col0;
#pragma unroll
                for (int bj = 0; bj < 2; ++bj)
#pragma unroll
                    for (int n = 0; n < 2; ++n) *(h16x4*)(X1 + off + bj * HALF + n * 16) = __builtin_convertvector(acc[ai][bj][m][n], h16x4); }
        st.collect(u, lds, wid, lane);
#pragma unroll
        for (int ai = 0; ai < 2; ++ai)
#pragma unroll
            for (int m = 0; m < 4; ++m) { const int r = ai * HALF + wr * 64 + m * 16 + fr; const float rstd = S[r]; const size_t off = (size_t)(grow0 + r) * 1024 + col0;
#pragma unroll
                for (int bj = 0; bj < 2; ++bj)
#pragma unroll
                    for (int n = 0; n < 2; ++n) { const f32x4 x1 = acc[ai][bj][m][n];
                        const f32x4 o = x1 * rstd * gn[bj][n] + shn[bj][n];
                        u32x2v pk; pk.x = cvt_pk_bf16(o[0], o[1]); pk.y = cvt_pk_bf16(o[2], o[3]);
                        *(u32x2v*)(Hn + off + bj * HALF + n * 16) = pk; }
                asm volatile("" ::: "memory"); }
    }
};
struct EpiResFinal { static constexpr bool PERM = false, AFTER_DRAIN = true;
    const _Float16* res; const float* gate; float* out; const float* fw; PanelRms st; int rows_per_batch; int pad;
    __device__ __forceinline__ void operator()(const f32x4 (&)[2][2][4][2], const Unit&, int, int, int, int) const {}
    __device__ __forceinline__ void fused(f32x4 (&acc)[2][2][4][2], const Unit& u, int wr, int wc, int fr, int fq, PG8_LAS unsigned char* lds, int wid, int lane) const {
        const PG8_LAS float* S = (const PG8_LAS float*)(lds + 8192);
        const int grow0 = (u.pm + st.pm_off) * BM, col0 = u.pn * BM + wc * 32 + 4 * fq; const int b = grow0 / rows_per_batch;
#pragma unroll
        for (int bj = 0; bj < 2; ++bj)
#pragma unroll
            for (int n = 0; n < 2; ++n) { const f32x4 gv = *(const f32x4*)(gate + b * 3072 + 2048 + col0 + bj * HALF + n * 16);
#pragma unroll
                for (int ai = 0; ai < 2; ++ai)
#pragma unroll
                    for (int m = 0; m < 4; ++m) acc[ai][bj][m][n] *= gv; }
#pragma unroll
        for (int ai = 0; ai < 2; ++ai)
#pragma unroll
            for (int m = 0; m < 4; ++m) { const size_t off = (size_t)(grow0 + ai * HALF + wr * 64 + m * 16 + fr) * 1024 + col0;
#pragma unroll
                for (int bj = 0; bj < 2; ++bj)
#pragma unroll
                    for (int n = 0; n < 2; ++n) acc[ai][bj][m][n] += __builtin_convertvector(__builtin_nontemporal_load((const h16x4*)(res + off + bj * HALF + n * 16)), f32x4);
                asm volatile("" : "+v"(acc[ai][0][m][0]), "+v"(acc[ai][0][m][1]), "+v"(acc[ai][1][m][0]), "+v"(acc[ai][1][m][1]));
                if (m == 3) asm volatile("" ::: "memory"); }
        f32x4 fwv[2][2];
#pragma unroll
        for (int bj = 0; bj < 2; ++bj)
#pragma unroll
            for (int n = 0; n < 2; ++n) fwv[bj][n] = *(const f32x4*)(fw + col0 + bj * HALF + n * 16);
        st.run(acc, u, wr, wc, fr, fq, lds, wid, lane);
#pragma unroll
        for (int ai = 0; ai < 2; ++ai)
#pragma unroll
            for (int m = 0; m < 4; ++m) { const int r = ai * HALF + wr * 64 + m * 16 + fr; const float rstd = S[r]; const size_t off = (size_t)(grow0 + r) * 1024 + col0;
#pragma unroll
                for (int bj = 0; bj < 2; ++bj)
#pragma unroll
                    for (int n = 0; n < 2; ++n) __builtin_nontemporal_store(acc[ai][bj][m][n] * rstd * fwv[bj][n], (f32x4*)(out + off + bj * HALF + n * 16));
                asm volatile("" ::: "memory"); }
    }
};
template <class Epi, class Sched, bool ALIGN_EPI = false, bool SP2 = false>
__device__ __forceinline__ void gemm_phase(PG8_LAS unsigned char* lds, const Gemm g, const Sched& S, const Epi& E) {
    int tid_ = TIDX; asm volatile("" : "+v"(tid_));
    const int tid = tid_, wid = __builtin_amdgcn_readfirstlane(tid >> 6), lane = tid & 63, wr = wid >> 2, wc = wid & 3, fr = lane & 15, fq = lane >> 4;
    const int K = g.K, nt = K / BK;
    unsigned voffA[2], voffB[2];
#pragma unroll
    for (int i = 0; i < 2; ++i) { int R, C; stage_rc(tid * 16 + i * 8192, R, C); const int Rb = Epi::PERM ? ((R & ~31) + perm32(R & 31)) : R;
        voffA[i] = (unsigned)(R * g.lda + C) * 2u; voffB[i] = (unsigned)(Rb * K + C) * 2u; }
    const unsigned kstep = (unsigned)(BK * 2);
    const unsigned hsA = (unsigned)HALF * g.lda * 2u, hsB = (unsigned)HALF * K * 2u;
    const unsigned tsA = 2 * hsA, tsB = 2 * hsB, apo = (unsigned)g.a_pn_off * 2u;
    const unsigned ldsw = (unsigned)wid * 1024u;
    const int aoff = lds_byte(wr * 64 + fr, fq * 8), boff = lds_byte(wc * 32 + fr, fq * 8);
#define PG8_SA(b, h) (((b) * 2 + (h)) * HTB)
#define PG8_SB(b, h) ((4 + (b) * 2 + (h)) * HTB)
#define PG8_STAGEX(rs, bufoff, goff, voff) do { _Pragma("unroll") for (int _i = 0; _i < 2; ++_i) \
        __builtin_amdgcn_raw_ptr_buffer_load_lds((rs), (PG8_LAS void*)(lds + (bufoff) + ldsw + _i * 8192), 16, (int)(voff)[_i], (int)(goff), 0, 0); } while (0)
#define PG8_STAGEA(bufoff, goff, voff) PG8_STAGEX(rsA, bufoff, goff, voff)
#define PG8_STAGEB(bufoff, goff, voff) PG8_STAGEX(rsB, bufoff, goff, voff)
#define PG8_LDA(dst, b, h) do { _Pragma("unroll") for (int m = 0; m < 4; ++m) _Pragma("unroll") for (int k = 0; k < 2; ++k) dst[m][k] = *(const PG8_LAS bf16x8*)(lds + PG8_SA(b, h) + aoff + m * 2048 + k * 1024); } while (0)
#define PG8_LDB(dst, b, h) do { _Pragma("unroll") for (int n = 0; n < 2; ++n) _Pragma("unroll") for (int k = 0; k < 2; ++k) dst[n][k] = *(const PG8_LAS bf16x8*)(lds + PG8_SB(b, h) + boff + n * 2048 + k * 1024); } while (0)
#define PG8_MMA(ai, bj, At, Bt) do { __builtin_amdgcn_s_setprio(1); _Pragma("unroll") for (int m = 0; m < 4; ++m) _Pragma("unroll") for (int n = 0; n < 2; ++n) _Pragma("unroll") for (int k = 0; k < 2; ++k) \
        acc[ai][bj][m][n] = __builtin_amdgcn_mfma_f32_16x16x32_bf16(Bt[n][k], At[m][k], acc[ai][bj][m][n], 0, 0, 0); __builtin_amdgcn_s_setprio(0); } while (0)
#define PG8_WAIT_V(n) asm volatile("s_waitcnt vmcnt(" #n ")" ::: "memory")
#define PG8_WAIT_L(n) asm volatile("s_waitcnt lgkmcnt(" #n ")" ::: "memory")
#define PG8_BAR __builtin_amdgcn_s_barrier()
#define PG8_SCHED __builtin_amdgcn_sched_barrier(0)
    Unit cur, nxt; int ui = 0;
    if (!S.next(0, cur)) return;
    f32x4 acc[2][2][4][2];
#pragma unroll
    for (int a = 0; a < 2; ++a)
#pragma unroll
        for (int b = 0; b < 2; ++b)
#pragma unroll
            for (int m = 0; m < 4; ++m)
#pragma unroll
                for (int n = 0; n < 2; ++n) acc[a][b][m][n] = (f32x4){0.f, 0.f, 0.f, 0.f};
    bf16x8 At[4][2], B0[2][2], B1[2][2];
    const __amdgpu_buffer_rsrc_t rsA = __builtin_amdgcn_make_buffer_rsrc((void*)g.A, 0, 0x7ffffff0, 0x00020000), rsB = __builtin_amdgcn_make_buffer_rsrc((void*)g.Bt, 0, 0x7ffffff0, 0x00020000);
    unsigned cA = (unsigned)cur.pm * tsA + (unsigned)cur.pn * apo, cB = (unsigned)cur.pn * tsB;
    S.a_ready(cur);
    if constexpr (SP2) {
        PG8_STAGEB(PG8_SB(0, 0), cB, voffB); PG8_STAGEB(PG8_SB(0, 1), cB + hsB, voffB); PG8_STAGEA(PG8_SA(0, 0), cA, voffA); PG8_STAGEA(PG8_SA(0, 1), cA + hsA, voffA);
        if (wr == 1) PG8_BAR;
        PG8_WAIT_V(2); PG8_BAR;
        PG8_STAGEB(PG8_SB(1, 0), cB + kstep, voffB); PG8_STAGEA(PG8_SA(1, 0), cA + kstep, voffA); PG8_STAGEB(PG8_SB(1, 1), cB + hsB + kstep, voffB);
        PG8_WAIT_V(6); PG8_BAR;
    } else {
        PG8_STAGEB(PG8_SB(0, 0), cB, voffB); PG8_STAGEA(PG8_SA(0, 0), cA, voffA); PG8_STAGEB(PG8_SB(0, 1), cB + hsB, voffB); PG8_STAGEA(PG8_SA(0, 1), cA + hsA, voffA);
        if (wr == 1) PG8_BAR;
        PG8_WAIT_V(4); PG8_BAR;
        PG8_STAGEB(PG8_SB(1, 0), cB + kstep, voffB); PG8_STAGEA(PG8_SA(1, 0), cA + kstep, voffA); PG8_STAGEB(PG8_SB(1, 1), cB + hsB + kstep, voffB);
        PG8_WAIT_V(6); PG8_BAR;
    }
    for (;;) {
        const bool has_next = S.next(ui + 1, nxt);
        const unsigned nA = has_next ? (unsigned)nxt.pm * tsA + (unsigned)nxt.pn * apo : cA, nB = has_next ? (unsigned)nxt.pn * tsB : cB;
        for (int t = 0; t < nt; t += 2) {
            const bool last = (t == nt - 2);
            const unsigned a1 = cA + (unsigned)(t + 1) * kstep;
            const unsigned a2 = last ? nA : cA + (unsigned)(t + 2) * kstep, b2 = last ? nB : cB + (unsigned)(t + 2) * kstep;
            const unsigned a3 = a2 + kstep, b3 = b2 + kstep;
            if (last && has_next) S.a_ready(nxt);
            if constexpr (SP2) {
            PG8_LDB(B0, 0, 0); PG8_LDB(B1, 0, 1); PG8_SCHED; PG8_LDA(At, 0, 0); PG8_STAGEA(PG8_SA(1, 1), a1 + hsA, voffA);
            PG8_WAIT_V(8); PG8_WAIT_L(0); PG8_BAR; PG8_MMA(0, 0, At, B0); PG8_MMA(0, 1, At, B1); PG8_BAR; PG8_SCHED;
            PG8_LDA(At, 0, 1); PG8_STAGEB(PG8_SB(0, 0), b2, voffB); PG8_STAGEB(PG8_SB(0, 1), b2 + hsB, voffB); PG8_STAGEA(PG8_SA(0, 0), a2, voffA);
            PG8_WAIT_V(8); PG8_WAIT_L(0); PG8_BAR; PG8_MMA(1, 0, At, B0); PG8_MMA(1, 1, At, B1); PG8_BAR; PG8_SCHED;
            PG8_LDB(B0, 1, 0); PG8_LDB(B1, 1, 1); PG8_SCHED; PG8_LDA(At, 1, 0); PG8_STAGEA(PG8_SA(0, 1), a2 + hsA, voffA);
            PG8_WAIT_V(8); PG8_WAIT_L(0); PG8_BAR; PG8_MMA(0, 0, At, B0); PG8_MMA(0, 1, At, B1); PG8_BAR; PG8_SCHED;
            PG8_LDA(At, 1, 1); PG8_STAGEB(PG8_SB(1, 0), b3, voffB); PG8_STAGEB(PG8_SB(1, 1), b3 + hsB, voffB); PG8_STAGEA(PG8_SA(1, 0), a3, voffA);
            PG8_WAIT_V(8); PG8_WAIT_L(0); PG8_BAR; PG8_MMA(1, 0, At, B0); PG8_MMA(1, 1, At, B1); PG8_BAR; PG8_SCHED;
            } else {
            PG8_LDB(B0, 0, 0); PG8_SCHED; PG8_LDA(At, 0, 0); PG8_STAGEA(PG8_SA(1, 1), a1 + hsA, voffA);
            PG8_WAIT_L(8); PG8_BAR; PG8_WAIT_L(0); PG8_MMA(0, 0, At, B0); PG8_BAR; PG8_SCHED;
            PG8_LDB(B1, 0, 1); PG8_STAGEB(PG8_SB(0, 0), b2, voffB);
            PG8_BAR; PG8_WAIT_L(0); PG8_MMA(0, 1, At, B1); PG8_BAR;
            PG8_LDA(At, 0, 1); PG8_STAGEA(PG8_SA(0, 0), a2, voffA);
            PG8_BAR; PG8_WAIT_L(0); PG8_MMA(1, 0, At, B0); PG8_BAR; PG8_SCHED;
            PG8_STAGEB(PG8_SB(0, 1), b2 + hsB, voffB);
            PG8_WAIT_V(6); PG8_BAR; PG8_MMA(1, 1, At, B1); PG8_BAR;
            PG8_LDB(B0, 1, 0); PG8_SCHED; PG8_LDA(At, 1, 0); PG8_STAGEA(PG8_SA(0, 1), a2 + hsA, voffA);
            PG8_WAIT_L(8); PG8_BAR; PG8_WAIT_L(0); PG8_MMA(0, 0, At, B0); PG8_BAR; PG8_SCHED;
            PG8_LDB(B1, 1, 1); PG8_STAGEB(PG8_SB(1, 0), b3, voffB);
            PG8_BAR; PG8_WAIT_L(0); PG8_MMA(0, 1, At, B1); PG8_BAR;
            PG8_LDA(At, 1, 1); PG8_STAGEA(PG8_SA(1, 0), a3, voffA);
            PG8_BAR; PG8_WAIT_L(0); PG8_MMA(1, 0, At, B0); PG8_BAR; PG8_SCHED;
            PG8_STAGEB(PG8_SB(1, 1), b3 + hsB, voffB);
            PG8_WAIT_V(6); PG8_BAR; PG8_MMA(1, 1, At, B1); PG8_BAR;
            }
        }
        if constexpr (ALIGN_EPI) { if (wr == 0) PG8_BAR; }
        if constexpr (!Epi::AFTER_DRAIN) { E(acc, cur, wr, wc, fr, fq); S.done(cur); }
        if (!has_next) break;
#pragma unroll
        for (int a = 0; a < 2; ++a)
#pragma unroll
            for (int b = 0; b < 2; ++b)
#pragma unroll
                for (int m = 0; m < 4; ++m)
#pragma unroll
                    for (int n = 0; n < 2; ++n) acc[a][b][m][n] = (f32x4){0.f, 0.f, 0.f, 0.f};
        cur = nxt; cA = nA; cB = nB; ++ui;
        if constexpr (ALIGN_EPI) { if (wr == 1) PG8_BAR; }
    }
    PG8_WAIT_V(0);
    if constexpr (!ALIGN_EPI) { if (wr == 0) PG8_BAR; }
    PG8_BAR;
    if constexpr (Epi::AFTER_DRAIN) { E.fused(acc, cur, wr, wc, fr, fq, lds, wid, lane); S.done(cur); }
#undef PG8_SA
#undef PG8_SB
#undef PG8_STAGEX
#undef PG8_STAGEA
#undef PG8_STAGEB
#undef PG8_LDA
#undef PG8_LDB
#undef PG8_MMA
#undef PG8_WAIT_V
#undef PG8_WAIT_L
#undef PG8_BAR
#undef PG8_SCHED
}
}


namespace attn {
using bf16x8 = __attribute__((ext_vector_type(8))) short;
using s16x4  = __attribute__((ext_vector_type(4))) short;
using f32x16 = __attribute__((ext_vector_type(16))) float;
using u32x4  = __attribute__((ext_vector_type(4))) unsigned;
constexpr int DQK = 96, DV = 64, NW = 8, QBLK = 32, KVBLK = 64;
constexpr float THR = 8.f;
constexpr int SHM_V = KVBLK * DV * 2, SHM_K = KVBLK * 256;
constexpr int SHM_ATTN = 2 * SHM_V + 2 * SHM_K + NW * 64 * 4;
#define AT_KSWZ(row, colB) ((row) * 256 + ((colB) ^ (((row) & 7) << 4)))
#define AT_SBAR() __builtin_amdgcn_sched_barrier(0)
__device__ __forceinline__ int crow(int r, int hi) { return (r & 3) + 8 * (r >> 2) + 4 * hi; }
__device__ __forceinline__ unsigned cvtpk(float lo, float hi) { unsigned r; asm volatile("v_cvt_pk_bf16_f32 %0, %1, %2" : "=v"(r) : "v"(lo), "v"(hi)); return r; }
__device__ __forceinline__ float rowmax32(const f32x16& p0, const f32x16& p1) {
  float a = fmaxf(fmaxf(p0[0], p0[1]), p1[0]), b = fmaxf(fmaxf(p0[2], p0[3]), p1[1]); a = fmaxf(fmaxf(a, p1[2]), p1[3]);
#pragma unroll
  for (int r = 4; r < 16; r += 4) { a = fmaxf(fmaxf(a, p0[r]), p0[r + 1]); b = fmaxf(fmaxf(b, p0[r + 2]), p0[r + 3]); a = fmaxf(fmaxf(a, p1[r]), p1[r + 1]); b = fmaxf(fmaxf(b, p1[r + 2]), p1[r + 3]); }
  float pm = fmaxf(a, b);
  auto rr = __builtin_amdgcn_permlane32_swap(__float_as_uint(pm), __float_as_uint(pm), false, false);
  return fmaxf(__uint_as_float(rr[0]), __uint_as_float(rr[1]));
}
template <int VAR, bool FIRST> __device__ __forceinline__ void partialSM(f32x16& p0, f32x16& p1, float& m_reg, f32x16& negm, float& alpha) {
  const float pmax = rowmax32(p0, p1);
  alpha = 1.f;
  if (FIRST || !__builtin_expect(__all(pmax <= THR), 1)) {
    const float dl = FIRST ? pmax : fmaxf(pmax, 0.f);
    m_reg += dl; alpha = FIRST ? 0.f : __builtin_amdgcn_exp2f(-dl);
#pragma unroll
    for (int r = 0; r < 16; ++r) { p0[r] -= dl; p1[r] -= dl; negm[r] = -m_reg; }
  }
#pragma unroll
  for (int r = 0; r < 16; ++r) p0[r] = VAR == 2 ? p0[r] * 0.5f : __builtin_amdgcn_exp2f(p0[r]);
}
template <int VAR> __device__ __forceinline__ void finishSM(f32x16& p0, f32x16& p1, float alpha, float& l_reg, bf16x8& pa0, bf16x8& pa1, bf16x8& pa2, bf16x8& pa3) {
#pragma unroll
  for (int r = 0; r < 16; ++r) p1[r] = VAR == 2 ? p1[r] * 0.5f : __builtin_amdgcn_exp2f(p1[r]);
  float ps = 0;
#pragma unroll
  for (int r = 0; r < 16; ++r) ps += p0[r];
#pragma unroll
  for (int r = 0; r < 16; ++r) ps += p1[r];
  { auto rr = __builtin_amdgcn_permlane32_swap(__float_as_uint(ps), __float_as_uint(ps), false, false);
    ps = __uint_as_float(rr[0]) + __uint_as_float(rr[1]); }
  l_reg = l_reg * alpha + ps;
#define AT_PK4(P, BASE, OUT) do { unsigned a0 = cvtpk(P[BASE + 0], P[BASE + 1]), a1 = cvtpk(P[BASE + 2], P[BASE + 3]);   \
    unsigned b0 = cvtpk(P[BASE + 4], P[BASE + 5]), b1 = cvtpk(P[BASE + 6], P[BASE + 7]);                              \
    auto r0 = __builtin_amdgcn_permlane32_swap(a0, b0, false, false); auto r1 = __builtin_amdgcn_permlane32_swap(a1, b1, false, false); \
    u32x4 w = {r0[0], r1[0], r0[1], r1[1]}; OUT = *reinterpret_cast<bf16x8*>(&w); } while (0)
  AT_PK4(p0, 0, pa0); AT_PK4(p0, 8, pa1); AT_PK4(p1, 0, pa2); AT_PK4(p1, 8, pa3);
#undef AT_PK4
}
__device__ __forceinline__ void qkt(f32x16& p0, f32x16& p1, const char* Ks, const bf16x8* qr, int r32, int hi) {
  p0 = f32x16{}; p1 = f32x16{};
#pragma unroll
  for (int d0 = 0; d0 < DQK / 16; ++d0) { int cb = (d0 * 16 + hi * 8) * 2;
    bf16x8 b0 = *reinterpret_cast<const bf16x8*>(Ks + AT_KSWZ(r32, cb));
    bf16x8 b1 = *reinterpret_cast<const bf16x8*>(Ks + AT_KSWZ(32 + r32, cb));
    p0 = __builtin_amdgcn_mfma_f32_32x32x16_bf16(b0, qr[d0], p0, 0, 0, 0);
    p1 = __builtin_amdgcn_mfma_f32_32x32x16_bf16(b1, qr[d0], p1, 0, 0, 0); }
}
__device__ __forceinline__ int v_st(int k, int c) { const int kk = (k & ~0xC) | ((k & 4) << 1) | ((k & 8) >> 1); return ((kk >> 3) * 2 + (c >> 5)) * 512 + ((kk & 7) * 32 + (c & 31)) * 2; }
__device__ __forceinline__ int v_rd_base(int lane) { return ((lane & 3) << 3) | (((lane >> 2) & 3) << 6) | (((lane >> 4) & 1) << 5) | (((lane >> 5) & 1) << 8); }
constexpr int v_rd_off(int d0, int ks, int half) { return d0 * 512 + ks * 2048 + half * 1024; }
template <int OFF> __device__ __forceinline__ s16x4 tr_read(int vb) {
  s16x4 r; asm volatile("ds_read_b64_tr_b16 %0, %1 offset:%2" : "=&v"(r) : "v"(vb), "i"(OFF) : "memory"); return r;
}
template <int D0> __device__ __forceinline__ void pv_one(f32x16& od, int vb, bf16x8 pa0, bf16x8 pa1, bf16x8 pa2, bf16x8 pa3) {
  const s16x4 l0 = tr_read<v_rd_off(D0, 0, 0)>(vb), h0 = tr_read<v_rd_off(D0, 0, 1)>(vb), l1 = tr_read<v_rd_off(D0, 1, 0)>(vb), h1 = tr_read<v_rd_off(D0, 1, 1)>(vb);
  const s16x4 l2 = tr_read<v_rd_off(D0, 2, 0)>(vb), h2 = tr_read<v_rd_off(D0, 2, 1)>(vb), l3 = tr_read<v_rd_off(D0, 3, 0)>(vb), h3 = tr_read<v_rd_off(D0, 3, 1)>(vb);
  asm volatile("s_waitcnt lgkmcnt(0)" ::: "memory"); AT_SBAR();
#define AT_PK(L, H) (bf16x8){L[0], L[1], L[2], L[3], H[0], H[1], H[2], H[3]}
  od = __builtin_amdgcn_mfma_f32_32x32x16_bf16(pa0, AT_PK(l0, h0), od, 0, 0, 0);
  od = __builtin_amdgcn_mfma_f32_32x32x16_bf16(pa1, AT_PK(l1, h1), od, 0, 0, 0);
  od = __builtin_amdgcn_mfma_f32_32x32x16_bf16(pa2, AT_PK(l2, h2), od, 0, 0, 0);
  od = __builtin_amdgcn_mfma_f32_32x32x16_bf16(pa3, AT_PK(l3, h3), od, 0, 0, 0);
}
struct VFrag { s16x4 l[2][4], h[2][4]; };
__device__ __forceinline__ void vfrag_issue(VFrag& f, int vb) {
  f.l[0][0] = tr_read<v_rd_off(0, 0, 0)>(vb); f.h[0][0] = tr_read<v_rd_off(0, 0, 1)>(vb); f.l[1][0] = tr_read<v_rd_off(1, 0, 0)>(vb); f.h[1][0] = tr_read<v_rd_off(1, 0, 1)>(vb);
  f.l[0][1] = tr_read<v_rd_off(0, 1, 0)>(vb); f.h[0][1] = tr_read<v_rd_off(0, 1, 1)>(vb); f.l[1][1] = tr_read<v_rd_off(1, 1, 0)>(vb); f.h[1][1] = tr_read<v_rd_off(1, 1, 1)>(vb);
  f.l[0][2] = tr_read<v_rd_off(0, 2, 0)>(vb); f.h[0][2] = tr_read<v_rd_off(0, 2, 1)>(vb); f.l[1][2] = tr_read<v_rd_off(1, 2, 0)>(vb); f.h[1][2] = tr_read<v_rd_off(1, 2, 1)>(vb);
  f.l[0][3] = tr_read<v_rd_off(0, 3, 0)>(vb); f.h[0][3] = tr_read<v_rd_off(0, 3, 1)>(vb); f.l[1][3] = tr_read<v_rd_off(1, 3, 0)>(vb); f.h[1][3] = tr_read<v_rd_off(1, 3, 1)>(vb);
}
__device__ __forceinline__ void pv_mma(f32x16* o, const VFrag& f, bf16x8 pa0, bf16x8 pa1, bf16x8 pa2, bf16x8 pa3) {
  asm volatile("s_waitcnt lgkmcnt(0)" ::: "memory"); AT_SBAR();
  o[0] = __builtin_amdgcn_mfma_f32_32x32x16_bf16(pa0, AT_PK(f.l[0][0], f.h[0][0]), o[0], 0, 0, 0); o[1] = __builtin_amdgcn_mfma_f32_32x32x16_bf16(pa0, AT_PK(f.l[1][0], f.h[1][0]), o[1], 0, 0, 0);
  o[0] = __builtin_amdgcn_mfma_f32_32x32x16_bf16(pa1, AT_PK(f.l[0][1], f.h[0][1]), o[0], 0, 0, 0); o[1] = __builtin_amdgcn_mfma_f32_32x32x16_bf16(pa1, AT_PK(f.l[1][1], f.h[1][1]), o[1], 0, 0, 0);
  o[0] = __builtin_amdgcn_mfma_f32_32x32x16_bf16(pa2, AT_PK(f.l[0][2], f.h[0][2]), o[0], 0, 0, 0); o[1] = __builtin_amdgcn_mfma_f32_32x32x16_bf16(pa2, AT_PK(f.l[1][2], f.h[1][2]), o[1], 0, 0, 0);
  o[0] = __builtin_amdgcn_mfma_f32_32x32x16_bf16(pa3, AT_PK(f.l[0][3], f.h[0][3]), o[0], 0, 0, 0); o[1] = __builtin_amdgcn_mfma_f32_32x32x16_bf16(pa3, AT_PK(f.l[1][3], f.h[1][3]), o[1], 0, 0, 0);
}
#undef AT_PK
__device__ __forceinline__ void pv_d0(f32x16* o, int vb, bf16x8 pa0, bf16x8 pa1, bf16x8 pa2, bf16x8 pa3) {
  pv_one<0>(o[0], vb, pa0, pa1, pa2, pa3); pv_one<1>(o[1], vb, pa0, pa1, pa2, pa3);
}
constexpr int NSLOT = 4, KROWB = 208, SLOT_KB = 64 * KROWB, SLOT_VB = 8192, SLOT_B = SLOT_KB + SLOT_VB, LDS_WS = NSLOT * SLOT_B;
template <int VAR> __device__ __forceinline__ void attn_unit(const bf16_t* __restrict__ Qb, const bf16_t* __restrict__ Kh, const bf16_t* __restrict__ Vh, int seq,
                                          bf16_t* __restrict__ Ob, int o_pitch, const bf16_t* __restrict__ GA, int ga_pitch, char* lds, LAS unsigned char* L3) {
  int tid_ = TIDX; asm volatile("" : "+v"(tid_));
  const int tid = tid_, lane = tid & 63, r32 = lane & 31, hi = lane >> 5; const int wid = __builtin_amdgcn_readfirstlane(tid >> 6);
  float* ws = (float*)(lds + LDS_WS) + wid * 64; float* li_l = ws; float* al_l = ws + 32;
  float m_reg = 0.f, l_reg = 0; f32x16 o[2] = {}; bf16x8 qr[6]; f32x16 negm = {}; VFrag vf;
  int koff0, koff1, voff;
  { const int s0 = 64 * wid + lane, row0 = s0 / 13, c0 = s0 - row0 * 13; koff0 = row0 * 192 + (c0 < 12 ? c0 : 0) * 16;
    const int s1 = s0 + 512, row1 = s1 / 13, c1 = s1 - row1 * 13; koff1 = row1 * 192 + (c1 < 12 ? c1 : 0) * 16;
    const int sub = s0 >> 5, kk = (sub >> 1) * 8 + ((s0 & 31) >> 2), k = (kk & ~0xC) | ((kk & 4) << 1) | ((kk & 8) >> 1), c = (sub & 1) * 32 + (s0 & 3) * 8; voff = k * 128 + c * 2; }
  const bool k2 = wid < 5;
  const __amdgpu_buffer_rsrc_t rsK = __builtin_amdgcn_make_buffer_rsrc((void*)Kh, 0, 0x7ffffff0, 0x00020000), rsV = __builtin_amdgcn_make_buffer_rsrc((void*)Vh, 0, 0x7ffffff0, 0x00020000);
#define AT_DMA(t) do { const int so_ = ((t) & 3) * SLOT_B; \
    __builtin_amdgcn_raw_ptr_buffer_load_lds(rsK, (LAS void*)(L3 + so_ + wid * 1024), 16, koff0, (t) * (64 * 192), 0, 0); \
    if (k2) __builtin_amdgcn_raw_ptr_buffer_load_lds(rsK, (LAS void*)(L3 + so_ + (wid + 8) * 1024), 16, koff1, (t) * (64 * 192), 0, 0); \
    __builtin_amdgcn_raw_ptr_buffer_load_lds(rsV, (LAS void*)(L3 + so_ + SLOT_KB + wid * 1024), 16, voff, (t) * (64 * 128), 0, 0); } while (0)
#define AT_WAITBAR(n) do { if (k2) asm volatile("s_waitcnt vmcnt(" #n "*3) lgkmcnt(0)" ::: "memory"); else asm volatile("s_waitcnt vmcnt(" #n "*2) lgkmcnt(0)" ::: "memory"); __builtin_amdgcn_s_barrier(); } while (0)
  const int NTL = seq / KVBLK;
  const bf16_t* Qw = Qb + (long)(wid * QBLK + r32) * DQK + hi * 8;
#pragma unroll
  for (int d0 = 0; d0 < 6; ++d0) qr[d0] = *reinterpret_cast<const bf16x8*>(Qw + d0 * 16);
  AT_DMA(0); AT_DMA(1); AT_DMA(2);
  const int kb = r32 * KROWB + hi * 16;
  const int vb0 = (int)(uintptr_t)lds + SLOT_KB + v_rd_base(lane);
#define AT_QKT(P0, P1, t) do { const char* ks_ = lds + ((t) & 3) * SLOT_B + kb; \
    _Pragma("unroll") for (int d0 = 0; d0 < 6; ++d0) { const bf16x8 b0 = *reinterpret_cast<const bf16x8*>(ks_ + d0 * 32), b1 = *reinterpret_cast<const bf16x8*>(ks_ + 32 * KROWB + d0 * 32); \
      if (d0 == 0) { P0 = __builtin_amdgcn_mfma_f32_32x32x16_bf16(b0, qr[0], negm, 0, 0, 0); P1 = __builtin_amdgcn_mfma_f32_32x32x16_bf16(b1, qr[0], negm, 0, 0, 0); } \
      else { P0 = __builtin_amdgcn_mfma_f32_32x32x16_bf16(b0, qr[d0], P0, 0, 0, 0); P1 = __builtin_amdgcn_mfma_f32_32x32x16_bf16(b1, qr[d0], P1, 0, 0, 0); } } } while (0)
#define AT_RESC(a) do { if (__any((a) < 1.f)) { if (hi == 0) al_l[r32] = (a); asm volatile("s_waitcnt lgkmcnt(0)" ::: "memory"); \
    _Pragma("unroll") for (int d = 0; d < 2; ++d) _Pragma("unroll") for (int r = 0; r < 16; ++r) o[d][r] *= al_l[crow(r, hi)]; } } while (0)
  f32x16 pA0, pA1, pB0, pB1; float alA, alB; bf16x8 pa0, pa1, pa2, pa3;
  if (k2) asm volatile("s_waitcnt vmcnt(6)" ::: "memory"); else asm volatile("s_waitcnt vmcnt(4)" ::: "memory");
  __builtin_amdgcn_s_barrier();
  AT_QKT(pA0, pA1, 0); partialSM<VAR, true>(pA0, pA1, m_reg, negm, alA);
  AT_WAITBAR(1);
  for (int j = 1; j + 1 < NTL; j += 2) {
    AT_DMA(j + 2);
    vfrag_issue(vf, vb0 + ((j - 1) & 3) * SLOT_B);
    AT_SBAR(); AT_QKT(pB0, pB1, j);
    finishSM<VAR>(pA0, pA1, alA, l_reg, pa0, pa1, pa2, pa3); AT_SBAR();
    pv_mma(o, vf, pa0, pa1, pa2, pa3); partialSM<VAR, false>(pB0, pB1, m_reg, negm, alB);
    AT_RESC(alB);
    AT_WAITBAR(1);
    if (j + 3 < NTL) AT_DMA(j + 3);
    vfrag_issue(vf, vb0 + (j & 3) * SLOT_B);
    AT_SBAR(); AT_QKT(pA0, pA1, j + 1);
    finishSM<VAR>(pB0, pB1, alB, l_reg, pa0, pa1, pa2, pa3); AT_SBAR();
    pv_mma(o, vf, pa0, pa1, pa2, pa3); partialSM<VAR, false>(pA0, pA1, m_reg, negm, alA);
    AT_RESC(alA);
    if (j + 3 < NTL) AT_WAITBAR(1); else AT_WAITBAR(0);
  }
  vfrag_issue(vf, vb0 + ((NTL - 2) & 3) * SLOT_B);
  AT_SBAR(); AT_QKT(pB0, pB1, NTL - 1);
  finishSM<VAR>(pA0, pA1, alA, l_reg, pa0, pa1, pa2, pa3); AT_SBAR();
  pv_mma(o, vf, pa0, pa1, pa2, pa3); partialSM<VAR, false>(pB0, pB1, m_reg, negm, alB);
  AT_RESC(alB);
  finishSM<VAR>(pB0, pB1, alB, l_reg, pa0, pa1, pa2, pa3); AT_SBAR();
  pv_d0(o, vb0 + ((NTL - 1) & 3) * SLOT_B, pa0, pa1, pa2, pa3);
  if (hi == 0) li_l[r32] = l_reg; asm volatile("s_waitcnt lgkmcnt(0)" ::: "memory");
  float rli[16];
#pragma unroll
  for (int r = 0; r < 16; ++r) rli[r] = __builtin_amdgcn_rcpf(li_l[crow(r, hi)]);
#pragma unroll
  for (int r = 0; r < 16; ++r) { const int orow = wid * QBLK + crow(r, hi);
#pragma unroll
    for (int d0 = 0; d0 < 2; ++d0) { if (VAR != 0 && seq >= 0) continue; const float ga = bf2f(GA[(long)orow * ga_pitch + d0 * 32 + r32]);
      Ob[(long)orow * o_pitch + d0 * 32 + r32] = f2bf(o[d0][r] * rli[r] * (ga * __builtin_amdgcn_rcpf(1.f + __expf(-ga)))); } }
  asm volatile("s_waitcnt vmcnt(0) lgkmcnt(0)" ::: "memory"); __builtin_amdgcn_s_barrier();
#undef AT_DMA
#undef AT_WAITBAR
#undef AT_QKT
#undef AT_RESC
}
#undef AT_KSWZ
#undef AT_SBAR
}


namespace ssd {
using attn::bf16x8; using attn::s16x4; using attn::f32x16; using attn::u32x4;
constexpr int LC = 128, NCH = 66;
constexpr int L_X = 0, L_B = 65536, L_C = 81920, L_CS = 98304, L_DT = L_CS + 4096, L_SC = L_DT + 4096;
constexpr float LOG2E = 1.4426950408889634f;
__device__ __forceinline__ int rimg(int row, int c) { return row * 128 + ((c ^ (row & 7)) << 4); }
__device__ __forceinline__ int chunk_row(int b, int c) { return c < 2 ? ML + b * CTXL + c * LC : b * SEQ + (c - 2) * LC; }
__device__ __forceinline__ float bfbits2f(short v) { return __uint_as_float(((unsigned)(unsigned short)v) << 16); }
template <bool STEP3> __device__ __forceinline__ float load_chunk(const bf16_t* __restrict__ U, const float* __restrict__ DTS, const float* __restrict__ a_log, int rowbase, int g, char* lds) {
    int tid_ = TIDX; asm volatile("" : "+v"(tid_)); const int tid = tid_;
    constexpr int NLD = STEP3 ? 12 : 10, NB2 = NLD / 2;
#pragma unroll
    for (int hb = 0; hb < 2; ++hb) {
        bf16x8 stg[NB2];
#pragma unroll
        for (int q = 0; q < NB2; ++q) { const int it = hb * NB2 + q; const int i = tid + it * NT;
            if (it < 8) { const int s = i >> 5, cc = i & 31; stg[q] = *(const bf16x8*)(U + (size_t)(rowbase + s) * 768 + g * 256 + cc * 8); }
            else if (it < 10) { const int j = i - 4096, s = j >> 3, c = j & 7; stg[q] = *(const bf16x8*)(U + (size_t)(rowbase + s) * 768 + 512 + g * 64 + c * 8); }
            else { const int j = i - 5120, s = j >> 3, c = j & 7; stg[q] = *(const bf16x8*)(U + (size_t)(rowbase + s) * 768 + 640 + g * 64 + c * 8); } }
#pragma unroll
        for (int q = 0; q < NB2; ++q) { const int it = hb * NB2 + q; const int i = tid + it * NT;
            if (it < 8) { const int s = i >> 5, cc = i & 31, hh = cc >> 3, c8 = (cc & 7) * 8; *(bf16x8*)(lds + L_X + hh * 16384 + attn::v_st(s, c8)) = stg[q]; }
            else if (it < 10) { const int j = i - 4096, s = j >> 3, c = j & 7; *(bf16x8*)(lds + L_B + (STEP3 ? rimg(s, c) : attn::v_st(s, c * 8))) = stg[q]; }
            else { const int j = i - 5120, s = j >> 3, c = j & 7; *(bf16x8*)(lds + L_C + rimg(s, c)) = stg[q]; } }
    }
    const int w = tid >> 6, lane = tid & 63, d = w >> 2, hh = w & 3, h = g * 4 + hh;
    const float A2 = -__expf(a_log[d * 8 + h]) * LOG2E;
    const int s0 = d ? 127 - lane : lane, s1 = d ? 63 - lane : 64 + lane;
    const float dt0 = DTS[(size_t)(rowbase + s0) * 16 + d * 8 + h], dt1 = DTS[(size_t)(rowbase + s1) * 16 + d * 8 + h];
    float x0 = dt0 * A2, x1 = dt1 * A2;
    { int ln = lane; asm volatile("" : "+v"(ln));
#pragma unroll
      for (int off = 1; off < 64; off <<= 1) { const int src = (ln - off) << 2;
          const float t0 = __int_as_float(__builtin_amdgcn_ds_bpermute(src, __float_as_int(x0))), t1 = __int_as_float(__builtin_amdgcn_ds_bpermute(src, __float_as_int(x1)));
          if (ln >= off) { x0 += t0; x1 += t1; } } }
    x1 += __int_as_float(__builtin_amdgcn_readlane(__float_as_int(x0), 63)); const float T = __int_as_float(__builtin_amdgcn_readlane(__float_as_int(x1), 63));
    float* CS = (float*)(lds + L_CS) + w * 128; float* DTL = (float*)(lds + L_DT) + w * 128; float* SC = (float*)(lds + L_SC) + w * 128;
    CS[s0] = x0; CS[s1] = x1; DTL[s0] = dt0; DTL[s1] = dt1;
    if (STEP3) { SC[s0] = exp2f(x0); SC[s1] = exp2f(x1); } else { SC[s0] = dt0 * exp2f(T - x0); SC[s1] = dt1 * exp2f(T - x1); }
    return T;
}
#define SSD_SBAR() __builtin_amdgcn_sched_barrier(0)
template <int KS> __device__ __forceinline__ void st1_step(f32x16 (&acc)[2][2], int vbx, int vbb, const float* SCw, int hi) {
    typedef float f32x4v __attribute__((ext_vector_type(4)));
    const f32x4v sA = *(const f32x4v*)(SCw + 16 * KS + 8 * hi), sB = *(const f32x4v*)(SCw + 16 * KS + 8 * hi + 4);
    const s16x4 xl0 = attn::tr_read<attn::v_rd_off(0, KS, 0)>(vbx), xh0 = attn::tr_read<attn::v_rd_off(0, KS, 1)>(vbx);
    const s16x4 xl1 = attn::tr_read<attn::v_rd_off(1, KS, 0)>(vbx), xh1 = attn::tr_read<attn::v_rd_off(1, KS, 1)>(vbx);
    const s16x4 bl0 = attn::tr_read<attn::v_rd_off(0, KS, 0)>(vbb), bh0 = attn::tr_read<attn::v_rd_off(0, KS, 1)>(vbb);
    const s16x4 bl1 = attn::tr_read<attn::v_rd_off(1, KS, 0)>(vbb), bh1 = attn::tr_read<attn::v_rd_off(1, KS, 1)>(vbb);
    asm volatile("s_waitcnt lgkmcnt(0)" ::: "memory"); SSD_SBAR();
#define SSD_SCL(L, H) ({ u32x4 w_; w_.x = attn::cvtpk(bfbits2f(L[0]) * sA[0], bfbits2f(L[1]) * sA[1]); w_.y = attn::cvtpk(bfbits2f(L[2]) * sA[2], bfbits2f(L[3]) * sA[3]); \
        w_.z = attn::cvtpk(bfbits2f(H[0]) * sB[0], bfbits2f(H[1]) * sB[1]); w_.w = attn::cvtpk(bfbits2f(H[2]) * sB[2], bfbits2f(H[3]) * sB[3]); *reinterpret_cast<bf16x8*>(&w_); })
#define SSD_PK(L, H) (bf16x8){L[0], L[1], L[2], L[3], H[0], H[1], H[2], H[3]}
    const bf16x8 a0 = SSD_SCL(xl0, xh0), a1 = SSD_SCL(xl1, xh1), b0 = SSD_PK(bl0, bh0), b1 = SSD_PK(bl1, bh1);
    acc[0][0] = __builtin_amdgcn_mfma_f32_32x32x16_bf16(a0, b0, acc[0][0], 0, 0, 0); acc[0][1] = __builtin_amdgcn_mfma_f32_32x32x16_bf16(a0, b1, acc[0][1], 0, 0, 0);
    acc[1][0] = __builtin_amdgcn_mfma_f32_32x32x16_bf16(a1, b0, acc[1][0], 0, 0, 0); acc[1][1] = __builtin_amdgcn_mfma_f32_32x32x16_bf16(a1, b1, acc[1][1], 0, 0, 0);
#undef SSD_SCL
}
__device__ __forceinline__ void states_item(const bf16_t* U, const float* DTS, const float* a_log, bf16_t* SST, float* CD, int b, int c, int g, char* lds) {
    const float T = load_chunk<false>(U, DTS, a_log, chunk_row(b, c), g, lds);
    __syncthreads();
    const int tid = TIDX, w = tid >> 6, lane = tid & 63, r32 = lane & 31, hi = lane >> 5, d = w >> 2, hh = w & 3, h = g * 4 + hh;
    const int vbx = (int)(uintptr_t)(lds + L_X + hh * 16384) + attn::v_rd_base(lane), vbb = (int)(uintptr_t)(lds + L_B) + attn::v_rd_base(lane);
    const float* SCw = (const float*)(lds + L_SC) + w * 128;
    f32x16 acc[2][2] = {};
    st1_step<0>(acc, vbx, vbb, SCw, hi); st1_step<1>(acc, vbx, vbb, SCw, hi); st1_step<2>(acc, vbx, vbb, SCw, hi); st1_step<3>(acc, vbx, vbb, SCw, hi);
    st1_step<4>(acc, vbx, vbb, SCw, hi); st1_step<5>(acc, vbx, vbb, SCw, hi); st1_step<6>(acc, vbx, vbb, SCw, hi); st1_step<7>(acc, vbx, vbb, SCw, hi);
    const size_t cidx = (((size_t)b * NCH + c) * 2 + d) * 8 + h;
    bf16_t* So = SST + cidx * 4096;
#pragma unroll
    for (int pb = 0; pb < 2; ++pb)
#pragma unroll
        for (int nb = 0; nb < 2; ++nb)
#pragma unroll
            for (int r = 0; r < 16; ++r) So[(pb * 32 + attn::crow(r, hi)) * 64 + nb * 32 + r32] = f2bf(acc[pb][nb][r]);
    if (lane == 0) CD[cidx] = exp2f(T);
    __syncthreads();
}
__device__ __forceinline__ void out_item(const bf16_t* U, const float* DTS, const float* a_log, const bf16_t* HIN, bf16_t* Y, int b, int j, int g, char* lds) {
    typedef float f32x4v __attribute__((ext_vector_type(4)));
    const int rowbase = b * SEQ + j * LC, c = j + 2;
    int tid_ = TIDX; asm volatile("" : "+v"(tid_));
    const int tid = tid_, w = tid >> 6, lane = tid & 63, r32 = lane & 31, hi = lane >> 5, hh = w & 3, lp = w >> 2, h = g * 4 + hh;
    bf16x8 hbn[4][2];
#define SSD_HLOAD(dd) do { const bf16_t* Hp_ = HIN + ((((size_t)b * NCH + c) * 2 + (dd)) * 8 + h) * 4096; \
    _Pragma("unroll") for (int ks = 0; ks < 4; ++ks) { const bf16_t* h0 = Hp_ + r32 * 64 + ks * 16 + hi * 8; hbn[ks][0] = *(const bf16x8*)h0; hbn[ks][1] = *(const bf16x8*)(h0 + 32 * 64); } } while (0)
    SSD_HLOAD(0);
    (void)load_chunk<true>(U, DTS, a_log, rowbase, g, lds);
    __syncthreads();
    const char* BR = lds + L_B; const char* CR = lds + L_C;
    const int vbx = (int)(uintptr_t)(lds + L_X + hh * 16384) + attn::v_rd_base(lane);
#pragma unroll
    for (int lti = 0; lti < 2; ++lti) { const int lt = 2 * lp + lti, l = 32 * lt + r32;
        f32x16 y0 = {}, y1 = {};
#pragma unroll
        for (int d = 0; d < 2; ++d) { const int combo = d * 4 + hh;
            const float* CSw = (const float*)(lds + L_CS) + combo * 128; const float* DTw = (const float*)(lds + L_DT) + combo * 128; const float* ELw = (const float*)(lds + L_SC) + combo * 128;
            f32x16 t0 = {}, t1 = {};
            bf16x8 hb[4][2];
#pragma unroll
            for (int ks = 0; ks < 4; ++ks) { hb[ks][0] = hbn[ks][0]; hb[ks][1] = hbn[ks][1]; }
            if (!(lti == 1 && d == 1)) SSD_HLOAD(1 - d);
#pragma unroll
            for (int ks = 0; ks < 4; ++ks) { const bf16x8 A = *(const bf16x8*)(CR + rimg(l, 2 * ks + hi));
                t0 = __builtin_amdgcn_mfma_f32_32x32x16_bf16(A, hb[ks][0], t0, 0, 0, 0);
                t1 = __builtin_amdgcn_mfma_f32_32x32x16_bf16(A, hb[ks][1], t1, 0, 0, 0); }
#pragma unroll
            for (int k4 = 0; k4 < 4; ++k4) { const f32x4v fv = *(const f32x4v*)(ELw + 32 * lt + 4 * hi + 8 * k4);
#pragma unroll
                for (int i = 0; i < 4; ++i) { t0[4 * k4 + i] *= fv[i]; t1[4 * k4 + i] *= fv[i]; } }
            const float fl = CSw[l];
#pragma unroll
            for (int st = 0; st < 2; ++st) {
                const bool need = d == 0 ? (64 * st <= 32 * lt + 31) : (64 * st + 63 >= 32 * lt);
                if (need) {
                    f32x16 p0 = {}, p1 = {};
#pragma unroll
                    for (int ks = 0; ks < 4; ++ks) { const bf16x8 q = *(const bf16x8*)(CR + rimg(l, 2 * ks + hi));
                        const bf16x8 b0 = *(const bf16x8*)(BR + rimg(64 * st + r32, 2 * ks + hi)), b1 = *(const bf16x8*)(BR + rimg(64 * st + 32 + r32, 2 * ks + hi));
                        p0 = __builtin_amdgcn_mfma_f32_32x32x16_bf16(b0, q, p0, 0, 0, 0); p1 = __builtin_amdgcn_mfma_f32_32x32x16_bf16(b1, q, p1, 0, 0, 0); }
#pragma unroll
                    for (int k4 = 0; k4 < 4; ++k4) {
                        const int sb = 64 * st + 8 * k4 + 4 * hi;
                        const f32x4v c0v = *(const f32x4v*)(CSw + sb), c1v = *(const f32x4v*)(CSw + sb + 32), d0v = *(const f32x4v*)(DTw + sb), d1v = *(const f32x4v*)(DTw + sb + 32);
#pragma unroll
                        for (int i = 0; i < 4; ++i) { const int r = 4 * k4 + i, s0 = sb + i, s1 = s0 + 32;
                            const bool m0 = d == 0 ? (s0 <= l) : (s0 >= l), m1 = d == 0 ? (s1 <= l) : (s1 >= l);
                            p0[r] = m0 ? p0[r] * (__builtin_amdgcn_exp2f(fl - c0v[i]) * d0v[i]) : 0.f; p1[r] = m1 ? p1[r] * (__builtin_amdgcn_exp2f(fl - c1v[i]) * d1v[i]) : 0.f; }
                        asm volatile("" ::: "memory"); }
                    bf16x8 pa0, pa1, pa2, pa3;
#define SSD_PK4(P, BASE, OUT) do { unsigned a0 = attn::cvtpk(P[BASE + 0], P[BASE + 1]), a1 = attn::cvtpk(P[BASE + 2], P[BASE + 3]);   \
    unsigned b0_ = attn::cvtpk(P[BASE + 4], P[BASE + 5]), b1_ = attn::cvtpk(P[BASE + 6], P[BASE + 7]);                              \
    auto r0 = __builtin_amdgcn_permlane32_swap(a0, b0_, false, false); auto r1 = __builtin_amdgcn_permlane32_swap(a1, b1_, false, false); \
    u32x4 w_ = {r0[0], r1[0], r0[1], r1[1]}; OUT = *reinterpret_cast<bf16x8*>(&w_); } while (0)
                    SSD_PK4(p0, 0, pa0); SSD_PK4(p0, 8, pa1); SSD_PK4(p1, 0, pa2); SSD_PK4(p1, 8, pa3);
#undef SSD_PK4
                    SSD_SBAR();
                    attn::pv_one<0>(t0, vbx + st * 8192, pa0, pa1, pa2, pa3); attn::pv_one<1>(t1, vbx + st * 8192, pa0, pa1, pa2, pa3);
                }
            }
            y0 += t0; y1 += t1;
        }
#pragma unroll
        for (int r = 0; r < 16; ++r) { bf16_t* yr = Y + (size_t)(rowbase + 32 * lt + attn::crow(r, hi)) * 512 + h * 64 + r32; yr[0] = f2bf(y0[r]); yr[32] = f2bf(y1[r]); }
    }
    __syncthreads();
#undef SSD_HLOAD
}
#undef SSD_PK
#undef SSD_SBAR
}

struct Ptrs {
    const float *x, *c, *ctx, *c_ctx, *mod_w, *mod_b, *norm_w, *w_in_mix, *q_norm, *w_uq, *kv_norm, *w_ukv, *conv_w, *conv_b, *a_log, *dt_bias, *d_skip, *ssd_norm,
        *w_out_mix, *w_in_pool, *pool_lin, *pool_scale, *w_out_pool, *final_norm;
    float* out; char* ws;
};


__device__ __forceinline__ unsigned pk2(float lo, float hi) { return (unsigned)f2bf(lo) | ((unsigned)f2bf(hi) << 16); }
typedef unsigned v4u __attribute__((ext_vector_type(4)));
__device__ __forceinline__ void tr_item(const float* W, int ldw, int Nsrc, int K, bf16_t* WT, int row_off, const float* kscale, int ks_off, const float* nscale, float gscale,
                                        LAS float* scr, int item, int nblk, int lane) {
    const int kb = item / nblk, nb = item % nblk, k0 = 64 * kb, n0 = 32 * nb;
    const int n4 = n0 + 4 * (lane & 7); const bool nin = n4 < Nsrc;
    f32x4 ns = {gscale, gscale, gscale, gscale};
    if (nscale && nin) { const f32x4 t = *(const f32x4*)(nscale + n4); ns = t * gscale; }
#pragma unroll
    for (int i = 0; i < 8; ++i) { const int kk = 8 * i + (lane >> 3);
        f32x4 w = nin ? __builtin_nontemporal_load((const f32x4*)(W + (size_t)(k0 + kk) * ldw + n4)) : (f32x4){0.f, 0.f, 0.f, 0.f};
        if (kscale && (k0 + kk) >= ks_off) w = w * kscale[k0 + kk - ks_off];
        w = w * ns;
        LAS float* d = scr + kk * 33 + 4 * (lane & 7); d[0] = w[0]; d[1] = w[1]; d[2] = w[2]; d[3] = w[3]; }
    asm volatile("s_waitcnt lgkmcnt(0)" ::: "memory");
    const int c = lane & 7;
#pragma unroll
    for (int j = 0; j < 4; ++j) { const int n = (lane >> 3) + 8 * j; const LAS float* sp = scr + (8 * c) * 33 + n;
        v4u o; o.x = pk2(sp[0 * 33], sp[1 * 33]); o.y = pk2(sp[2 * 33], sp[3 * 33]); o.z = pk2(sp[4 * 33], sp[5 * 33]); o.w = pk2(sp[6 * 33], sp[7 * 33]);
        *(v4u*)(WT + (size_t)(row_off + n0 + n) * K + k0 + 8 * c) = o; }
    asm volatile("s_waitcnt lgkmcnt(0)" ::: "memory");
}
__device__ __forceinline__ void ph_weights(const Ptrs& P, LAS unsigned char* L) {
    const int lane = TIDX & 63, wv = TIDX >> 6;
    LAS float* scr = (LAS float*)(L + wv * 16384);
    const int gw = blockIdx.x * (NT / 64) + wv, NGW = gridDim.x * (NT / 64);
    constexpr int I1 = 16 * 80, I2 = 6 * 24, I3 = 4 * 32, I4 = 16 * 32, I5 = 16 * 64, I6 = 4 * 32, I7 = 16 * 32;
    for (int it = gw; it < I1 + I2 + I3 + I4 + I5 + I6 + I7; it += NGW) {
        int r = it;
        if (r < I1) { tr_item(P.w_in_mix, 2480, 2480, 1024, (bf16_t*)(P.ws + WS_WT1), 0, nullptr, 0, nullptr, 1.f, scr, r, 80, lane); continue; } r -= I1;
        if (r < I2) { tr_item(P.w_uq, 768, 768, 384, (bf16_t*)(P.ws + WS_WTQ), 0, P.q_norm, 0, nullptr, QSCALE, scr, r, 24, lane); continue; } r -= I2;
        if (r < I3) { tr_item(P.w_ukv, 1024, 1024, 256, (bf16_t*)(P.ws + WS_WTKV), 0, P.kv_norm, 0, nullptr, 1.f, scr, r, 32, lane); continue; } r -= I3;
        if (r < I4) { tr_item(P.w_out_mix, 1024, 1024, 1024, (bf16_t*)(P.ws + WS_WTO), 0, P.ssd_norm, 512, nullptr, 1.f, scr, r, 32, lane); continue; } r -= I4;
        if (r < I5) { tr_item(P.w_in_pool, 2048, 2048, 1024, (bf16_t*)(P.ws + WS_WTP), 0, nullptr, 0, nullptr, 1.f, scr, r, 64, lane); continue; } r -= I5;
        if (r < I6) { const int g = r / 32; tr_item(P.pool_lin + (size_t)g * 65536, 256, 256, 256, (bf16_t*)(P.ws + WS_WTL), g * 256, nullptr, 0, P.pool_scale + g * 256, 1.f, scr, r % 32, 8, lane); continue; } r -= I6;
        tr_item(P.w_out_pool, 1024, 1024, 1024, (bf16_t*)(P.ws + WS_WTOP), 0, nullptr, 0, nullptr, 1.f, scr, r, 32, lane);
    }
}

__device__ __forceinline__ void ph_modvec(const Ptrs& P, LAS unsigned char* L) {
    float* modv = (float*)(P.ws + WS_MODV);
    LAS float* sv = (LAS float*)L;
    LAS float* red = (LAS float*)(L + 20480);
    const int tid = TIDX;
    for (int i = tid; i < 5 * 1024; i += NT) { const int v = i >> 10, k = i & 1023; sv[i] = siluf(v < 4 ? P.c[v * 1024 + k] : P.c_ctx[k]); }
    __syncthreads();
    for (int it = blockIdx.x; it < 2 * 128; it += gridDim.x) {
        const int layer = it >> 7, col0 = (it & 127) * 24;
        if (tid < 384) { const int c4 = tid % 6, kg = tid / 6;
            const float* wp = P.mod_w + ((size_t)layer * 1024 + kg * 16) * 3072 + col0 + c4 * 4;
            f32x4 w[16];
#pragma unroll
            for (int r = 0; r < 16; ++r) w[r] = __builtin_nontemporal_load((const f32x4*)(wp + (size_t)r * 3072));
            f32x4 acc[5];
#pragma unroll
            for (int v = 0; v < 5; ++v) acc[v] = (f32x4){0.f, 0.f, 0.f, 0.f};
#pragma unroll
            for (int r = 0; r < 16; ++r)
#pragma unroll
                for (int v = 0; v < 5; ++v) acc[v] += w[r] * sv[v * 1024 + kg * 16 + r];
#pragma unroll
            for (int v = 0; v < 5; ++v) { LAS float* d = red + (kg * 5 + v) * 24 + c4 * 4; d[0] = acc[v][0]; d[1] = acc[v][1]; d[2] = acc[v][2]; d[3] = acc[v][3]; }
        }
        __syncthreads();
        if (tid < 120) { const int v = tid / 24, cc = tid % 24; float a = 0.f;
#pragma unroll 8
            for (int kg = 0; kg < 64; ++kg) a += red[(kg * 5 + v) * 24 + cc];
            modv[(layer * 5 + v) * 3072 + col0 + cc] = a + P.mod_b[layer * 3072 + col0 + cc]; }
        __syncthreads();
    }
    float* COS = (float*)(P.ws + WS_COS); float* SIN = (float*)(P.ws + WS_SIN);
    GSTRIDE(idx, SEQ * 16) {
        int t = (int)(idx / 16), j = (int)(idx % 16);
        float pos = (float)(j < 8 ? t / 64 : t % 64);
        float invf = 1.0f / powf(10000.0f, (float)(2 * (j & 7)) / 16.0f);
        float ang = pos * invf;
        COS[idx] = cosf(ang); SIN[idx] = sinf(ang);
    }
}
template <bool HAS_CTX> __device__ __forceinline__ void ph_norm_mod(const float* xl, const float* ctx, int nrows, const float* norm_w, const float* modv, bf16_t* H) {
    const int tid = TIDX, lane = tid & 63, gw = blockIdx.x * (NT / 64) + (tid >> 6), NGW = gridDim.x * (NT / 64);
    f32x4 nw[4];
#pragma unroll
    for (int j = 0; j < 4; ++j) nw[j] = *(const f32x4*)(norm_w + 4 * lane + 256 * j);
#define NM_SRC(r) ((!HAS_CTX || (r) < ML) ? xl + (size_t)(r) * DM : ctx + (size_t)((r) - ML) * DM)
    int vc = -1; f32x4 scv[4], shv[4];
    for (int row = 2 * gw; row < nrows; row += 2 * NGW) {
        f32x4 xv[2][4];
#pragma unroll
        for (int q = 0; q < 2; ++q) { const float* src = NM_SRC(row + q);
#pragma unroll
            for (int j = 0; j < 4; ++j) xv[q][j] = __builtin_nontemporal_load((const f32x4*)(src + 4 * lane + 256 * j)); }
        { const int v = (!HAS_CTX || row < ML) ? row / SEQ : 4;
          if (v != vc) { vc = v;
#pragma unroll
              for (int j = 0; j < 4; ++j) { const int k = 4 * lane + 256 * j; shv[j] = *(const f32x4*)(modv + v * 3072 + k); scv[j] = *(const f32x4*)(modv + v * 3072 + 1024 + k) + 1.f; } } }
#pragma unroll
        for (int q = 0; q < 2; ++q) { const int r = row + q; float ss = 0.f;
#pragma unroll
            for (int j = 0; j < 4; ++j) ss += (xv[q][j].x * xv[q][j].x + xv[q][j].y * xv[q][j].y) + (xv[q][j].z * xv[q][j].z + xv[q][j].w * xv[q][j].w);
            ss = wave_sum(ss);
            const float rstd = rsqrtf(ss * (1.f / DM) + RMS_EPS);
#pragma unroll
            for (int j = 0; j < 4; ++j) { const int k = 4 * lane + 256 * j;
                const f32x4 o = xv[q][j] * rstd * nw[j] * scv[j] + shv[j];
                uint2 w; w.x = pk2f(o.x, o.y); w.y = pk2f(o.z, o.w);
                *(uint2*)(H + (size_t)r * DM + k) = w; } }
    }
#undef NM_SRC
}
template <int RT, class Epi>
__device__ __forceinline__ void ph_gemm(const bf16_t* A, int lda, const float* W, int ldw, int M, int N, int K, const float* kscale, int ks_off, const Epi& E) {
    const int ncb = (N + NT - 1) / NT, nitems = ncb * (M / RT);
    for (int it = blockIdx.x; it < nitems; it += gridDim.x) {
        const int cb = it % ncb, rg = it / ncb; const int col = cb * NT + TIDX, row0 = rg * RT;
        float acc[RT];
#pragma unroll
        for (int r = 0; r < RT; ++r) acc[r] = 0.f;
        if (col < N) {
            for (int k = 0; k < K; ++k) {
                float w = W[(size_t)k * ldw + col];
                if (kscale && k >= ks_off) w *= kscale[k - ks_off];
#pragma unroll
                for (int r = 0; r < RT; ++r) acc[r] += bf2f(A[(size_t)(row0 + r) * lda + k]) * w;
            }
#pragma unroll
            for (int r = 0; r < RT; ++r) E(row0 + r, col, acc[r]);
        }
    }
}
struct EpiProj { bf16_t* P; float* DT;
    __device__ void operator()(int row, int col, float a) const { P[(size_t)row * PN + col] = f2bf(a); if (col >= C_DT) DT[row * 16 + col - C_DT] = a; } };
struct EpiRes { const float* res; const float* gate; float* out;
    __device__ void operator()(int row, int col, float a) const { int b = row / SEQ; out[(size_t)row * DM + col] = res[(size_t)row * DM + col] + gate[b * 3072 + 2048 + col] * a; } };
struct EpiBf { bf16_t* O; int ld;
    __device__ void operator()(int row, int col, float a) const { O[(size_t)row * ld + col] = f2bf(a); } };

__device__ __forceinline__ void ph_upproj(const Ptrs& P) {
    const bf16_t* PR = (const bf16_t*)(P.ws + WS_PROJ); const float* COS = (const float*)(P.ws + WS_COS); const float* SIN = (const float*)(P.ws + WS_SIN);
    bf16_t* Q = (bf16_t*)(P.ws + WS_Q); bf16_t* Kb = (bf16_t*)(P.ws + WS_K); bf16_t* Vb = (bf16_t*)(P.ws + WS_V);
    GSTRIDE(idx, MT * 16) {
        int jj = (int)(idx % 16), row = (int)(idx / 16); int b, t; bool isctx; row_info(row, b, t, isctx); int key = isctx ? t : CTXL + t;
        float k1 = bf2f(PR[(size_t)row * PN + C_KPE + jj]), k2 = bf2f(PR[(size_t)row * PN + C_KPE + 16 + jj]);
        float o1 = k1, o2 = k2;
        if (!isctx) { float cs = COS[t * 16 + jj], sn = SIN[t * 16 + jj]; o1 = k1 * cs - k2 * sn; o2 = k2 * cs + k1 * sn; }
        for (int h = 0; h < 8; ++h) { size_t kr = (size_t)(b * 8 + h) * NKEY + key; Kb[kr * 96 + 64 + jj] = f2bf(o1); Kb[kr * 96 + 80 + jj] = f2bf(o2); }
    }
    bf16_t* U = (bf16_t*)(P.ws + WS_U);
    GSTRIDE(idx, (long)(MT / 32) * 96) {
        const int cq = (int)(idx % 96), rb = (int)(idx / 96), row0 = rb * 32; int b, t0; bool isctx; row_info(row0, b, t0, isctx); const int n = isctx ? CTXL : SEQ;
        const bf16_t* p = PR + (size_t)row0 * PN + C_XBC + cq * 8; bf16_t* uo = U + (size_t)row0 * 768 + cq * 8;
        float w0[8], w1[8], w2[8], bs[8];
#pragma unroll
        for (int i = 0; i < 8; ++i) { w0[i] = P.conv_w[cq * 8 + i]; w1[i] = P.conv_w[768 + cq * 8 + i]; w2[i] = P.conv_w[1536 + cq * 8 + i]; bs[i] = P.conv_b[cq * 8 + i]; }
        typedef unsigned v4u_ __attribute__((ext_vector_type(4)));
        v4u_ rows[34];
#pragma unroll
        for (int r = 0; r < 34; ++r) { const int t = t0 - 1 + r; rows[r] = (t >= 0 && t < n) ? *(const v4u_*)(p + (long)(r - 1) * PN) : (v4u_){0u, 0u, 0u, 0u}; }
#pragma unroll
        for (int r = 0; r < 32; ++r) { v4u_ o;
#pragma unroll
            for (int i = 0; i < 4; ++i) {
                const float a0 = __uint_as_float(rows[r][i] << 16), a1 = __uint_as_float(rows[r][i] & 0xffff0000u);
                const float c0 = __uint_as_float(rows[r + 1][i] << 16), c1 = __uint_as_float(rows[r + 1][i] & 0xffff0000u);
                const float n0 = __uint_as_float(rows[r + 2][i] << 16), n1 = __uint_as_float(rows[r + 2][i] & 0xffff0000u);
                const float v0 = bs[2 * i] + w0[2 * i] * a0 + w1[2 * i] * c0 + w2[2 * i] * n0, v1 = bs[2 * i + 1] + w0[2 * i + 1] * a1 + w1[2 * i + 1] * c1 + w2[2 * i + 1] * n1;
                o[i] = pk2(siluf(v0), siluf(v1)); }
            *(v4u_*)(uo + (size_t)r * 768) = o; }
    }
    const float* DT = (const float*)(P.ws + WS_DT); float* DTS = (float*)(P.ws + WS_DTS);
    GSTRIDE(idx, MT * 16) DTS[idx] = softplusf(DT[idx] + P.dt_bias[idx % 16]);
}
__device__ __forceinline__ void ph_ssd_states(const Ptrs& P, unsigned char* lds) {
    const bf16_t* U = (const bf16_t*)(P.ws + WS_U); const float* DTS = (const float*)(P.ws + WS_DTS);
    for (int it = blockIdx.x; it < NB * ssd::NCH * 2; it += gridDim.x) { const int b = it / (ssd::NCH * 2), rem = it % (ssd::NCH * 2);
        ssd::states_item(U, DTS, P.a_log, (bf16_t*)(P.ws + WS_SST), (float*)(P.ws + WS_CD), b, rem >> 1, rem & 1, (char*)lds); }
}
__device__ __forceinline__ void ph_ssd_chunkscan(const Ptrs& P) {
    bf16_t* SST = (bf16_t*)(P.ws + WS_SST); const float* CD = (const float*)(P.ws + WS_CD);
    GSTRIDE(idx, NB * 2 * 8 * 2048) {
        const int e2 = (int)(idx & 2047); const int bdh = __builtin_amdgcn_readfirstlane((int)(idx >> 11));
        const int h = bdh & 7, d = (bdh >> 3) & 1, b = bdh >> 4;
        unsigned Sv[ssd::NCH];
#pragma unroll
        for (int k = 0; k < ssd::NCH; ++k) { const int c = d == 0 ? k : (k < 2 ? 1 - k : 67 - k); const size_t ci = (((size_t)b * ssd::NCH + c) * 2 + d) * 8 + h; Sv[k] = *(const unsigned*)(SST + ci * 4096 + 2 * e2); }
        float h0 = 0.f, h1 = 0.f;
#pragma unroll
        for (int k = 0; k < ssd::NCH; ++k) { const int c = d == 0 ? k : (k < 2 ? 1 - k : 67 - k); const size_t ci = (((size_t)b * ssd::NCH + c) * 2 + d) * 8 + h;
            if (k >= 2) *(unsigned*)(SST + ci * 4096 + 2 * e2) = pk2f(h0, h1);
            const float dec = CD[ci];
            h0 = h0 * dec + __uint_as_float(Sv[k] << 16); h1 = h1 * dec + __uint_as_float(Sv[k] & 0xffff0000u); }
    }
}
__device__ __forceinline__ void ph_ssd_out(const Ptrs& P, unsigned char* lds);
template <int VAR> __device__ __forceinline__ void ph_attn_mfma(const Ptrs& P, unsigned char* lds) {
    const bf16_t* Q = (const bf16_t*)(P.ws + WS_Q); const bf16_t* Kb = (const bf16_t*)(P.ws + WS_K); const bf16_t* Vb = (const bf16_t*)(P.ws + WS_V);
    const bf16_t* PR = (const bf16_t*)(P.ws + WS_PROJ); bf16_t* CAT = (bf16_t*)P.out;
    const int G = gridDim.x, c = blockIdx.x; const int vcu = (G % 8 == 0) ? (c % 8) * (G / 8) + c / 8 : c;
    for (int unit = vcu; unit < NB * 8 * 32; unit += G) {
        const int bh = unit >> 5, qb = unit & 31; const int b = bh >> 3, h = bh & 7; const int row0 = b * SEQ + qb * 256;
        attn::attn_unit<VAR>(Q + ((size_t)bh * SEQ + qb * 256) * 96, Kb + (size_t)bh * NKEY * 96, Vb + (size_t)bh * NKEY * 64, NKEY,
                        CAT + (size_t)row0 * DM + h * 64, DM, PR + (size_t)row0 * PN + C_GA + h * 64, PN, (char*)lds, (LAS unsigned char*)lds);
    }
}

__device__ __forceinline__ void merge_rows(const Ptrs& P, int row_begin, int row_end, int gw, int NGW) {
    const bf16_t* Y = (const bf16_t*)(P.ws + WS_H); const bf16_t* U = (const bf16_t*)(P.ws + WS_U); const bf16_t* PR = (const bf16_t*)(P.ws + WS_PROJ); bf16_t* CAT = (bf16_t*)P.out;
    int lane = lane_id_(); asm volatile("" : "+v"(lane));
    typedef unsigned v4u_ __attribute__((ext_vector_type(4)));
    const int h = lane >> 3; const float sk = P.d_skip[h] + P.d_skip[8 + h];
    for (int row = row_begin + 4 * gw; row < row_end; row += 4 * NGW) {
        v4u_ yv[4], xv[4], zv[4];
#pragma unroll
        for (int q = 0; q < 4; ++q) { const size_t r = (size_t)(row + q);
            yv[q] = *(const v4u_*)(Y + r * 512 + 8 * lane); xv[q] = *(const v4u_*)(U + r * 768 + 8 * lane); zv[q] = *(const v4u_*)(PR + r * PN + C_Z + 8 * lane); }
#pragma unroll
        for (int q = 0; q < 4; ++q) { float v[8]; float ss = 0.f;
#pragma unroll
            for (int i = 0; i < 4; ++i) {
                const float y0 = __uint_as_float(yv[q][i] << 16), y1 = __uint_as_float(yv[q][i] & 0xffff0000u), x0 = __uint_as_float(xv[q][i] << 16), x1 = __uint_as_float(xv[q][i] & 0xffff0000u);
                const float z0 = __uint_as_float(zv[q][i] << 16), z1 = __uint_as_float(zv[q][i] & 0xffff0000u);
                v[2 * i] = (y0 + sk * x0) * siluf(z0); v[2 * i + 1] = (y1 + sk * x1) * siluf(z1); ss += v[2 * i] * v[2 * i] + v[2 * i + 1] * v[2 * i + 1]; }
            ss = wave_sum(ss);
            const float rstd = rsqrtf(ss * (1.f / 512.f) + RMS_EPS);
            v4u_ o;
#pragma unroll
            for (int i = 0; i < 4; ++i) o[i] = pk2f(v[2 * i] * rstd, v[2 * i + 1] * rstd);
            *(v4u_*)(CAT + (size_t)(row + q) * DM + 512 + 8 * lane) = o; }
    }
}
__device__ __forceinline__ void ph_merge(const Ptrs& P) { const int tid = TIDX; merge_rows(P, 0, ML, blockIdx.x * (NT / 64) + (tid >> 6), gridDim.x * (NT / 64)); }

__device__ __forceinline__ void ph_ssd_out(const Ptrs& P, unsigned char* lds) {
    const bf16_t* U = (const bf16_t*)(P.ws + WS_U); const float* DTS = (const float*)(P.ws + WS_DTS);
    for (int it = blockIdx.x; it < NB * 64; it += gridDim.x) { const int b = it >> 6, j = it & 63;
#pragma unroll 1
        for (int g = 0; g < 2; ++g) ssd::out_item(U, DTS, P.a_log, (const bf16_t*)(P.ws + WS_SST), (bf16_t*)(P.ws + WS_H), b, j, g, (char*)lds);
        asm volatile("s_waitcnt vmcnt(0)" ::: "memory"); __syncthreads();
        const int row0 = b * SEQ + j * ssd::LC; merge_rows(P, row0, row0 + ssd::LC, TIDX >> 6, NT / 64); }
}

template <int W, int R> __device__ __forceinline__ void pool_item(const bf16_t* __restrict__ UG, bf16_t* __restrict__ MP, int row0, int t0, int ch) {
    typedef unsigned v4u_ __attribute__((ext_vector_type(4)));
    constexpr int NR = R + W - 1, LO = W / 2;
    v4u_ v[NR];
#pragma unroll
    for (int r = 0; r < NR; ++r) { const int t = t0 - LO + r; v[r] = (t >= 0 && t < SEQ) ? *(const v4u_*)(UG + (size_t)(row0 - LO + r) * 2048 + ch) : (v4u_){0u, 0u, 0u, 0u}; }
    float S[8];
#pragma unroll
    for (int i = 0; i < 8; ++i) S[i] = 0.f;
#pragma unroll
    for (int r = 0; r < W; ++r)
#pragma unroll
        for (int i = 0; i < 4; ++i) { S[2 * i] += __uint_as_float(v[r][i] << 16); S[2 * i + 1] += __uint_as_float(v[r][i] & 0xffff0000u); }
#pragma unroll
    for (int r = 0; r < R; ++r) { const int t = t0 + r; int lo = t - LO; if (lo < 0) lo = 0; int hi = t + (W - LO - 1); if (hi > SEQ - 1) hi = SEQ - 1;
        const float inv = 1.f / (float)(hi - lo + 1); v4u_ o;
#pragma unroll
        for (int i = 0; i < 4; ++i) { const float u0 = __uint_as_float(v[r + LO][i] << 16), u1 = __uint_as_float(v[r + LO][i] & 0xffff0000u);
            o[i] = pk2(S[2 * i] * inv - u0, S[2 * i + 1] * inv - u1); }
        *(v4u_*)(MP + (size_t)(row0 + r) * 1024 + ch) = o;
        if (r < R - 1) {
#pragma unroll
            for (int i = 0; i < 4; ++i) { S[2 * i] += __uint_as_float(v[r + W][i] << 16) - __uint_as_float(v[r][i] << 16); S[2 * i + 1] += __uint_as_float(v[r + W][i] & 0xffff0000u) - __uint_as_float(v[r][i] & 0xffff0000u); } } }
}
__device__ __forceinline__ void ph_pool(const Ptrs& P) {
    const bf16_t* UG = (const bf16_t*)(P.ws + WS_Q); bf16_t* MP = (bf16_t*)(P.ws + WS_H);
    GSTRIDE(idx, (long)(ML / 32) * 4 * 64) {
        const int cg = (int)(idx & 31), rsub = (int)((idx >> 5) & 1), g = (int)((idx >> 6) & 3), rp = (int)(idx >> 8);
        const int row0 = rp * 32 + rsub * 16, t0 = row0 & (SEQ - 1), ch = g * 256 + cg * 8;
        if (g == 0) pool_item<2, 16>(UG, MP, row0, t0, ch); else if (g == 1) pool_item<4, 16>(UG, MP, row0, t0, ch); else if (g == 2) pool_item<8, 16>(UG, MP, row0, t0, ch);
        else { pool_item<16, 8>(UG, MP, row0, t0, ch); asm volatile("" ::: "memory"); pool_item<16, 8>(UG, MP, row0 + 8, t0 + 8, ch); }
    }
}
__device__ __forceinline__ void ph_final(const Ptrs& P) {
    const int lane = TIDX & 63, gw = blockIdx.x * (NT / 64) + (TIDX >> 6), NGW = gridDim.x * (NT / 64);
    f32x4 nx[4]; f32x4 fw[4];
#pragma unroll
    for (int j = 0; j < 4; ++j) fw[j] = *(const f32x4*)(P.final_norm + 4 * lane + 256 * j);
    if (gw < ML) {
#pragma unroll
        for (int j = 0; j < 4; ++j) nx[j] = *(const f32x4*)(P.out + (size_t)gw * DM + 4 * lane + 256 * j); }
    for (int row = gw; row < ML; row += NGW) {
        float* xr = P.out + (size_t)row * DM; f32x4 xv[4]; float ss = 0.f;
#pragma unroll
        for (int j = 0; j < 4; ++j) xv[j] = nx[j];
        if (row + NGW < ML) {
#pragma unroll
            for (int j = 0; j < 4; ++j) nx[j] = *(const f32x4*)(xr + (size_t)NGW * DM + 4 * lane + 256 * j); }
#pragma unroll
        for (int j = 0; j < 4; ++j) ss += (xv[j].x * xv[j].x + xv[j].y * xv[j].y) + (xv[j].z * xv[j].z + xv[j].w * xv[j].w);
        ss = wave_sum(ss);
        const float rstd = rsqrtf(ss * (1.f / DM) + RMS_EPS);
#pragma unroll
        for (int j = 0; j < 4; ++j) { const int k = 4 * lane + 256 * j; *(f32x4*)(xr + k) = xv[j] * rstd * fw[j]; }
    }
}


template <int W, int R> __device__ __forceinline__ void pool_to_lds(const bf16_t* __restrict__ UG, int grow0, int t0, int ch, LAS unsigned char* dst, int r0, int cc) {
    typedef unsigned v4u_ __attribute__((ext_vector_type(4)));
    constexpr int NR = R + W - 1, LO = W / 2;
    v4u_ v[NR];
#pragma unroll
    for (int r = 0; r < NR; ++r) { const int t = t0 - LO + r; v[r] = (t >= 0 && t < SEQ) ? *(const v4u_*)(UG + (size_t)(grow0 - LO + r) * 2048 + ch) : (v4u_){0u, 0u, 0u, 0u}; }
    float S[8];
#pragma unroll
    for (int i = 0; i < 8; ++i) S[i] = 0.f;
#pragma unroll
    for (int r = 0; r < W; ++r)
#pragma unroll
        for (int i = 0; i < 4; ++i) { S[2 * i] += __uint_as_float(v[r][i] << 16); S[2 * i + 1] += __uint_as_float(v[r][i] & 0xffff0000u); }
#pragma unroll
    for (int r = 0; r < R; ++r) { const int t = t0 + r; int lo = t - LO; if (lo < 0) lo = 0; int hi = t + (W - LO - 1); if (hi > SEQ - 1) hi = SEQ - 1;
        const float inv = 1.f / (float)(hi - lo + 1); v4u_ o;
#pragma unroll
        for (int i = 0; i < 4; ++i) { const float u0 = __uint_as_float(v[r + LO][i] << 16), u1 = __uint_as_float(v[r + LO][i] & 0xffff0000u);
            o[i] = pk2f(S[2 * i] * inv - u0, S[2 * i + 1] * inv - u1); }
        *(LAS v4u_*)(dst + pg8::lds_byte(r0 + r, cc)) = o;
        if (r < R - 1) {
#pragma unroll
            for (int i = 0; i < 4; ++i) { S[2 * i] += __uint_as_float(v[r + W][i] << 16) - __uint_as_float(v[r][i] << 16); S[2 * i + 1] += __uint_as_float(v[r + W][i] & 0xffff0000u) - __uint_as_float(v[r][i] & 0xffff0000u); } } }
}
__device__ __forceinline__ void ph_pool_lin_fused(const Ptrs& P, LAS unsigned char* L) {
    using pg8::f32x4; using pg8::bf16x8;
    const bf16_t* UG = (const bf16_t*)(P.ws + WS_Q); const bf16_t* Wtl = (const bf16_t*)(P.ws + WS_WTL); bf16_t* T = (bf16_t*)(P.ws + WS_U);
    pg8::StaticOrder S; S.init(ML, 1024, (int)gridDim.x, (int)blockIdx.x);
    const pg8::EpiPL E{T, UG};
    pg8::Unit u;
    for (int ui = 0; S.next(ui, u); ++ui) {
        int tid_ = TIDX; asm volatile("" : "+v"(tid_));
        const int tid = tid_, wid = __builtin_amdgcn_readfirstlane(tid >> 6), lane = tid & 63, wr = wid >> 2, wc = wid & 3, fr = lane & 15, fq = lane >> 4;
        const int g = u.pn;
        { const int chunk = tid & 31, run = tid >> 5; const int kt = chunk >> 3, cc = (chunk & 7) * 8, ai = run >> 3, r0 = (run & 7) * 16;
          const int grow0 = u.pm * 256 + run * 16, t0 = grow0 & (SEQ - 1), ch = g * 256 + chunk * 8;
          LAS unsigned char* dst = L + (ai * 4 + kt) * 16384;
          if (g == 0) pool_to_lds<2, 16>(UG, grow0, t0, ch, dst, r0, cc); else if (g == 1) pool_to_lds<4, 16>(UG, grow0, t0, ch, dst, r0, cc); else if (g == 2) pool_to_lds<8, 16>(UG, grow0, t0, ch, dst, r0, cc);
          else { pool_to_lds<16, 8>(UG, grow0, t0, ch, dst, r0, cc); asm volatile("" ::: "memory"); pool_to_lds<16, 8>(UG, grow0 + 8, t0 + 8, ch, dst, r0 + 8, cc); } }
        __syncthreads();
        f32x4 acc[2][2][4][2];
#pragma unroll
        for (int a = 0; a < 2; ++a)
#pragma unroll
            for (int b = 0; b < 2; ++b)
#pragma unroll
                for (int m = 0; m < 4; ++m)
#pragma unroll
                    for (int n = 0; n < 2; ++n) acc[a][b][m][n] = (f32x4){0.f, 0.f, 0.f, 0.f};
        const int aoff = pg8::lds_byte(wr * 64 + fr, fq * 8);
        const bf16_t* Bg = Wtl + (size_t)(g * 256) * 256 + fq * 8;
        const int brow = 32 * wc + 8 * (fr >> 2) + (fr & 3);
#pragma unroll 1
        for (int kt = 0; kt < 4; ++kt) {
            bf16x8 Bf[2][2][2];
#pragma unroll
            for (int bj = 0; bj < 2; ++bj)
#pragma unroll
                for (int n = 0; n < 2; ++n)
#pragma unroll
                    for (int k = 0; k < 2; ++k) Bf[bj][n][k] = *(const bf16x8*)(Bg + (size_t)(128 * bj + brow + 4 * n) * 256 + kt * 64 + k * 32);
#pragma unroll
            for (int ai = 0; ai < 2; ++ai) { bf16x8 At[4][2];
#pragma unroll
                for (int m = 0; m < 4; ++m)
#pragma unroll
                    for (int k = 0; k < 2; ++k) At[m][k] = *(const LAS bf16x8*)(L + (ai * 4 + kt) * 16384 + aoff + m * 2048 + k * 1024);
#pragma unroll
                for (int bj = 0; bj < 2; ++bj)
#pragma unroll
                    for (int m = 0; m < 4; ++m)
#pragma unroll
                        for (int n = 0; n < 2; ++n)
#pragma unroll
                            for (int k = 0; k < 2; ++k) acc[ai][bj][m][n] = __builtin_amdgcn_mfma_f32_16x16x32_bf16(Bf[bj][n][k], At[m][k], acc[ai][bj][m][n], 0, 0, 0); }
        }
        E(acc, u, wr, wc, fr, fq);
        __syncthreads();
    }
}

#ifndef ATTN_PROBE
#define ATTN_PROBE 0
#endif
struct Args { const float* in[24]; float* out; char* ws; int ph_lo, ph_hi; };
constexpr int N_PHASES = 15;
__global__ void __launch_bounds__(NT, 2) mk_fwd(Args a) {
    unsigned char* lds = g_lds;
    LAS unsigned char* L = (LAS unsigned char*)lds;
    for (int u = threadIdx.x; u < (LDS_BYTES - LDSCTL_OFF) / 4; u += NT) ((LAS unsigned*)(L + LDSCTL_OFF))[u] = 0u;
    __syncthreads();
    if ((threadIdx.x & 63) == 0) ((LAS int*)(L + WIDTAB_OFF))[hw_slot_()] = (int)(threadIdx.x >> 6);
    __syncthreads();
    Ptrs P;
    P.x = a.in[0]; P.c = a.in[1]; P.ctx = a.in[2]; P.c_ctx = a.in[3]; P.mod_w = a.in[4]; P.mod_b = a.in[5]; P.norm_w = a.in[6]; P.w_in_mix = a.in[7];
    P.q_norm = a.in[8]; P.w_uq = a.in[9]; P.kv_norm = a.in[10]; P.w_ukv = a.in[11]; P.conv_w = a.in[12]; P.conv_b = a.in[13]; P.a_log = a.in[14];
    P.dt_bias = a.in[15]; P.d_skip = a.in[16]; P.ssd_norm = a.in[17]; P.w_out_mix = a.in[18]; P.w_in_pool = a.in[19]; P.pool_lin = a.in[20];
    P.pool_scale = a.in[21]; P.w_out_pool = a.in[22]; P.final_norm = a.in[23]; P.out = a.out; P.ws = a.ws;
    unsigned* ctl = (unsigned*)(a.ws + WS_CTL);
    const bool one_launch = (a.ph_hi - a.ph_lo) > 1;
    XcdBarrier bar; bar.bar = ctl + CW_BAR; bar.x = 0; bar.st = nullptr;
    if (one_launch) bar = xcd_barrier_post(ctl + CW_BAR, (volatile LAS unsigned*)(L + MISC_OFF) + 8);
    const int lo = a.ph_lo, hi = a.ph_hi;
#define IN(k) (lo <= (k) && (k) < hi)
#define SEAM(k) do { if (IN(k) && IN((k) + 1)) xcd_barrier(bar); } while (0)
    float* MODV = (float*)(a.ws + WS_MODV);
    bf16_t* H = (bf16_t*)(a.ws + WS_H); bf16_t* PROJ = (bf16_t*)(a.ws + WS_PROJ); float* X1 = (float*)(a.ws + WS_PROJ);
    bf16_t* UG = (bf16_t*)(a.ws + WS_Q); bf16_t* T = (bf16_t*)(a.ws + WS_U); bf16_t* CAT = (bf16_t*)a.out;
    if (IN(0)) { ph_modvec(P, L); } SEAM(0);
    if (IN(1)) { ph_weights(P, L); ph_norm_mod<true>(P.x, P.ctx, MT, P.norm_w, MODV, H); } SEAM(1);
    if (IN(2)) { pg8::Gemm g{H, (const bf16_t*)(a.ws + WS_WT1), MT, 2560, 1024, 1024, 0}; pg8::StaticOrder S; S.init(MT, 2560, (int)gridDim.x, (int)blockIdx.x);
        pg8::EpiProjM E{PROJ, (float*)(a.ws + WS_SS), (float*)(a.ws + WS_DT)};
        pg8::gemm_phase<pg8::EpiProjM, pg8::StaticOrder, true, true>(L, g, S, E); } SEAM(2);
    if (IN(3)) {
        { pg8::Gemm g{PROJ + C_QA, (const bf16_t*)(a.ws + WS_WTQ), ML, 768, 384, PN, 0}; pg8::StaticOrder S; S.init(ML, 768, (int)gridDim.x, (int)blockIdx.x);
          pg8::EpiQ E{(bf16_t*)(a.ws + WS_Q), (const float*)(a.ws + WS_SS), (const float*)(a.ws + WS_COS), (const float*)(a.ws + WS_SIN)};
          pg8::gemm_phase<pg8::EpiQ, pg8::StaticOrder, true, true>(L, g, S, E); }
        { pg8::Gemm g{PROJ + C_KVA, (const bf16_t*)(a.ws + WS_WTKV), MT, 1024, 256, PN, 0}; pg8::StaticOrder S; S.init(MT, 1024, (int)gridDim.x, (int)((blockIdx.x + gridDim.x / 2) % gridDim.x));
          pg8::EpiKV E{(bf16_t*)(a.ws + WS_K), (bf16_t*)(a.ws + WS_V), (const float*)(a.ws + WS_SS)};
          pg8::gemm_phase<pg8::EpiKV, pg8::StaticOrder, true, true>(L, g, S, E); }
        ph_upproj(P); } SEAM(3);
    if (IN(4)) { ph_ssd_states(P, lds); } SEAM(4);
    if (IN(5)) { ph_ssd_chunkscan(P); ph_attn_mfma<ATTN_PROBE>(P, lds); if (ATTN_PROBE != 0) ph_attn_mfma<0>(P, lds); } SEAM(5);
    if (IN(6)) { ph_ssd_out(P, lds); } SEAM(6);
    const bool fusedn = gridDim.x == 256 && one_launch;
    if (IN(8)) {
        if (fusedn) {
#pragma unroll 1
            for (int half = 0; half < 2; ++half) { pg8::Gemm g{CAT + (size_t)half * 16384 * 1024, (const bf16_t*)(a.ws + WS_WTO), 16384, 1024, 1024, 1024, 0}; pg8::StaticOrder S; S.init(16384, 1024, (int)gridDim.x, (int)blockIdx.x);
                pg8::PanelRms st{(unsigned*)(a.ws + WS_XB), ctl + CW_PANEL, half * 64, RMS_EPS};
                pg8::EpiResNorm E{P.x, MODV, (_Float16*)X1, H, P.norm_w + DM, MODV + 5 * 3072, st, SEQ, 0};
                pg8::gemm_phase<pg8::EpiResNorm, pg8::StaticOrder, false, true>(L, g, S, E); __syncthreads(); }
        } else {
            pg8::Gemm g{CAT, (const bf16_t*)(a.ws + WS_WTO), ML, 1024, 1024, 1024, 0}; pg8::StaticOrder S; S.init(ML, 1024, (int)gridDim.x, (int)blockIdx.x);
            pg8::EpiResM E{P.x, MODV, X1, SEQ, 0};
            pg8::gemm_phase<pg8::EpiResM, pg8::StaticOrder, true, true>(L, g, S, E); } } SEAM(8);
    if (IN(9) && !fusedn) { ph_norm_mod<false>(X1, nullptr, ML, P.norm_w + DM, MODV + 5 * 3072, H); } if (!fusedn) SEAM(9);
    if (IN(10)) { pg8::Gemm g{H, (const bf16_t*)(a.ws + WS_WTP), ML, 2048, 1024, 1024, 0}; pg8::StaticOrder S; S.init(ML, 2048, (int)gridDim.x, (int)blockIdx.x);
        pg8::EpiBf16<0> E{UG, 2048, nullptr, 0, 0, 1.f};
        pg8::gemm_phase<pg8::EpiBf16<0>, pg8::StaticOrder, true, true>(L, g, S, E); } SEAM(10);
    if (IN(11)) { ph_pool_lin_fused(P, L); } SEAM(11);
    if (IN(13)) {
        if (fusedn) {
#pragma unroll 1
            for (int half = 0; half < 2; ++half) { pg8::Gemm g{T + (size_t)half * 16384 * 1024, (const bf16_t*)(a.ws + WS_WTOP), 16384, 1024, 1024, 1024, 0}; pg8::StaticOrder S; S.init(16384, 1024, (int)gridDim.x, (int)blockIdx.x);
                pg8::PanelRms st{(unsigned*)(a.ws + WS_XB) + 32768 * 4, ctl + CW_PANEL + 8192, half * 64, RMS_EPS};
                pg8::EpiResFinal E{(const _Float16*)X1, MODV + 5 * 3072, P.out, P.final_norm, st, SEQ, 0};
                pg8::gemm_phase<pg8::EpiResFinal, pg8::StaticOrder, false, true>(L, g, S, E); __syncthreads(); }
        } else {
            pg8::Gemm g{T, (const bf16_t*)(a.ws + WS_WTOP), ML, 1024, 1024, 1024, 0}; pg8::StaticOrder S; S.init(ML, 1024, (int)gridDim.x, (int)blockIdx.x);
            pg8::EpiResM E{X1, MODV + 5 * 3072, P.out, SEQ, 0};
            pg8::gemm_phase<pg8::EpiResM, pg8::StaticOrder, true, true>(L, g, S, E); } } if (!fusedn) SEAM(13);
    if (IN(14) && !fusedn) { ph_final(P); }
#undef IN
#undef SEAM
}

#ifndef MK_PER_PHASE
#define MK_PER_PHASE 0
#endif
extern "C" void kernel_launch(void* const* d_in, const int* in_sizes, int n_in, void* d_out, int out_size, void* d_ws, size_t ws_size, hipStream_t stream) {
    static int grid = 0;
    if (grid == 0) {
        if (n_in != 24 || out_size != ML * DM || ws_size < WS_END) { fprintf(stderr, "kernel_launch: unexpected shapes n_in %d out %d ws %zu\n", n_in, out_size, ws_size); grid = -1; return; }
        int dev = 0, cus = 0;
        if (hipGetDevice(&dev) != hipSuccess || hipDeviceGetAttribute(&cus, hipDeviceAttributeMultiprocessorCount, dev) != hipSuccess) { grid = -1; return; }
        if (hipFuncSetAttribute((const void*)mk_fwd, hipFuncAttributeMaxDynamicSharedMemorySize, LDS_BYTES) != hipSuccess) { fprintf(stderr, "kernel_launch: hipFuncSetAttribute failed\n"); grid = -1; return; }
        grid = cus;
    }
    if (grid < 0) return;
    (void)hipMemsetAsync((char*)d_ws + WS_CTL, 0, CTL_ZERO_BYTES, stream);
    Args a{};
    for (int i = 0; i < 24; ++i) a.in[i] = (const float*)d_in[i];
    a.out = (float*)d_out; a.ws = (char*)d_ws;
#if MK_PER_PHASE
    for (int p = 0; p < N_PHASES; ++p) { a.ph_lo = p; a.ph_hi = p + 1; hipLaunchKernelGGL(mk_fwd, dim3(grid), dim3(NT), LDS_BYTES, stream, a); }
#else
    a.ph_lo = 0; a.ph_hi = N_PHASES;
    hipLaunchKernelGGL(mk_fwd, dim3(grid), dim3(NT), LDS_BYTES, stream, a);
#endif
}
```

```cpp
#include <hip/hip_runtime.h>
#include <cstdint>
#include <cstdio>

typedef unsigned short bf16_t;
#define LAS __attribute__((address_space(3)))
__device__ __forceinline__ float bf2f(bf16_t v) { return __uint_as_float(((unsigned)v) << 16); }
typedef float f32x2_c __attribute__((ext_vector_type(2))); typedef __bf16 bf16x2_c __attribute__((ext_vector_type(2)));
__device__ __forceinline__ unsigned pk2f(float lo, float hi) { f32x2_c v = {lo, hi}; return __builtin_bit_cast(unsigned, __builtin_convertvector(v, bf16x2_c)); }
__device__ __forceinline__ bf16_t f2bf(float f) { return (bf16_t)(pk2f(f, 0.f) & 0xffffu); }
__device__ __forceinline__ float siluf(float x) { return x * __builtin_amdgcn_rcpf(1.f + __expf(-x)); }
__device__ __forceinline__ float softplusf(float x) { return fmaxf(x, 0.f) + log1pf(__expf(-fabsf(x))); }

constexpr int NB = 4, SEQ = 8192, DM = 1024, CTXL = 256, NKEY = SEQ + CTXL;
constexpr int ML = NB * SEQ, MC = NB * CTXL, MT = ML + MC;
constexpr int PN = 2560;
constexpr int C_QA = 0, C_KVA = 384, C_KPE = 640, C_GA = 672, C_Z = 1184, C_XBC = 1696, C_DT = 2464;
constexpr float RMS_EPS = 1e-6f;
constexpr float QSCALE = 0.10206207261596575f * 1.4426950408889634f;
constexpr int NT = 512;

constexpr size_t MiB = 1u << 20;
constexpr size_t WS_CTL = 0, CTL_ZERO_BYTES = 128 * 1024;
constexpr size_t WS_MODV = 1 * MiB;
constexpr size_t WS_COS = 3 * MiB, WS_SIN = 3 * MiB + 512 * 1024;
constexpr size_t WS_WT1 = 4 * MiB;
constexpr size_t WS_WTQ = 9 * MiB;
constexpr size_t WS_WTKV = 10 * MiB;
constexpr size_t WS_WTO = 11 * MiB;
constexpr size_t WS_WTP = 13 * MiB;
constexpr size_t WS_WTL = 17 * MiB;
constexpr size_t WS_WTOP = 18 * MiB;
constexpr size_t WS_H = 20 * MiB;
constexpr size_t WS_PROJ = 86 * MiB;
constexpr size_t WS_SS = 251 * MiB;
constexpr size_t WS_DT = 254 * MiB;
constexpr size_t WS_Q = 257 * MiB;
constexpr size_t WS_K = 305 * MiB;
constexpr size_t WS_V = 355 * MiB;
constexpr size_t WS_U = 388 * MiB;
constexpr size_t WS_DTS = 438 * MiB;
constexpr size_t WS_SST = 441 * MiB;
constexpr size_t WS_CD = 1 * MiB + 512 * 1024;
constexpr size_t WS_END = 507 * MiB;
constexpr int CW_PANEL = 16384;
constexpr size_t WS_XB = 2 * MiB;
constexpr int CW_BAR = 4096;

constexpr int RING_BYTES = 131072, LDSCTL_OFF = RING_BYTES, MISC_OFF = LDSCTL_OFF + 320, LDS_BYTES = 147456;


extern __shared__ __attribute__((aligned(16))) unsigned char g_lds[];
constexpr int WIDTAB_OFF = LDSCTL_OFF + 64;
__device__ __forceinline__ int lane_id_() { return (int)__builtin_amdgcn_mbcnt_hi(~0u, __builtin_amdgcn_mbcnt_lo(~0u, 0u)); }
__device__ __forceinline__ int hw_slot_() { return (int)(__builtin_amdgcn_s_getreg((5 << 11) | 4) & 0x3Fu); }
__device__ __forceinline__ int wave_id_() { return __builtin_amdgcn_readfirstlane(((volatile LAS int*)((LAS unsigned char*)g_lds + WIDTAB_OFF))[hw_slot_()]); }
#define TIDX (wave_id_() * 64 + lane_id_())

#define XB_TMO      128
#define XB_XCNT(j)  (256  + 64 * (j))
#define XB_XSUB(j)  (1280 + 64 * (j))
#define XB_XGEN(j)  (2304 + 64 * (j))
#define XB_TOP      3328
#define XB_TOPGEN   3392
#define XCD_BAR_WORDS 3456
#define XB_SPIN_CAP (1u << 18)
__device__ __forceinline__ unsigned xb_ld(unsigned* p)              { return __hip_atomic_load(p, __ATOMIC_RELAXED, __HIP_MEMORY_SCOPE_AGENT); }
__device__ __forceinline__ unsigned xb_add(unsigned* p, unsigned v) { return __hip_atomic_fetch_add(p, v, __ATOMIC_RELAXED, __HIP_MEMORY_SCOPE_AGENT); }
__device__ __forceinline__ unsigned xb_xcc_id() { return (unsigned)__builtin_amdgcn_s_getreg((3 << 11) | 20) & 0xFu; }
#define XB_SPIN(cond, bar) do { unsigned _sp = 0; while (cond) { __builtin_amdgcn_s_sleep(1); \
    if ((++_sp & 255u) == 0u) { if (xb_ld(&(bar)[XB_TMO])) break; if (_sp > XB_SPIN_CAP) { atomicAdd(&(bar)[XB_TMO], 1u); break; } } } } while (0)
struct XcdBarrier { unsigned* bar; unsigned x; volatile LAS unsigned* st; };
__device__ __forceinline__ XcdBarrier xcd_barrier_post(unsigned* bar, volatile LAS unsigned* st) {
    XcdBarrier b; b.bar = bar; b.x = xb_xcc_id(); b.st = st;
    if (TIDX == 0) (void)xb_add(&bar[XB_XCNT(b.x)], 1u);
    return b;
}
__device__ __forceinline__ void xcd_barrier_complete(unsigned* bar, unsigned x, unsigned& nloc, unsigned& nx) {
    const unsigned G = gridDim.x * gridDim.y * gridDim.z;
    unsigned sum, cnt, mine, sp = 0u;
    for (;;) {
        sum = 0u; cnt = 0u; mine = 0u;
#pragma unroll
        for (unsigned j = 0; j < 16; ++j) { const unsigned c = xb_ld(&bar[XB_XCNT(j)]); sum += c; cnt += (c > 0u) ? 1u : 0u; mine = (j == x) ? c : mine; }
        if (sum == G) break;
        __builtin_amdgcn_s_sleep(1);
        if ((++sp & 255u) == 0u) { if (xb_ld(&bar[XB_TMO])) break; if (sp > XB_SPIN_CAP) { atomicAdd(&bar[XB_TMO], 1u); break; } }
    }
    nloc = mine > 0u ? mine : 1u; nx = cnt > 0u ? cnt : 1u;
}
__device__ __forceinline__ void xcd_barrier(const XcdBarrier& b) {
    asm volatile("s_waitcnt vmcnt(0)" ::: "memory");
    __syncthreads();
    if (TIDX == 0) {
        unsigned* bar = b.bar;
        __builtin_amdgcn_s_waitcnt(0);
        unsigned nloc = b.st[0], nx = b.st[1];
        if (nloc == 0u) { xcd_barrier_complete(bar, b.x, nloc, nx); b.st[0] = nloc; b.st[1] = nx; }
        const unsigned old = xb_add(&bar[XB_XSUB(b.x)], 1u);
        const unsigned gen = old / nloc;
        if (old + 1u == (gen + 1u) * nloc) {
            __builtin_amdgcn_fence(__ATOMIC_RELEASE, "agent");
            asm volatile("s_waitcnt vmcnt(0)" ::: "memory");
            const unsigned og = xb_add(&bar[XB_TOP], 1u);
            const unsigned tg = og / nx;
            if (og + 1u == (tg + 1u) * nx) xb_add(&bar[XB_TOPGEN], 1u);
            else XB_SPIN(xb_ld(&bar[XB_TOPGEN]) == tg, bar);
            __builtin_amdgcn_fence(__ATOMIC_ACQUIRE, "agent");
            xb_add(&bar[XB_XGEN(b.x)], 1u);
            asm volatile("s_waitcnt vmcnt(0)" ::: "memory");
        } else {
            XB_SPIN(xb_ld(&bar[XB_XGEN(b.x)]) == gen, bar);
            __builtin_amdgcn_fence(__ATOMIC_ACQUIRE, "agent");
            asm volatile("s_waitcnt vmcnt(0)" ::: "memory");
        }
    }
    __syncthreads();
}

__device__ __forceinline__ void row_info(int row, int& b, int& t, bool& isctx) {
    if (row < ML) { b = row / SEQ; t = row % SEQ; isctx = false; } else { int rc = row - ML; b = rc / CTXL; t = rc % CTXL; isctx = true; }
}
__device__ __forceinline__ float wave_sum(float v) {
#define WS_SWZ(x, k) __int_as_float(__builtin_amdgcn_ds_swizzle(__float_as_int(x), 0x1F | ((k) << 10)))
    v += WS_SWZ(v, 1); v += WS_SWZ(v, 2); v += WS_SWZ(v, 4); v += WS_SWZ(v, 8); v += WS_SWZ(v, 16);
#undef WS_SWZ
    auto rr = __builtin_amdgcn_permlane32_swap(__float_as_uint(v), __float_as_uint(v), false, false);
    return __uint_as_float(rr[0]) + __uint_as_float(rr[1]);
}
typedef float f32x4 __attribute__((ext_vector_type(4)));
#define GSTRIDE(idx, n) for (long idx = (long)blockIdx.x * NT + TIDX; idx < (long)(n); idx += (long)gridDim.x * NT)

namespace pg8 {
#define PG8_LAS __attribute__((address_space(3)))
typedef unsigned short bf16_t;
typedef short bf16x8 __attribute__((ext_vector_type(8)));
typedef float f32x4 __attribute__((ext_vector_type(4)));
typedef unsigned u32x4 __attribute__((ext_vector_type(4)));
constexpr int BM = 256, BK = 64, HALF = 128, HTB = HALF * BK * 2  , STAGE_BYTES = 8 * HTB, NXCD = 8, WGM = 8;

__host__ __device__ __forceinline__ int lds_byte(int r, int c) { const int st = (r >> 4) * 2 + (c >> 5), rr = r & 15, cc = c & 31, ob = rr * 64 + cc * 2; return st * 1024 + (ob ^ (((ob >> 9) & 1) << 5)); }
__host__ __device__ __forceinline__ void stage_rc(int b, int& R, int& C) { const int st = b / 1024, sb = b % 1024, swz = sb ^ (((sb >> 9) & 1) << 5); R = (st >> 1) * 16 + swz / 64; C = (st & 1) * 32 + (swz % 64) / 2; }
__host__ __device__ __forceinline__ int perm32(int rho) { const int n = rho >> 4, i = rho & 15; return 8 * (i >> 2) + 4 * n + (i & 3); }

struct Unit { int pm, pn; };
struct Gemm { const bf16_t* A; const bf16_t* Bt; int M, N, K, lda, a_pn_off; };

struct StaticOrder {
    int nM, nN, nwg, G, c;
    __host__ __device__ void init(int M, int N, int G_, int c_) { nM = M / BM; nN = N / BM; nwg = nM * nN; G = G_; c = c_; }
    __host__ __device__ bool next(int i, Unit& u) const {
        const long L = (long)i * G + c; if (L >= nwg) return false;
        int wgid = (int)L; { const int q = nwg / NXCD, r = nwg % NXCD, xcd = wgid % NXCD, off = wgid / NXCD; wgid = (xcd < r ? xcd * (q + 1) : r * (q + 1) + (xcd - r) * q) + off; }
        const int nig = WGM * nN, gid = wgid / nig, fm = gid * WGM, gsz = (nM - fm) < WGM ? (nM - fm) : WGM;
        u.pm = fm + ((wgid % nig) % gsz); u.pn = (wgid % nig) / gsz; return true;
    }
    __device__ __forceinline__ void a_ready(const Unit&) const {}
    __device__ __forceinline__ void done(const Unit&) const {}
};

__device__ __forceinline__ unsigned cvt_pk_bf16(float lo, float hi) { unsigned r; asm volatile("v_cvt_pk_bf16_f32 %0, %1, %2" : "=v"(r) : "v"(lo), "v"(hi)); return r; }
typedef float f32x2 __attribute__((ext_vector_type(2)));
__device__ __forceinline__ f32x2 gelu_pk(f32x2 v) {
    const f32x2 av = __builtin_elementwise_abs(v), d = av * 0.2316418882f + 1.0f;
    f32x2 t; t.x = __builtin_amdgcn_rcpf(d.x); t.y = __builtin_amdgcn_rcpf(d.y);
    f32x2 q = t * 0.5307027145f + (-0.7265760135f); q = q * t + 0.7107068705f; q = q * t + (-0.142248368f); q = q * t + 0.127414796f; q = q * t;
    const f32x2 s = (v * v) * (-0.72134752044f);
    f32x2 e; e.x = __builtin_amdgcn_exp2f(s.x); e.y = __builtin_amdgcn_exp2f(s.y);
    const f32x2 m = v * (q * e), r = v - m;
    f32x2 o; o.x = v.x < 0.f ? m.x : r.x; o.y = v.y < 0.f ? m.y : r.y; return o;
}

template <int ACT  > struct EpiBf16 {
    static constexpr bool PERM = true, AFTER_DRAIN = false; static_assert(ACT == 0 || ACT == 1, "EpiBf16: ACT is 0 (none) or 1 (gelu_pk)");
    bf16_t* O; int ldc; const float* bias; int split_cols; size_t split_stride; float scale0;
    __device__ __forceinline__ void operator()(const f32x4 (&acc)[2][2][4][2], const Unit& u, int wr, int wc, int fr, int fq) const {
        const int row0 = u.pm * BM + wr * 64 + fr; int colt = u.pn * BM; bf16_t* base = O;
        float sc = 1.f; if (split_cols) { const int t = colt / split_cols; base += (size_t)t * split_stride; colt -= t * split_cols; if (t == 0) sc = scale0; }
        const int col0 = colt + wc * 32 + 8 * fq, bcol0 = u.pn * BM + wc * 32 + 8 * fq;
        f32x4 bv[2][2];
#pragma unroll
        for (int bj = 0; bj < 2; ++bj)
#pragma unroll
            for (int n = 0; n < 2; ++n) bv[bj][n] = bias ? *(const f32x4*)(bias + bcol0 + bj * HALF + 4 * n) : (f32x4){0.f, 0.f, 0.f, 0.f};
#pragma unroll
        for (int ai = 0; ai < 2; ++ai)
#pragma unroll
            for (int m = 0; m < 4; ++m) { bf16_t* rowp = base + (size_t)(row0 + ai * HALF + m * 16) * ldc + col0;
#pragma unroll
                for (int bj = 0; bj < 2; ++bj) { f32x4 v0 = acc[ai][bj][m][0] + bv[bj][0], v1 = acc[ai][bj][m][1] + bv[bj][1];
                    if (ACT == 1) { f32x2 a = gelu_pk((f32x2){v0[0], v0[1]}), b = gelu_pk((f32x2){v0[2], v0[3]}), c = gelu_pk((f32x2){v1[0], v1[1]}), d = gelu_pk((f32x2){v1[2], v1[3]});
                        v0 = (f32x4){a.x, a.y, b.x, b.y}; v1 = (f32x4){c.x, c.y, d.x, d.y}; }
                    v0 = v0 * sc; v1 = v1 * sc; u32x4 w; w.x = cvt_pk_bf16(v0[0], v0[1]); w.y = cvt_pk_bf16(v0[2], v0[3]); w.z = cvt_pk_bf16(v1[0], v1[1]); w.w = cvt_pk_bf16(v1[2], v1[3]);
                    *(u32x4*)(rowp + bj * HALF) = w; } }
    }
};

struct EpiProjM { static constexpr bool PERM = true, AFTER_DRAIN = false;
    bf16_t* O; float* SS; float* DT;
    __device__ __forceinline__ void operator()(const f32x4 (&acc)[2][2][4][2], const Unit& u, int wr, int wc, int fr, int fq) const {
        const int row0 = u.pm * BM + wr * 64 + fr, colt = u.pn * BM, col0 = colt + wc * 32 + 8 * fq;
#pragma unroll
        for (int ai = 0; ai < 2; ++ai)
#pragma unroll
            for (int m = 0; m < 4; ++m) { const int row = row0 + ai * HALF + m * 16; bf16_t* rowp = O + (size_t)row * 2560 + col0;
#pragma unroll
                for (int bj = 0; bj < 2; ++bj) { const f32x4 v0 = acc[ai][bj][m][0], v1 = acc[ai][bj][m][1];
                    u32x4 w; w.x = cvt_pk_bf16(v0[0], v0[1]); w.y = cvt_pk_bf16(v0[2], v0[3]); w.z = cvt_pk_bf16(v1[0], v1[1]); w.w = cvt_pk_bf16(v1[2], v1[3]);
                    *(u32x4*)(rowp + bj * HALF) = w;
                    const int cs = colt + bj * HALF + wc * 32;
                    if (cs < 640) { float q = (v0[0] * v0[0] + v0[1] * v0[1]) + (v0[2] * v0[2] + v0[3] * v0[3]) + (v1[0] * v1[0] + v1[1] * v1[1]) + (v1[2] * v1[2] + v1[3] * v1[3]);
                        q += __shfl_xor(q, 16); q += __shfl_xor(q, 32); if (fq == 0) SS[(size_t)row * 20 + (cs >> 5)] = q; }
                    if (cs == 2464 && fq < 2) { *(f32x4*)(DT + (size_t)row * 16 + 8 * fq) = v0; *(f32x4*)(DT + (size_t)row * 16 + 8 * fq + 4) = v1; } } }
    }
};

struct EpiQ { static constexpr bool PERM = true, AFTER_DRAIN = false;
    bf16_t* Q; const float* SS; const float* COS; const float* SIN;
    __device__ __forceinline__ void operator()(const f32x4 (&acc)[2][2][4][2], const Unit& u, int wr, int wc, int fr, int fq) const {
        asm volatile("" : "+v"(fr), "+v"(fq));
        const int row0 = u.pm * BM + wr * 64 + fr, colt = u.pn * BM;
#pragma unroll
        for (int ai = 0; ai < 2; ++ai)
#pragma unroll
            for (int m = 0; m < 4; ++m) { const int row = row0 + ai * HALF + m * 16; const int b = row >> 13, t = row & 8191;
                const f32x4 s0 = *(const f32x4*)(SS + (size_t)row * 20), s1 = *(const f32x4*)(SS + (size_t)row * 20 + 4), s2 = *(const f32x4*)(SS + (size_t)row * 20 + 8);
                const float ssq = ((s0[0] + s0[1]) + (s0[2] + s0[3])) + ((s1[0] + s1[1]) + (s1[2] + s1[3])) + ((s2[0] + s2[1]) + (s2[2] + s2[3]));
                const float rstd = rsqrtf(ssq * (1.f / 384.f) + 1e-6f);
#pragma unroll
                for (int bj = 0; bj < 2; ++bj) { const int cs = colt + bj * HALF + wc * 32, c0 = cs + 8 * fq; const int h = c0 / 96, j = c0 - h * 96;
                    float v[8];
#pragma unroll
                    for (int i = 0; i < 4; ++i) { v[i] = acc[ai][bj][m][0][i] * rstd; v[4 + i] = acc[ai][bj][m][1][i] * rstd; }
                    if ((cs % 96) == 64) {
                        const int jj0 = 8 * (fq & 1);
                        const f32x4 c0v = *(const f32x4*)(COS + t * 16 + jj0), c1v = *(const f32x4*)(COS + t * 16 + jj0 + 4), s0v = *(const f32x4*)(SIN + t * 16 + jj0), s1v = *(const f32x4*)(SIN + t * 16 + jj0 + 4);
#pragma unroll
                        for (int i = 0; i < 8; ++i) { const float pv = __shfl_xor(v[i], 32); const float cc = i < 4 ? c0v[i & 3] : c1v[i & 3], sn = i < 4 ? s0v[i & 3] : s1v[i & 3];
                            v[i] = fq < 2 ? v[i] * cc - pv * sn : v[i] * cc + pv * sn; }
                    }
                    u32x4 w; w.x = cvt_pk_bf16(v[0], v[1]); w.y = cvt_pk_bf16(v[2], v[3]); w.z = cvt_pk_bf16(v[4], v[5]); w.w = cvt_pk_bf16(v[6], v[7]);
                    *(u32x4*)(Q + ((size_t)(b * 8 + h) * 8192 + t) * 96 + j) = w; }
                asm volatile("" ::: "memory"); }
    }
};
struct EpiKV { static constexpr bool PERM = true, AFTER_DRAIN = false;
    bf16_t* Kb; bf16_t* Vb; const float* SS;
    __device__ __forceinline__ void operator()(const f32x4 (&acc)[2][2][4][2], const Unit& u, int wr, int wc, int fr, int fq) const {
        asm volatile("" : "+v"(fr), "+v"(fq));
        const int colt = u.pn * BM; int b, key0; if (u.pm < 128) { b = u.pm >> 5; key0 = 256 + (u.pm & 31) * 256; } else { b = u.pm - 128; key0 = 0; }
        float rs[2][4];
#pragma unroll
        for (int ai = 0; ai < 2; ++ai) { f32x4 t[4][2];
#pragma unroll
            for (int m = 0; m < 4; ++m) { const float* sp = SS + (size_t)(u.pm * BM + wr * 64 + fr + ai * HALF + m * 16) * 20 + 12; t[m][0] = *(const f32x4*)sp; t[m][1] = *(const f32x4*)(sp + 4); }
#pragma unroll
            for (int m = 0; m < 4; ++m) { const f32x4 s0 = t[m][0], s1 = t[m][1];
                const float ssq = ((s0[0] + s0[1]) + (s0[2] + s0[3])) + ((s1[0] + s1[1]) + (s1[2] + s1[3]));
                rs[ai][m] = rsqrtf(ssq * (1.f / 256.f) + 1e-6f); }
            asm volatile("" ::: "memory"); }
#pragma unroll
        for (int ai = 0; ai < 2; ++ai)
#pragma unroll
            for (int m = 0; m < 4; ++m) { const int lr = wr * 64 + fr + ai * HALF + m * 16; const int key = key0 + lr;
                const float rstd = rs[ai][m];
#pragma unroll
                for (int bj = 0; bj < 2; ++bj) { const int c0 = colt + bj * HALF + wc * 32 + 8 * fq; const int h = c0 >> 7, j = c0 & 127; const size_t kr = (size_t)(b * 8 + h) * 8448 + key;
                    const f32x4 v0 = acc[ai][bj][m][0] * rstd, v1 = acc[ai][bj][m][1] * rstd;
                    u32x4 w; w.x = cvt_pk_bf16(v0[0], v0[1]); w.y = cvt_pk_bf16(v0[2], v0[3]); w.z = cvt_pk_bf16(v1[0], v1[1]); w.w = cvt_pk_bf16(v1[2], v1[3]);
                    if (wc < 2) *(u32x4*)(Kb + kr * 96 + j) = w; else *(u32x4*)(Vb + kr * 64 + (j - 64)) = w; }
                asm volatile("" ::: "memory"); }
    }
};
struct EpiPL { static constexpr bool PERM = true, AFTER_DRAIN = false;
    bf16_t* T; const bf16_t* UG;
    __device__ __forceinline__ void operator()(const f32x4 (&acc)[2][2][4][2], const Unit& u, int wr, int wc, int fr, int fq) const {
        const int row0 = u.pm * BM + wr * 64 + fr, col0 = u.pn * BM + wc * 32 + 8 * fq;
        u32x4 g8[2][4][2];
#pragma unroll
        for (int ai = 0; ai < 2; ++ai)
#pragma unroll
            for (int m = 0; m < 4; ++m)
#pragma unroll
                for (int bj = 0; bj < 2; ++bj) g8[ai][m][bj] = *(const u32x4*)(UG + (size_t)(row0 + ai * HALF + m * 16) * 2048 + 1024 + col0 + bj * HALF);
#pragma unroll
        for (int ai = 0; ai < 2; ++ai)
#pragma unroll
            for (int m = 0; m < 4; ++m) { const int row = row0 + ai * HALF + m * 16;
#pragma unroll
                for (int bj = 0; bj < 2; ++bj) { const int c0 = col0 + bj * HALF; const u32x4 gq = g8[ai][m][bj];
                    float v[8];
#pragma unroll
                    for (int i = 0; i < 4; ++i) { const float glo = __uint_as_float(gq[i] << 16), ghi = __uint_as_float(gq[i] & 0xffff0000u);
                        const float a0 = i < 2 ? acc[ai][bj][m][0][2 * i] : acc[ai][bj][m][1][2 * i - 4], a1 = i < 2 ? acc[ai][bj][m][0][2 * i + 1] : acc[ai][bj][m][1][2 * i - 3];
                        v[2 * i] = a0 * (glo * __builtin_amdgcn_rcpf(1.f + __expf(-glo))); v[2 * i + 1] = a1 * (ghi * __builtin_amdgcn_rcpf(1.f + __expf(-ghi))); }
                    u32x4 w; w.x = cvt_pk_bf16(v[0], v[1]); w.y = cvt_pk_bf16(v[2], v[3]); w.z = cvt_pk_bf16(v[4], v[5]); w.w = cvt_pk_bf16(v[6], v[7]);
                    *(u32x4*)(T + (size_t)row * 1024 + c0) = w; } }
    }
};
struct EpiResM { static constexpr bool PERM = false, AFTER_DRAIN = false;
    const float* res; const float* gate; float* out; int rows_per_batch; int pad;
    __device__ __forceinline__ void operator()(const f32x4 (&acc)[2][2][4][2], const Unit& u, int wr, int wc, int fr, int fq) const {
        const int row0 = u.pm * BM + wr * 64 + fr, col0 = u.pn * BM + wc * 32 + 4 * fq; const int b = (u.pm * BM) / rows_per_batch;
        f32x4 gv[2][2];
#pragma unroll
        for (int bj = 0; bj < 2; ++bj)
#pragma unroll
            for (int n = 0; n < 2; ++n) gv[bj][n] = *(const f32x4*)(gate + b * 3072 + 2048 + col0 + bj * HALF + n * 16);
#pragma unroll
        for (int ai = 0; ai < 2; ++ai)
#pragma unroll
            for (int m = 0; m < 4; ++m) { const size_t off = (size_t)(row0 + ai * HALF + m * 16) * 1024 + col0;
#pragma unroll
                for (int bj = 0; bj < 2; ++bj)
#pragma unroll
                    for (int n = 0; n < 2; ++n) { const f32x4 r = *(const f32x4*)(res + off + bj * HALF + n * 16); *(f32x4*)(out + off + bj * HALF + n * 16) = r + gv[bj][n] * acc[ai][bj][m][n]; }
                if (m == 3) asm volatile("" ::: "memory"); }
    }
};

struct PanelRms {
    unsigned* xbuf;
    unsigned* cnt;
    int pm_off; float eps;
    __device__ __forceinline__ void run(const f32x4 (&v)[2][2][4][2], const Unit& u, int wr, int wc, int fr, int fq, PG8_LAS unsigned char* lds, int wid, int lane) const { publish(v, u, wr, wc, fr, fq, lds, wid, lane); collect(u, lds, wid, lane); }
    __device__ __forceinline__ void publish(const f32x4 (&v)[2][2][4][2], const Unit& u, int wr, int wc, int fr, int fq, PG8_LAS unsigned char* lds, int wid, int lane) const {
        PG8_LAS float* Pq = (PG8_LAS float*)lds;
        PG8_LAS float* S = (PG8_LAS float*)(lds + 8192);
        const int gpm = u.pm + pm_off;
#pragma unroll
        for (int ai = 0; ai < 2; ++ai)
#pragma unroll
            for (int m = 0; m < 4; ++m) { float q = 0.f;
#pragma unroll
                for (int bj = 0; bj < 2; ++bj)
#pragma unroll
                    for (int n = 0; n < 2; ++n) { const f32x4 x = v[ai][bj][m][n]; q += (x[0] * x[0] + x[1] * x[1]) + (x[2] * x[2] + x[3] * x[3]); }
                q += __shfl_xor(q, 16); q += __shfl_xor(q, 32);
                if (fq == 0) Pq[(ai * HALF + wr * 64 + m * 16 + fr) * 4 + wc] = q; }
        asm volatile("s_waitcnt lgkmcnt(0)" ::: "memory"); __builtin_amdgcn_s_barrier(); asm volatile("" ::: "memory");
        const int row = wid * 32 + (lane & 31);
        if (lane < 32) { const float sq = (Pq[row * 4 + 0] + Pq[row * 4 + 1]) + (Pq[row * 4 + 2] + Pq[row * 4 + 3]);
            __hip_atomic_store(xbuf + ((size_t)(gpm * BM + row) * 4 + u.pn), __float_as_uint(sq), __ATOMIC_RELAXED, __HIP_MEMORY_SCOPE_AGENT); }
        asm volatile("s_waitcnt vmcnt(0)" ::: "memory");
        if (lane == 0) __hip_atomic_fetch_add(cnt + 64 * gpm, 1u, __ATOMIC_RELAXED, __HIP_MEMORY_SCOPE_AGENT);
    }
    __device__ __forceinline__ void collect(const Unit& u, PG8_LAS unsigned char* lds, int wid, int lane) const {
        PG8_LAS float* S = (PG8_LAS float*)(lds + 8192);
        const int gpm = u.pm + pm_off; const int row = wid * 32 + (lane & 31);
        if (wid == 0) {
            for (unsigned sp = 0; sp < (1u << 22); ++sp) {
                if ((unsigned)__builtin_amdgcn_readfirstlane(__hip_atomic_load(cnt + 64 * gpm, __ATOMIC_RELAXED, __HIP_MEMORY_SCOPE_AGENT)) >= 32u) break;
                __builtin_amdgcn_s_sleep(2); }
            __builtin_amdgcn_fence(__ATOMIC_ACQUIRE, "agent");
        }
        asm volatile("s_waitcnt vmcnt(0) lgkmcnt(0)" ::: "memory"); __builtin_amdgcn_s_barrier(); asm volatile("" ::: "memory");
        if (lane < 32) { const unsigned* slot = xbuf + (size_t)(gpm * BM + row) * 4; float tot = 0.f;
#pragma unroll
            for (int t = 0; t < 4; ++t) tot += __uint_as_float(__hip_atomic_load(slot + t, __ATOMIC_RELAXED, __HIP_MEMORY_SCOPE_AGENT));
            S[row] = rsqrtf(tot * (1.f / 1024.f) + eps); }
        asm volatile("s_waitcnt lgkmcnt(0)" ::: "memory"); __builtin_amdgcn_s_barrier(); asm volatile("" ::: "memory");
    }
};
typedef _Float16 h16x4 __attribute__((ext_vector_type(4)));
struct EpiResNorm { static constexpr bool PERM = false, AFTER_DRAIN = true;
    const float* res; const float* gate; _Float16* X1; bf16_t* Hn; const float* nw; const float* modn; PanelRms st; int rows_per_batch; int pad;
    __device__ __forceinline__ void operator()(const f32x4 (&)[2][2][4][2], const Unit&, int, int, int, int) const {}
    __device__ __forceinline__ void fused(f32x4 (&acc)[2][2][4][2], const Unit& u, int wr, int wc, int fr, int fq, PG8_LAS unsigned char* lds, int wid, int lane) const {
        typedef unsigned u32x2v __attribute__((ext_vector_type(2)));
        const PG8_LAS float* S = (const PG8_LAS float*)(lds + 8192);
        const int grow0 = (u.pm + st.pm_off) * BM, col0 = u.pn * BM + wc * 32 + 4 * fq; const int b = grow0 / rows_per_batch;
#pragma unroll
        for (int bj = 0; bj < 2; ++bj)
#pragma unroll
            for (int n = 0; n < 2; ++n) { const f32x4 gv = *(const f32x4*)(gate + b * 3072 + 2048 + col0 + bj * HALF + n * 16);
#pragma unroll
                for (int ai = 0; ai < 2; ++ai)
#pragma unroll
                    for (int m = 0; m < 4; ++m) acc[ai][bj][m][n] *= gv; }
#pragma unroll
        for (int ai = 0; ai < 2; ++ai)
#pragma unroll
            for (int m = 0; m < 4; ++m) { const size_t off = (size_t)(grow0 + ai * HALF + wr * 64 + m * 16 + fr) * 1024 + col0;
#pragma unroll
                for (int bj = 0; bj < 2; ++bj)
#pragma unroll
                    for (int n = 0; n < 2; ++n) acc[ai][bj][m][n] += *(const f32x4*)(res + off + bj * HALF + n * 16);
                asm volatile("" : "+v"(acc[ai][0][m][0]), "+v"(acc[ai][0][m][1]), "+v"(acc[ai][1][m][0]), "+v"(acc[ai][1][m][1]));
                if (m == 3) asm volatile("" ::: "memory"); }
        f32x4 gn[2][2], shn[2][2];
#pragma unroll
        for (int bj = 0; bj < 2; ++bj)
#pragma unroll
            for (int n = 0; n < 2; ++n) { const int c = col0 + bj * HALF + n * 16;
                gn[bj][n] = *(const f32x4*)(nw + c) * (*(const f32x4*)(modn + b * 3072 + 1024 + c) + 1.f); shn[bj][n] = *(const f32x4*)(modn + b * 3072 + c); }
        st.publish(acc, u, wr, wc, fr, fq, lds, wid, lane);
#pragma unroll
        for (int ai = 0; ai < 2; ++ai)
#pragma unroll
            for (int m = 0; m < 4; ++m) { const size_t off = (size_t)(grow0 + ai * HALF + wr * 64 + m * 16 + fr) * 1024 + col0;
#pragma unroll
                for (int bj = 0; bj < 2; ++bj)
#pragma unroll
                    for (int n = 0; n < 2; ++n) *(h16x4*)(X1 + off + bj * HALF + n * 16) = __builtin_convertvector(acc[ai][bj][m][n], h16x4); }
        st.collect(u, lds, wid, lane);
#pragma unroll
        for (int ai = 0; ai < 2; ++ai)
#pragma unroll
            for (int m = 0; m < 4; ++m) { const int r = ai * HALF + wr * 64 + m * 16 + fr; const float rstd = S[r]; const size_t off = (size_t)(grow0 + r) * 1024 + col0;
#pragma unroll
                for (int bj = 0; bj < 2; ++bj)
#pragma unroll
                    for (int n = 0; n < 2; ++n) { const f32x4 x1 = acc[ai][bj][m][n];
                        const f32x4 o = x1 * rstd * gn[bj][n] + shn[bj][n];
                        u32x2v pk; pk.x = cvt_pk_bf16(o[0], o[1]); pk.y = cvt_pk_bf16(o[2], o[3]);
                        *(u32x2v*)(Hn + off + bj * HALF + n * 16) = pk; }
                asm volatile("" ::: "memory"); }
    }
};
struct EpiResFinal { static constexpr bool PERM = false, AFTER_DRAIN = true;
    const _Float16* res; const float* gate; float* out; const float* fw; PanelRms st; int rows_per_batch; int pad;
    __device__ __forceinline__ void operator()(const f32x4 (&)[2][2][4][2], const Unit&, int, int, int, int) const {}
    __device__ __forceinline__ void fused(f32x4 (&acc)[2][2][4][2], const Unit& u, int wr, int wc, int fr, int fq, PG8_LAS unsigned char* lds, int wid, int lane) const {
        const PG8_LAS float* S = (const PG8_LAS float*)(lds + 8192);
        const int grow0 = (u.pm + st.pm_off) * BM, col0 = u.pn * BM + wc * 32 + 4 * fq; const int b = grow0 / rows_per_batch;
#pragma unroll
        for (int bj = 0; bj < 2; ++bj)
#pragma unroll
            for (int n = 0; n < 2; ++n) { const f32x4 gv = *(const f32x4*)(gate + b * 3072 + 2048 + col0 + bj * HALF + n * 16);
#pragma unroll
                for (int ai = 0; ai < 2; ++ai)
#pragma unroll
                    for (int m = 0; m < 4; ++m) acc[ai][bj][m][n] *= gv; }
#pragma unroll
        for (int ai = 0; ai < 2; ++ai)
#pragma unroll
            for (int m = 0; m < 4; ++m) { const size_t off = (size_t)(grow0 + ai * HALF + wr * 64 + m * 16 + fr) * 1024 + col0;
#pragma unroll
                for (int bj = 0; bj < 2; ++bj)
#pragma unroll
                    for (int n = 0; n < 2; ++n) acc[ai][bj][m][n] += __builtin_convertvector(*(const h16x4*)(res + off + bj * HALF + n * 16), f32x4);
                asm volatile("" : "+v"(acc[ai][0][m][0]), "+v"(acc[ai][0][m][1]), "+v"(acc[ai][1][m][0]), "+v"(acc[ai][1][m][1]));
                if (m == 3) asm volatile("" ::: "memory"); }
        f32x4 fwv[2][2];
#pragma unroll
        for (int bj = 0; bj < 2; ++bj)
#pragma unroll
            for (int n = 0; n < 2; ++n) fwv[bj][n] = *(const f32x4*)(fw + col0 + bj * HALF + n * 16);
        st.run(acc, u, wr, wc, fr, fq, lds, wid, lane);
#pragma unroll
        for (int ai = 0; ai < 2; ++ai)
#pragma unroll
            for (int m = 0; m < 4; ++m) { const int r = ai * HALF + wr * 64 + m * 16 + fr; const float rstd = S[r]; const size_t off = (size_t)(grow0 + r) * 1024 + col0;
#pragma unroll
                for (int bj = 0; bj < 2; ++bj)
#pragma unroll
                    for (int n = 0; n < 2; ++n) *(f32x4*)(out + off + bj * HALF + n * 16) = acc[ai][bj][m][n] * rstd * fwv[bj][n];
                asm volatile("" ::: "memory"); }
    }
};
template <class Epi, class Sched, bool ALIGN_EPI = false, bool SP2 = false>
__device__ __forceinline__ void gemm_phase(PG8_LAS unsigned char* lds, const Gemm g, const Sched& S, const Epi& E) {
    int tid_ = TIDX; asm volatile("" : "+v"(tid_));
    const int tid = tid_, wid = __builtin_amdgcn_readfirstlane(tid >> 6), lane = tid & 63, wr = wid >> 2, wc = wid & 3, fr = lane & 15, fq = lane >> 4;
    const int K = g.K, nt = K / BK;
    unsigned voffA[2], voffB[2];
#pragma unroll
    for (int i = 0; i < 2; ++i) { int R, C; stage_rc(tid * 16 + i * 8192, R, C); const int Rb = Epi::PERM ? ((R & ~31) + perm32(R & 31)) : R;
        voffA[i] = (unsigned)(R * g.lda + C) * 2u; voffB[i] = (unsigned)(Rb * K + C) * 2u; }
    const unsigned kstep = (unsigned)(BK * 2);
    const unsigned hsA = (unsigned)HALF * g.lda * 2u, hsB = (unsigned)HALF * K * 2u;
    const unsigned tsA = 2 * hsA, tsB = 2 * hsB, apo = (unsigned)g.a_pn_off * 2u;
    const unsigned ldsw = (unsigned)wid * 1024u;
    const int aoff = lds_byte(wr * 64 + fr, fq * 8), boff = lds_byte(wc * 32 + fr, fq * 8);
#define PG8_SA(b, h) (((b) * 2 + (h)) * HTB)
#define PG8_SB(b, h) ((4 + (b) * 2 + (h)) * HTB)
#define PG8_STAGEX(rs, bufoff, goff, voff) do { _Pragma("unroll") for (int _i = 0; _i < 2; ++_i) \
        __builtin_amdgcn_raw_ptr_buffer_load_lds((rs), (PG8_LAS void*)(lds + (bufoff) + ldsw + _i * 8192), 16, (int)(voff)[_i], (int)(goff), 0, 0); } while (0)
#define PG8_STAGEA(bufoff, goff, voff) PG8_STAGEX(rsA, bufoff, goff, voff)
#define PG8_STAGEB(bufoff, goff, voff) PG8_STAGEX(rsB, bufoff, goff, voff)
#define PG8_LDA(dst, b, h) do { _Pragma("unroll") for (int m = 0; m < 4; ++m) _Pragma("unroll") for (int k = 0; k < 2; ++k) dst[m][k] = *(const PG8_LAS bf16x8*)(lds + PG8_SA(b, h) + aoff + m * 2048 + k * 1024); } while (0)
#define PG8_LDB(dst, b, h) do { _Pragma("unroll") for (int n = 0; n < 2; ++n) _Pragma("unroll") for (int k = 0; k < 2; ++k) dst[n][k] = *(const PG8_LAS bf16x8*)(lds + PG8_SB(b, h) + boff + n * 2048 + k * 1024); } while (0)
#define PG8_MMA(ai, bj, At, Bt) do { __builtin_amdgcn_s_setprio(1); _Pragma("unroll") for (int m = 0; m < 4; ++m) _Pragma("unroll") for (int n = 0; n < 2; ++n) _Pragma("unroll") for (int k = 0; k < 2; ++k) \
        acc[ai][bj][m][n] = __builtin_amdgcn_mfma_f32_16x16x32_bf16(Bt[n][k], At[m][k], acc[ai][bj][m][n], 0, 0, 0); __builtin_amdgcn_s_setprio(0); } while (0)
#define PG8_WAIT_V(n) asm volatile("s_waitcnt vmcnt(" #n ")" ::: "memory")
#define PG8_WAIT_L(n) asm volatile("s_waitcnt lgkmcnt(" #n ")" ::: "memory")
#define PG8_BAR __builtin_amdgcn_s_barrier()
#define PG8_SCHED __builtin_amdgcn_sched_barrier(0)
    Unit cur, nxt; int ui = 0;
    if (!S.next(0, cur)) return;
    f32x4 acc[2][2][4][2];
#pragma unroll
    for (int a = 0; a < 2; ++a)
#pragma unroll
        for (int b = 0; b < 2; ++b)
#pragma unroll
            for (int m = 0; m < 4; ++m)
#pragma unroll
                for (int n = 0; n < 2; ++n) acc[a][b][m][n] = (f32x4){0.f, 0.f, 0.f, 0.f};
    bf16x8 At[4][2], B0[2][2], B1[2][2];
    const __amdgpu_buffer_rsrc_t rsA = __builtin_amdgcn_make_buffer_rsrc((void*)g.A, 0, 0x7ffffff0, 0x00020000), rsB = __builtin_amdgcn_make_buffer_rsrc((void*)g.Bt, 0, 0x7ffffff0, 0x00020000);
    unsigned cA = (unsigned)cur.pm * tsA + (unsigned)cur.pn * apo, cB = (unsigned)cur.pn * tsB;
    S.a_ready(cur);
    if constexpr (SP2) {
        PG8_STAGEB(PG8_SB(0, 0), cB, voffB); PG8_STAGEB(PG8_SB(0, 1), cB + hsB, voffB); PG8_STAGEA(PG8_SA(0, 0), cA, voffA); PG8_STAGEA(PG8_SA(0, 1), cA + hsA, voffA);
        if (wr == 1) PG8_BAR;
        PG8_WAIT_V(2); PG8_BAR;
        PG8_STAGEB(PG8_SB(1, 0), cB + kstep, voffB); PG8_STAGEA(PG8_SA(1, 0), cA + kstep, voffA); PG8_STAGEB(PG8_SB(1, 1), cB + hsB + kstep, voffB);
        PG8_WAIT_V(6); PG8_BAR;
    } else {
        PG8_STAGEB(PG8_SB(0, 0), cB, voffB); PG8_STAGEA(PG8_SA(0, 0), cA, voffA); PG8_STAGEB(PG8_SB(0, 1), cB + hsB, voffB); PG8_STAGEA(PG8_SA(0, 1), cA + hsA, voffA);
        if (wr == 1) PG8_BAR;
        PG8_WAIT_V(4); PG8_BAR;
        PG8_STAGEB(PG8_SB(1, 0), cB + kstep, voffB); PG8_STAGEA(PG8_SA(1, 0), cA + kstep, voffA); PG8_STAGEB(PG8_SB(1, 1), cB + hsB + kstep, voffB);
        PG8_WAIT_V(6); PG8_BAR;
    }
    for (;;) {
        const bool has_next = S.next(ui + 1, nxt);
        const unsigned nA = has_next ? (unsigned)nxt.pm * tsA + (unsigned)nxt.pn * apo : cA, nB = has_next ? (unsigned)nxt.pn * tsB : cB;
        for (int t = 0; t < nt; t += 2) {
            const bool last = (t == nt - 2);
            const unsigned a1 = cA + (unsigned)(t + 1) * kstep;
            const unsigned a2 = last ? nA : cA + (unsigned)(t + 2) * kstep, b2 = last ? nB : cB + (unsigned)(t + 2) * kstep;
            const unsigned a3 = a2 + kstep, b3 = b2 + kstep;
            if (last && has_next) S.a_ready(nxt);
            if constexpr (SP2) {
            PG8_LDB(B0, 0, 0); PG8_LDB(B1, 0, 1); PG8_SCHED; PG8_LDA(At, 0, 0); PG8_STAGEA(PG8_SA(1, 1), a1 + hsA, voffA);
            PG8_WAIT_V(8); PG8_WAIT_L(0); PG8_BAR; PG8_MMA(0, 0, At, B0); PG8_MMA(0, 1, At, B1); PG8_BAR; PG8_SCHED;
            PG8_LDA(At, 0, 1); PG8_STAGEB(PG8_SB(0, 0), b2, voffB); PG8_STAGEB(PG8_SB(0, 1), b2 + hsB, voffB); PG8_STAGEA(PG8_SA(0, 0), a2, voffA);
            PG8_WAIT_V(8); PG8_WAIT_L(0); PG8_BAR; PG8_MMA(1, 0, At, B0); PG8_MMA(1, 1, At, B1); PG8_BAR; PG8_SCHED;
            PG8_LDB(B0, 1, 0); PG8_LDB(B1, 1, 1); PG8_SCHED; PG8_LDA(At, 1, 0); PG8_STAGEA(PG8_SA(0, 1), a2 + hsA, voffA);
            PG8_WAIT_V(8); PG8_WAIT_L(0); PG8_BAR; PG8_MMA(0, 0, At, B0); PG8_MMA(0, 1, At, B1); PG8_BAR; PG8_SCHED;
            PG8_LDA(At, 1, 1); PG8_STAGEB(PG8_SB(1, 0), b3, voffB); PG8_STAGEB(PG8_SB(1, 1), b3 + hsB, voffB); PG8_STAGEA(PG8_SA(1, 0), a3, voffA);
            PG8_WAIT_V(8); PG8_WAIT_L(0); PG8_BAR; PG8_MMA(1, 0, At, B0); PG8_MMA(1, 1, At, B1); PG8_BAR; PG8_SCHED;
            } else {
            PG8_LDB(B0, 0, 0); PG8_SCHED; PG8_LDA(At, 0, 0); PG8_STAGEA(PG8_SA(1, 1), a1 + hsA, voffA);
            PG8_WAIT_L(8); PG8_BAR; PG8_WAIT_L(0); PG8_MMA(0, 0, At, B0); PG8_BAR; PG8_SCHED;
            PG8_LDB(B1, 0, 1); PG8_STAGEB(PG8_SB(0, 0), b2, voffB);
            PG8_BAR; PG8_WAIT_L(0); PG8_MMA(0, 1, At, B1); PG8_BAR;
            PG8_LDA(At, 0, 1); PG8_STAGEA(PG8_SA(0, 0), a2, voffA);
            PG8_BAR; PG8_WAIT_L(0); PG8_MMA(1, 0, At, B0); PG8_BAR; PG8_SCHED;
            PG8_STAGEB(PG8_SB(0, 1), b2 + hsB, voffB);
            PG8_WAIT_V(6); PG8_BAR; PG8_MMA(1, 1, At, B1); PG8_BAR;
            PG8_LDB(B0, 1, 0); PG8_SCHED; PG8_LDA(At, 1, 0); PG8_STAGEA(PG8_SA(0, 1), a2 + hsA, voffA);
            PG8_WAIT_L(8); PG8_BAR; PG8_WAIT_L(0); PG8_MMA(0, 0, At, B0); PG8_BAR; PG8_SCHED;
            PG8_LDB(B1, 1, 1); PG8_STAGEB(PG8_SB(1, 0), b3, voffB);
            PG8_BAR; PG8_WAIT_L(0); PG8_MMA(0, 1, At, B1); PG8_BAR;
            PG8_LDA(At, 1, 1); PG8_STAGEA(PG8_SA(1, 0), a3, voffA);
            PG8_BAR; PG8_WAIT_L(0); PG8_MMA(1, 0, At, B0); PG8_BAR; PG8_SCHED;
            PG8_STAGEB(PG8_SB(1, 1), b3 + hsB, voffB);
            PG8_WAIT_V(6); PG8_BAR; PG8_MMA(1, 1, At, B1); PG8_BAR;
            }
        }
        if constexpr (ALIGN_EPI) { if (wr == 0) PG8_BAR; }
        if constexpr (!Epi::AFTER_DRAIN) { E(acc, cur, wr, wc, fr, fq); S.done(cur); }
        if (!has_next) break;
#pragma unroll
        for (int a = 0; a < 2; ++a)
#pragma unroll
            for (int b = 0; b < 2; ++b)
#pragma unroll
                for (int m = 0; m < 4; ++m)
#pragma unroll
                    for (int n = 0; n < 2; ++n) acc[a][b][m][n] = (f32x4){0.f, 0.f, 0.f, 0.f};
        cur = nxt; cA = nA; cB = nB; ++ui;
        if constexpr (ALIGN_EPI) { if (wr == 1) PG8_BAR; }
    }
    PG8_WAIT_V(0);
    if constexpr (!ALIGN_EPI) { if (wr == 0) PG8_BAR; }
    PG8_BAR;
    if constexpr (Epi::AFTER_DRAIN) { E.fused(acc, cur, wr, wc, fr, fq, lds, wid, lane); S.done(cur); }
#undef PG8_SA
#undef PG8_SB
#undef PG8_STAGEX
#undef PG8_STAGEA
#undef PG8_STAGEB
#undef PG8_LDA
#undef PG8_LDB
#undef PG8_MMA
#undef PG8_WAIT_V
#undef PG8_WAIT_L
#undef PG8_BAR
#undef PG8_SCHED
}
}


namespace attn {
using bf16x8 = __attribute__((ext_vector_type(8))) short;
using s16x4  = __attribute__((ext_vector_type(4))) short;
using f32x16 = __attribute__((ext_vector_type(16))) float;
using u32x4  = __attribute__((ext_vector_type(4))) unsigned;
constexpr int DQK = 96, DV = 64, NW = 8, QBLK = 32, KVBLK = 64;
constexpr float THR = 8.f;
constexpr int SHM_V = KVBLK * DV * 2, SHM_K = KVBLK * 256;
constexpr int SHM_ATTN = 2 * SHM_V + 2 * SHM_K + NW * 64 * 4;
#define AT_KSWZ(row, colB) ((row) * 256 + ((colB) ^ (((row) & 7) << 4)))
#define AT_SBAR() __builtin_amdgcn_sched_barrier(0)
__device__ __forceinline__ int crow(int r, int hi) { return (r & 3) + 8 * (r >> 2) + 4 * hi; }
__device__ __forceinline__ unsigned cvtpk(float lo, float hi) { unsigned r; asm volatile("v_cvt_pk_bf16_f32 %0, %1, %2" : "=v"(r) : "v"(lo), "v"(hi)); return r; }
__device__ __forceinline__ float rowmax32(const f32x16& p0, const f32x16& p1) {
  float a = fmaxf(fmaxf(p0[0], p0[1]), p1[0]), b = fmaxf(fmaxf(p0[2], p0[3]), p1[1]); a = fmaxf(fmaxf(a, p1[2]), p1[3]);
#pragma unroll
  for (int r = 4; r < 16; r += 4) { a = fmaxf(fmaxf(a, p0[r]), p0[r + 1]); b = fmaxf(fmaxf(b, p0[r + 2]), p0[r + 3]); a = fmaxf(fmaxf(a, p1[r]), p1[r + 1]); b = fmaxf(fmaxf(b, p1[r + 2]), p1[r + 3]); }
  float pm = fmaxf(a, b);
  auto rr = __builtin_amdgcn_permlane32_swap(__float_as_uint(pm), __float_as_uint(pm), false, false);
  return fmaxf(__uint_as_float(rr[0]), __uint_as_float(rr[1]));
}
template <int VAR, bool FIRST> __device__ __forceinline__ void partialSM(f32x16& p0, f32x16& p1, float& m_reg, f32x16& negm, float& alpha) {
  const float pmax = rowmax32(p0, p1);
  alpha = 1.f;
  if (FIRST || !__builtin_expect(__all(pmax <= THR), 1)) {
    const float dl = FIRST ? pmax : fmaxf(pmax, 0.f);
    m_reg += dl; alpha = FIRST ? 0.f : __builtin_amdgcn_exp2f(-dl);
#pragma unroll
    for (int r = 0; r < 16; ++r) { p0[r] -= dl; p1[r] -= dl; negm[r] = -m_reg; }
  }
#pragma unroll
  for (int r = 0; r < 16; ++r) p0[r] = VAR == 2 ? p0[r] * 0.5f : __builtin_amdgcn_exp2f(p0[r]);
}
template <int VAR> __device__ __forceinline__ void finishSM(f32x16& p0, f32x16& p1, float alpha, float& l_reg, bf16x8& pa0, bf16x8& pa1, bf16x8& pa2, bf16x8& pa3) {
#pragma unroll
  for (int r = 0; r < 16; ++r) p1[r] = VAR == 2 ? p1[r] * 0.5f : __builtin_amdgcn_exp2f(p1[r]);
  float ps = 0;
#pragma unroll
  for (int r = 0; r < 16; ++r) ps += p0[r];
#pragma unroll
  for (int r = 0; r < 16; ++r) ps += p1[r];
  { auto rr = __builtin_amdgcn_permlane32_swap(__float_as_uint(ps), __float_as_uint(ps), false, false);
    ps = __uint_as_float(rr[0]) + __uint_as_float(rr[1]); }
  l_reg = l_reg * alpha + ps;
#define AT_PK4(P, BASE, OUT) do { unsigned a0 = cvtpk(P[BASE + 0], P[BASE + 1]), a1 = cvtpk(P[BASE + 2], P[BASE + 3]);   \
    unsigned b0 = cvtpk(P[BASE + 4], P[BASE + 5]), b1 = cvtpk(P[BASE + 6], P[BASE + 7]);                              \
    auto r0 = __builtin_amdgcn_permlane32_swap(a0, b0, false, false); auto r1 = __builtin_amdgcn_permlane32_swap(a1, b1, false, false); \
    u32x4 w = {r0[0], r1[0], r0[1], r1[1]}; OUT = *reinterpret_cast<bf16x8*>(&w); } while (0)
  AT_PK4(p0, 0, pa0); AT_PK4(p0, 8, pa1); AT_PK4(p1, 0, pa2); AT_PK4(p1, 8, pa3);
#undef AT_PK4
}
__device__ __forceinline__ void qkt(f32x16& p0, f32x16& p1, const char* Ks, const bf16x8* qr, int r32, int hi) {
  p0 = f32x16{}; p1 = f32x16{};
#pragma unroll
  for (int d0 = 0; d0 < DQK / 16; ++d0) { int cb = (d0 * 16 + hi * 8) * 2;
    bf16x8 b0 = *reinterpret_cast<const bf16x8*>(Ks + AT_KSWZ(r32, cb));
    bf16x8 b1 = *reinterpret_cast<const bf16x8*>(Ks + AT_KSWZ(32 + r32, cb));
    p0 = __builtin_amdgcn_mfma_f32_32x32x16_bf16(b0, qr[d0], p0, 0, 0, 0);
    p1 = __builtin_amdgcn_mfma_f32_32x32x16_bf16(b1, qr[d0], p1, 0, 0, 0); }
}
__device__ __forceinline__ int v_st(int k, int c) { const int kk = (k & ~0xC) | ((k & 4) << 1) | ((k & 8) >> 1); return ((kk >> 3) * 2 + (c >> 5)) * 512 + ((kk & 7) * 32 + (c & 31)) * 2; }
__device__ __forceinline__ int v_rd_base(int lane) { return ((lane & 3) << 3) | (((lane >> 2) & 3) << 6) | (((lane >> 4) & 1) << 5) | (((lane >> 5) & 1) << 8); }
constexpr int v_rd_off(int d0, int ks, int half) { return d0 * 512 + ks * 2048 + half * 1024; }
template <int OFF> __device__ __forceinline__ s16x4 tr_read(int vb) {
  s16x4 r; asm volatile("ds_read_b64_tr_b16 %0, %1 offset:%2" : "=&v"(r) : "v"(vb), "i"(OFF) : "memory"); return r;
}
template <int D0> __device__ __forceinline__ void pv_one(f32x16& od, int vb, bf16x8 pa0, bf16x8 pa1, bf16x8 pa2, bf16x8 pa3) {
  const s16x4 l0 = tr_read<v_rd_off(D0, 0, 0)>(vb), h0 = tr_read<v_rd_off(D0, 0, 1)>(vb), l1 = tr_read<v_rd_off(D0, 1, 0)>(vb), h1 = tr_read<v_rd_off(D0, 1, 1)>(vb);
  const s16x4 l2 = tr_read<v_rd_off(D0, 2, 0)>(vb), h2 = tr_read<v_rd_off(D0, 2, 1)>(vb), l3 = tr_read<v_rd_off(D0, 3, 0)>(vb), h3 = tr_read<v_rd_off(D0, 3, 1)>(vb);
  asm volatile("s_waitcnt lgkmcnt(0)" ::: "memory"); AT_SBAR();
#define AT_PK(L, H) (bf16x8){L[0], L[1], L[2], L[3], H[0], H[1], H[2], H[3]}
  od = __builtin_amdgcn_mfma_f32_32x32x16_bf16(pa0, AT_PK(l0, h0), od, 0, 0, 0);
  od = __builtin_amdgcn_mfma_f32_32x32x16_bf16(pa1, AT_PK(l1, h1), od, 0, 0, 0);
  od = __builtin_amdgcn_mfma_f32_32x32x16_bf16(pa2, AT_PK(l2, h2), od, 0, 0, 0);
  od = __builtin_amdgcn_mfma_f32_32x32x16_bf16(pa3, AT_PK(l3, h3), od, 0, 0, 0);
}
struct VFrag { s16x4 l[2][4], h[2][4]; };
__device__ __forceinline__ void vfrag_issue(VFrag& f, int vb) {
  f.l[0][0] = tr_read<v_rd_off(0, 0, 0)>(vb); f.h[0][0] = tr_read<v_rd_off(0, 0, 1)>(vb); f.l[1][0] = tr_read<v_rd_off(1, 0, 0)>(vb); f.h[1][0] = tr_read<v_rd_off(1, 0, 1)>(vb);
  f.l[0][1] = tr_read<v_rd_off(0, 1, 0)>(vb); f.h[0][1] = tr_read<v_rd_off(0, 1, 1)>(vb); f.l[1][1] = tr_read<v_rd_off(1, 1, 0)>(vb); f.h[1][1] = tr_read<v_rd_off(1, 1, 1)>(vb);
  f.l[0][2] = tr_read<v_rd_off(0, 2, 0)>(vb); f.h[0][2] = tr_read<v_rd_off(0, 2, 1)>(vb); f.l[1][2] = tr_read<v_rd_off(1, 2, 0)>(vb); f.h[1][2] = tr_read<v_rd_off(1, 2, 1)>(vb);
  f.l[0][3] = tr_read<v_rd_off(0, 3, 0)>(vb); f.h[0][3] = tr_read<v_rd_off(0, 3, 1)>(vb); f.l[1][3] = tr_read<v_rd_off(1, 3, 0)>(vb); f.h[1][3] = tr_read<v_rd_off(1, 3, 1)>(vb);
}
__device__ __forceinline__ void pv_mma(f32x16* o, const VFrag& f, bf16x8 pa0, bf16x8 pa1, bf16x8 pa2, bf16x8 pa3) {
  asm volatile("s_waitcnt lgkmcnt(0)" ::: "memory"); AT_SBAR();
  o[0] = __builtin_amdgcn_mfma_f32_32x32x16_bf16(pa0, AT_PK(f.l[0][0], f.h[0][0]), o[0], 0, 0, 0); o[1] = __builtin_amdgcn_mfma_f32_32x32x16_bf16(pa0, AT_PK(f.l[1][0], f.h[1][0]), o[1], 0, 0, 0);
  o[0] = __builtin_amdgcn_mfma_f32_32x32x16_bf16(pa1, AT_PK(f.l[0][1], f.h[0][1]), o[0], 0, 0, 0); o[1] = __builtin_amdgcn_mfma_f32_32x32x16_bf16(pa1, AT_PK(f.l[1][1], f.h[1][1]), o[1], 0, 0, 0);
  o[0] = __builtin_amdgcn_mfma_f32_32x32x16_bf16(pa2, AT_PK(f.l[0][2], f.h[0][2]), o[0], 0, 0, 0); o[1] = __builtin_amdgcn_mfma_f32_32x32x16_bf16(pa2, AT_PK(f.l[1][2], f.h[1][2]), o[1], 0, 0, 0);
  o[0] = __builtin_amdgcn_mfma_f32_32x32x16_bf16(pa3, AT_PK(f.l[0][3], f.h[0][3]), o[0], 0, 0, 0); o[1] = __builtin_amdgcn_mfma_f32_32x32x16_bf16(pa3, AT_PK(f.l[1][3], f.h[1][3]), o[1], 0, 0, 0);
}
#undef AT_PK
__device__ __forceinline__ void pv_d0(f32x16* o, int vb, bf16x8 pa0, bf16x8 pa1, bf16x8 pa2, bf16x8 pa3) {
  pv_one<0>(o[0], vb, pa0, pa1, pa2, pa3); pv_one<1>(o[1], vb, pa0, pa1, pa2, pa3);
}
constexpr int NSLOT = 4, KROWB = 208, SLOT_KB = 64 * KROWB, SLOT_VB = 8192, SLOT_B = SLOT_KB + SLOT_VB, LDS_WS = NSLOT * SLOT_B;
template <int VAR> __device__ __forceinline__ void attn_unit(const bf16_t* __restrict__ Qb, const bf16_t* __restrict__ Kh, const bf16_t* __restrict__ Vh, int seq,
                                          bf16_t* __restrict__ Ob, int o_pitch, const bf16_t* __restrict__ GA, int ga_pitch, char* lds, LAS unsigned char* L3) {
  int tid_ = TIDX; asm volatile("" : "+v"(tid_));
  const int tid = tid_, lane = tid & 63, r32 = lane & 31, hi = lane >> 5; const int wid = __builtin_amdgcn_readfirstlane(tid >> 6);
  float* ws = (float*)(lds + LDS_WS) + wid * 64; float* li_l = ws; float* al_l = ws + 32;
  float m_reg = 0.f, l_reg = 0; f32x16 o[2] = {}; bf16x8 qr[6]; f32x16 negm = {}; VFrag vf;
  int koff0, koff1, voff;
  { const int s0 = 64 * wid + lane, row0 = s0 / 13, c0 = s0 - row0 * 13; koff0 = row0 * 192 + (c0 < 12 ? c0 : 0) * 16;
    const int s1 = s0 + 512, row1 = s1 / 13, c1 = s1 - row1 * 13; koff1 = row1 * 192 + (c1 < 12 ? c1 : 0) * 16;
    const int sub = s0 >> 5, kk = (sub >> 1) * 8 + ((s0 & 31) >> 2), k = (kk & ~0xC) | ((kk & 4) << 1) | ((kk & 8) >> 1), c = (sub & 1) * 32 + (s0 & 3) * 8; voff = k * 128 + c * 2; }
  const bool k2 = wid < 5;
  const __amdgpu_buffer_rsrc_t rsK = __builtin_amdgcn_make_buffer_rsrc((void*)Kh, 0, 0x7ffffff0, 0x00020000), rsV = __builtin_amdgcn_make_buffer_rsrc((void*)Vh, 0, 0x7ffffff0, 0x00020000);
#define AT_DMA(t) do { const int so_ = ((t) & 3) * SLOT_B; \
    __builtin_amdgcn_raw_ptr_buffer_load_lds(rsK, (LAS void*)(L3 + so_ + wid * 1024), 16, koff0, (t) * (64 * 192), 0, 0); \
    if (k2) __builtin_amdgcn_raw_ptr_buffer_load_lds(rsK, (LAS void*)(L3 + so_ + (wid + 8) * 1024), 16, koff1, (t) * (64 * 192), 0, 0); \
    __builtin_amdgcn_raw_ptr_buffer_load_lds(rsV, (LAS void*)(L3 + so_ + SLOT_KB + wid * 1024), 16, voff, (t) * (64 * 128), 0, 0); } while (0)
#define AT_WAITBAR(n) do { if (k2) asm volatile("s_waitcnt vmcnt(" #n "*3) lgkmcnt(0)" ::: "memory"); else asm volatile("s_waitcnt vmcnt(" #n "*2) lgkmcnt(0)" ::: "memory"); __builtin_amdgcn_s_barrier(); } while (0)
  const int NTL = seq / KVBLK;
  const bf16_t* Qw = Qb + (long)(wid * QBLK + r32) * DQK + hi * 8;
#pragma unroll
  for (int d0 = 0; d0 < 6; ++d0) qr[d0] = *reinterpret_cast<const bf16x8*>(Qw + d0 * 16);
  AT_DMA(0); AT_DMA(1); AT_DMA(2);
  const int kb = r32 * KROWB + hi * 16;
  const int vb0 = (int)(uintptr_t)lds + SLOT_KB + v_rd_base(lane);
#define AT_QKT(P0, P1, t) do { const char* ks_ = lds + ((t) & 3) * SLOT_B + kb; \
    _Pragma("unroll") for (int d0 = 0; d0 < 6; ++d0) { const bf16x8 b0 = *reinterpret_cast<const bf16x8*>(ks_ + d0 * 32), b1 = *reinterpret_cast<const bf16x8*>(ks_ + 32 * KROWB + d0 * 32); \
      if (d0 == 0) { P0 = __builtin_amdgcn_mfma_f32_32x32x16_bf16(b0, qr[0], negm, 0, 0, 0); P1 = __builtin_amdgcn_mfma_f32_32x32x16_bf16(b1, qr[0], negm, 0, 0, 0); } \
      else { P0 = __builtin_amdgcn_mfma_f32_32x32x16_bf16(b0, qr[d0], P0, 0, 0, 0); P1 = __builtin_amdgcn_mfma_f32_32x32x16_bf16(b1, qr[d0], P1, 0, 0, 0); } } } while (0)
#define AT_RESC(a) do { if (__any((a) < 1.f)) { if (hi == 0) al_l[r32] = (a); asm volatile("s_waitcnt lgkmcnt(0)" ::: "memory"); \
    _Pragma("unroll") for (int d = 0; d < 2; ++d) _Pragma("unroll") for (int r = 0; r < 16; ++r) o[d][r] *= al_l[crow(r, hi)]; } } while (0)
  f32x16 pA0, pA1, pB0, pB1; float alA, alB; bf16x8 pa0, pa1, pa2, pa3;
  if (k2) asm volatile("s_waitcnt vmcnt(6)" ::: "memory"); else asm volatile("s_waitcnt vmcnt(4)" ::: "memory");
  __builtin_amdgcn_s_barrier();
  AT_QKT(pA0, pA1, 0); partialSM<VAR, true>(pA0, pA1, m_reg, negm, alA);
  AT_WAITBAR(1);
  for (int j = 1; j + 1 < NTL; j += 2) {
    AT_DMA(j + 2);
    vfrag_issue(vf, vb0 + ((j - 1) & 3) * SLOT_B);
    AT_SBAR(); AT_QKT(pB0, pB1, j);
    finishSM<VAR>(pA0, pA1, alA, l_reg, pa0, pa1, pa2, pa3); AT_SBAR();
    pv_mma(o, vf, pa0, pa1, pa2, pa3); partialSM<VAR, false>(pB0, pB1, m_reg, negm, alB);
    AT_RESC(alB);
    AT_WAITBAR(1);
    if (j + 3 < NTL) AT_DMA(j + 3);
    vfrag_issue(vf, vb0 + (j & 3) * SLOT_B);
    AT_SBAR(); AT_QKT(pA0, pA1, j + 1);
    finishSM<VAR>(pB0, pB1, alB, l_reg, pa0, pa1, pa2, pa3); AT_SBAR();
    pv_mma(o, vf, pa0, pa1, pa2, pa3); partialSM<VAR, false>(pA0, pA1, m_reg, negm, alA);
    AT_RESC(alA);
    if (j + 3 < NTL) AT_WAITBAR(1); else AT_WAITBAR(0);
  }
  vfrag_issue(vf, vb0 + ((NTL - 2) & 3) * SLOT_B);
  AT_SBAR(); AT_QKT(pB0, pB1, NTL - 1);
  finishSM<VAR>(pA0, pA1, alA, l_reg, pa0, pa1, pa2, pa3); AT_SBAR();
  pv_mma(o, vf, pa0, pa1, pa2, pa3); partialSM<VAR, false>(pB0, pB1, m_reg, negm, alB);
  AT_RESC(alB);
  finishSM<VAR>(pB0, pB1, alB, l_reg, pa0, pa1, pa2, pa3); AT_SBAR();
  pv_d0(o, vb0 + ((NTL - 1) & 3) * SLOT_B, pa0, pa1, pa2, pa3);
  if (hi == 0) li_l[r32] = l_reg; asm volatile("s_waitcnt lgkmcnt(0)" ::: "memory");
  float rli[16];
#pragma unroll
  for (int r = 0; r < 16; ++r) rli[r] = __builtin_amdgcn_rcpf(li_l[crow(r, hi)]);
#pragma unroll
  for (int r = 0; r < 16; ++r) { const int orow = wid * QBLK + crow(r, hi);
#pragma unroll
    for (int d0 = 0; d0 < 2; ++d0) { if (VAR != 0 && seq >= 0) continue; const float ga = bf2f(GA[(long)orow * ga_pitch + d0 * 32 + r32]);
      Ob[(long)orow * o_pitch + d0 * 32 + r32] = f2bf(o[d0][r] * rli[r] * (ga * __builtin_amdgcn_rcpf(1.f + __expf(-ga)))); } }
  asm volatile("s_waitcnt vmcnt(0) lgkmcnt(0)" ::: "memory"); __builtin_amdgcn_s_barrier();
#undef AT_DMA
#undef AT_WAITBAR
#undef AT_QKT
#undef AT_RESC
}

__device__ __forceinline__ void pv_mma_nw(f32x16* o, const VFrag& f, bf16x8 pa0, bf16x8 pa1, bf16x8 pa2, bf16x8 pa3) {
#define AT_PK(L, H) (bf16x8){L[0], L[1], L[2], L[3], H[0], H[1], H[2], H[3]}
  o[0] = __builtin_amdgcn_mfma_f32_32x32x16_bf16(pa0, AT_PK(f.l[0][0], f.h[0][0]), o[0], 0, 0, 0); o[1] = __builtin_amdgcn_mfma_f32_32x32x16_bf16(pa0, AT_PK(f.l[1][0], f.h[1][0]), o[1], 0, 0, 0);
  o[0] = __builtin_amdgcn_mfma_f32_32x32x16_bf16(pa1, AT_PK(f.l[0][1], f.h[0][1]), o[0], 0, 0, 0); o[1] = __builtin_amdgcn_mfma_f32_32x32x16_bf16(pa1, AT_PK(f.l[1][1], f.h[1][1]), o[1], 0, 0, 0);
  o[0] = __builtin_amdgcn_mfma_f32_32x32x16_bf16(pa2, AT_PK(f.l[0][2], f.h[0][2]), o[0], 0, 0, 0); o[1] = __builtin_amdgcn_mfma_f32_32x32x16_bf16(pa2, AT_PK(f.l[1][2], f.h[1][2]), o[1], 0, 0, 0);
  o[0] = __builtin_amdgcn_mfma_f32_32x32x16_bf16(pa3, AT_PK(f.l[0][3], f.h[0][3]), o[0], 0, 0, 0); o[1] = __builtin_amdgcn_mfma_f32_32x32x16_bf16(pa3, AT_PK(f.l[1][3], f.h[1][3]), o[1], 0, 0, 0);
#undef AT_PK
}
__device__ __forceinline__ void softmax_seg(f32x16& p0, f32x16& p1, float& m_reg, f32x16& negm, float& l_reg, f32x16* o, float* al_l, int r32, int hi, bool first,
                                            bf16x8& pa0, bf16x8& pa1, bf16x8& pa2, bf16x8& pa3) {
  const float pmax = rowmax32(p0, p1);
  float alpha = 1.f;
  if (first || !__builtin_expect(__all(pmax <= THR), 1)) {
    const float dl = first ? pmax : fmaxf(pmax, 0.f);
    m_reg += dl; alpha = first ? 0.f : __builtin_amdgcn_exp2f(-dl);
#pragma unroll
    for (int r = 0; r < 16; ++r) { p0[r] -= dl; p1[r] -= dl; negm[r] = -m_reg; }
    if (!first) { if (hi == 0) al_l[r32] = alpha; asm volatile("s_waitcnt lgkmcnt(0)" ::: "memory");
#pragma unroll
      for (int d = 0; d < 2; ++d)
#pragma unroll
        for (int r = 0; r < 16; ++r) o[d][r] *= al_l[crow(r, hi)]; }
  }
#pragma unroll
  for (int r = 0; r < 16; ++r) p0[r] = __builtin_amdgcn_exp2f(p0[r]);
#pragma unroll
  for (int r = 0; r < 16; ++r) p1[r] = __builtin_amdgcn_exp2f(p1[r]);
  float ps = 0;
#pragma unroll
  for (int r = 0; r < 16; ++r) ps += p0[r];
#pragma unroll
  for (int r = 0; r < 16; ++r) ps += p1[r];
  { auto rr = __builtin_amdgcn_permlane32_swap(__float_as_uint(ps), __float_as_uint(ps), false, false);
    ps = __uint_as_float(rr[0]) + __uint_as_float(rr[1]); }
  l_reg = l_reg * alpha + ps;
#define AT_PK4(P, BASE, OUT) do { unsigned a0 = cvtpk(P[BASE + 0], P[BASE + 1]), a1 = cvtpk(P[BASE + 2], P[BASE + 3]);   \
    unsigned b0 = cvtpk(P[BASE + 4], P[BASE + 5]), b1 = cvtpk(P[BASE + 6], P[BASE + 7]);                              \
    auto r0 = __builtin_amdgcn_permlane32_swap(a0, b0, false, false); auto r1 = __builtin_amdgcn_permlane32_swap(a1, b1, false, false); \
    u32x4 w = {r0[0], r1[0], r0[1], r1[1]}; OUT = *reinterpret_cast<bf16x8*>(&w); } while (0)
  AT_PK4(p0, 0, pa0); AT_PK4(p0, 8, pa1); AT_PK4(p1, 0, pa2); AT_PK4(p1, 8, pa3);
#undef AT_PK4
}
template <int VAR> __device__ __forceinline__ void attn_unit_st(const bf16_t* __restrict__ Qb, const bf16_t* __restrict__ Kh, const bf16_t* __restrict__ Vh, int seq,
                                          bf16_t* __restrict__ Ob, int o_pitch, const bf16_t* __restrict__ GA, int ga_pitch, char* lds, LAS unsigned char* L3) {
  int tid_ = TIDX; asm volatile("" : "+v"(tid_));
  const int tid = tid_, lane = tid & 63, r32 = lane & 31, hi = lane >> 5; const int wid = __builtin_amdgcn_readfirstlane(tid >> 6);
  const bool grpA = wid < 4;
  float* ws = (float*)(lds + LDS_WS) + wid * 64; float* li_l = ws; float* al_l = ws + 32;
  float m_reg = 0.f, l_reg = 0; f32x16 o[2] = {}; bf16x8 qr[6]; f32x16 negm = {}; VFrag vf; f32x16 p0 = {}, p1 = {}; bf16x8 pa0 = {}, pa1 = {}, pa2 = {}, pa3 = {};
  int koff0, koff1, voff;
  { const int s0 = 64 * wid + lane, row0 = s0 / 13, c0 = s0 - row0 * 13; koff0 = row0 * 192 + (c0 < 12 ? c0 : 0) * 16;
    const int s1 = s0 + 512, row1 = s1 / 13, c1 = s1 - row1 * 13; koff1 = row1 * 192 + (c1 < 12 ? c1 : 0) * 16;
    const int sub = s0 >> 5, kk = (sub >> 1) * 8 + ((s0 & 31) >> 2), k = (kk & ~0xC) | ((kk & 4) << 1) | ((kk & 8) >> 1), c = (sub & 1) * 32 + (s0 & 3) * 8; voff = k * 128 + c * 2; }
  const bool k2 = wid < 5;
  const __amdgpu_buffer_rsrc_t rsK = __builtin_amdgcn_make_buffer_rsrc((void*)Kh, 0, 0x7ffffff0, 0x00020000), rsV = __builtin_amdgcn_make_buffer_rsrc((void*)Vh, 0, 0x7ffffff0, 0x00020000);
#define AT_DMA(t) do { const int so_ = ((t) & 3) * SLOT_B; \
    __builtin_amdgcn_raw_ptr_buffer_load_lds(rsK, (LAS void*)(L3 + so_ + wid * 1024), 16, koff0, (t) * (64 * 192), 0, 0); \
    if (k2) __builtin_amdgcn_raw_ptr_buffer_load_lds(rsK, (LAS void*)(L3 + so_ + (wid + 8) * 1024), 16, koff1, (t) * (64 * 192), 0, 0); \
    __builtin_amdgcn_raw_ptr_buffer_load_lds(rsV, (LAS void*)(L3 + so_ + SLOT_KB + wid * 1024), 16, voff, (t) * (64 * 128), 0, 0); } while (0)
#define AT_WAITBAR(n) do { if (k2) asm volatile("s_waitcnt vmcnt(" #n "*3) lgkmcnt(0)" ::: "memory"); else asm volatile("s_waitcnt vmcnt(" #n "*2) lgkmcnt(0)" ::: "memory"); AT_SBAR(); __builtin_amdgcn_s_barrier(); AT_SBAR(); } while (0)
#define AT_BAR() do { AT_SBAR(); __builtin_amdgcn_s_barrier(); AT_SBAR(); } while (0)
  const int NTL = seq / KVBLK;
  const bf16_t* Qw = Qb + (long)(wid * QBLK + r32) * DQK + hi * 8;
#pragma unroll
  for (int d0 = 0; d0 < 6; ++d0) qr[d0] = *reinterpret_cast<const bf16x8*>(Qw + d0 * 16);
  AT_DMA(0); AT_DMA(1);
  const int kb = r32 * KROWB + hi * 16;
  const int vb0 = (int)(uintptr_t)lds + SLOT_KB + v_rd_base(lane);
#define AT_SEG_M(t) do { const char* ks_ = lds + ((t) & 3) * SLOT_B + kb; bf16x8 kf0[6], kf1[6]; \
    _Pragma("unroll") for (int d0 = 0; d0 < 6; ++d0) { kf0[d0] = *reinterpret_cast<const bf16x8*>(ks_ + d0 * 32); kf1[d0] = *reinterpret_cast<const bf16x8*>(ks_ + 32 * KROWB + d0 * 32); } \
    AT_SBAR(); __builtin_amdgcn_s_setprio(1); if ((t) >= 1) pv_mma_nw(o, vf, pa0, pa1, pa2, pa3); \
    p0 = __builtin_amdgcn_mfma_f32_32x32x16_bf16(kf0[0], qr[0], negm, 0, 0, 0); p1 = __builtin_amdgcn_mfma_f32_32x32x16_bf16(kf1[0], qr[0], negm, 0, 0, 0); \
    _Pragma("unroll") for (int d0 = 1; d0 < 6; ++d0) { p0 = __builtin_amdgcn_mfma_f32_32x32x16_bf16(kf0[d0], qr[d0], p0, 0, 0, 0); p1 = __builtin_amdgcn_mfma_f32_32x32x16_bf16(kf1[d0], qr[d0], p1, 0, 0, 0); } __builtin_amdgcn_s_setprio(0); } while (0)
#define AT_SEG_V(t) do { vfrag_issue(vf, vb0 + ((t) & 3) * SLOT_B); AT_SBAR(); \
    softmax_seg(p0, p1, m_reg, negm, l_reg, o, al_l, r32, hi, (t) == 0, pa0, pa1, pa2, pa3); asm volatile("s_waitcnt lgkmcnt(0)" ::: "memory"); } while (0)
  if (k2) asm volatile("s_waitcnt vmcnt(3)" ::: "memory"); else asm volatile("s_waitcnt vmcnt(2)" ::: "memory");
  AT_BAR();
  if (!grpA) AT_BAR();
  for (int t = 0; t < NTL; ++t) {
    if (t + 2 < NTL) AT_DMA(t + 2);
    AT_SEG_M(t);
    if (t + 2 < NTL) AT_WAITBAR(1); else AT_WAITBAR(0);
    AT_SEG_V(t);
    AT_BAR();
  }
  pv_mma_nw(o, vf, pa0, pa1, pa2, pa3);
  if (grpA) AT_BAR();
  if (hi == 0) li_l[r32] = l_reg; asm volatile("s_waitcnt lgkmcnt(0)" ::: "memory");
  float rli[16];
#pragma unroll
  for (int r = 0; r < 16; ++r) rli[r] = __builtin_amdgcn_rcpf(li_l[crow(r, hi)]);
#pragma unroll
  for (int r = 0; r < 16; ++r) { const int orow = wid * QBLK + crow(r, hi);
#pragma unroll
    for (int d0 = 0; d0 < 2; ++d0) { const float ga = bf2f(GA[(long)orow * ga_pitch + d0 * 32 + r32]);
      Ob[(long)orow * o_pitch + d0 * 32 + r32] = f2bf(o[d0][r] * rli[r] * (ga * __builtin_amdgcn_rcpf(1.f + __expf(-ga)))); } }
  asm volatile("s_waitcnt vmcnt(0) lgkmcnt(0)" ::: "memory"); __builtin_amdgcn_s_barrier();
#undef AT_DMA
#undef AT_WAITBAR
#undef AT_BAR
#undef AT_SEG_M
#undef AT_SEG_V
}
#undef AT_KSWZ
#undef AT_SBAR
}


namespace ssd {
using attn::bf16x8; using attn::s16x4; using attn::f32x16; using attn::u32x4;
constexpr int LC = 128, NCH = 66;
constexpr int L_X = 0, L_B = 65536, L_C = 81920, L_CS = 98304, L_DT = L_CS + 4096, L_SC = L_DT + 4096;
constexpr float LOG2E = 1.4426950408889634f;
__device__ __forceinline__ int rimg(int row, int c) { return row * 128 + ((c ^ (row & 7)) << 4); }
__device__ __forceinline__ int chunk_row(int b, int c) { return c < 2 ? ML + b * CTXL + c * LC : b * SEQ + (c - 2) * LC; }
__device__ __forceinline__ float bfbits2f(short v) { return __uint_as_float(((unsigned)(unsigned short)v) << 16); }
template <bool STEP3> __device__ __forceinline__ float load_chunk(const bf16_t* __restrict__ U, const float* __restrict__ DTS, const float* __restrict__ a_log, int rowbase, int g, char* lds) {
    int tid_ = TIDX; asm volatile("" : "+v"(tid_)); const int tid = tid_;
    constexpr int NLD = STEP3 ? 12 : 10, NB2 = NLD / 2;
#pragma unroll
    for (int hb = 0; hb < 2; ++hb) {
        bf16x8 stg[NB2];
#pragma unroll
        for (int q = 0; q < NB2; ++q) { const int it = hb * NB2 + q; const int i = tid + it * NT;
            if (it < 8) { const int s = i >> 5, cc = i & 31; stg[q] = *(const bf16x8*)(U + (size_t)(rowbase + s) * 768 + g * 256 + cc * 8); }
            else if (it < 10) { const int j = i - 4096, s = j >> 3, c = j & 7; stg[q] = *(const bf16x8*)(U + (size_t)(rowbase + s) * 768 + 512 + g * 64 + c * 8); }
            else { const int j = i - 5120, s = j >> 3, c = j & 7; stg[q] = *(const bf16x8*)(U + (size_t)(rowbase + s) * 768 + 640 + g * 64 + c * 8); } }
#pragma unroll
        for (int q = 0; q < NB2; ++q) { const int it = hb * NB2 + q; const int i = tid + it * NT;
            if (it < 8) { const int s = i >> 5, cc = i & 31, hh = cc >> 3, c8 = (cc & 7) * 8; *(bf16x8*)(lds + L_X + hh * 16384 + attn::v_st(s, c8)) = stg[q]; }
            else if (it < 10) { const int j = i - 4096, s = j >> 3, c = j & 7; *(bf16x8*)(lds + L_B + (STEP3 ? rimg(s, c) : attn::v_st(s, c * 8))) = stg[q]; }
            else { const int j = i - 5120, s = j >> 3, c = j & 7; *(bf16x8*)(lds + L_C + rimg(s, c)) = stg[q]; } }
    }
    const int w = tid >> 6, lane = tid & 63, d = w >> 2, hh = w & 3, h = g * 4 + hh;
    const float A2 = -__expf(a_log[d * 8 + h]) * LOG2E;
    const int s0 = d ? 127 - lane : lane, s1 = d ? 63 - lane : 64 + lane;
    const float dt0 = DTS[(size_t)(rowbase + s0) * 16 + d * 8 + h], dt1 = DTS[(size_t)(rowbase + s1) * 16 + d * 8 + h];
    float x0 = dt0 * A2, x1 = dt1 * A2;
    { int ln = lane; asm volatile("" : "+v"(ln));
#pragma unroll
      for (int off = 1; off < 64; off <<= 1) { const int src = (ln - off) << 2;
          const float t0 = __int_as_float(__builtin_amdgcn_ds_bpermute(src, __float_as_int(x0))), t1 = __int_as_float(__builtin_amdgcn_ds_bpermute(src, __float_as_int(x1)));
          if (ln >= off) { x0 += t0; x1 += t1; } } }
    x1 += __int_as_float(__builtin_amdgcn_readlane(__float_as_int(x0), 63)); const float T = __int_as_float(__builtin_amdgcn_readlane(__float_as_int(x1), 63));
    float* CS = (float*)(lds + L_CS) + w * 128; float* DTL = (float*)(lds + L_DT) + w * 128; float* SC = (float*)(lds + L_SC) + w * 128;
    CS[s0] = x0; CS[s1] = x1; DTL[s0] = dt0; DTL[s1] = dt1;
    if (STEP3) { SC[s0] = exp2f(x0); SC[s1] = exp2f(x1); } else { SC[s0] = dt0 * exp2f(T - x0); SC[s1] = dt1 * exp2f(T - x1); }
    return T;
}
#define SSD_SBAR() __builtin_amdgcn_sched_barrier(0)
template <int KS> __device__ __forceinline__ void st1_step(f32x16 (&acc)[2][2], int vbx, int vbb, const float* SCw, int hi) {
    typedef float f32x4v __attribute__((ext_vector_type(4)));
    const f32x4v sA = *(const f32x4v*)(SCw + 16 * KS + 8 * hi), sB = *(const f32x4v*)(SCw + 16 * KS + 8 * hi + 4);
    const s16x4 xl0 = attn::tr_read<attn::v_rd_off(0, KS, 0)>(vbx), xh0 = attn::tr_read<attn::v_rd_off(0, KS, 1)>(vbx);
    const s16x4 xl1 = attn::tr_read<attn::v_rd_off(1, KS, 0)>(vbx), xh1 = attn::tr_read<attn::v_rd_off(1, KS, 1)>(vbx);
    const s16x4 bl0 = attn::tr_read<attn::v_rd_off(0, KS, 0)>(vbb), bh0 = attn::tr_read<attn::v_rd_off(0, KS, 1)>(vbb);
    const s16x4 bl1 = attn::tr_read<attn::v_rd_off(1, KS, 0)>(vbb), bh1 = attn::tr_read<attn::v_rd_off(1, KS, 1)>(vbb);
    asm volatile("s_waitcnt lgkmcnt(0)" ::: "memory"); SSD_SBAR();
#define SSD_SCL(L, H) ({ u32x4 w_; w_.x = attn::cvtpk(bfbits2f(L[0]) * sA[0], bfbits2f(L[1]) * sA[1]); w_.y = attn::cvtpk(bfbits2f(L[2]) * sA[2], bfbits2f(L[3]) * sA[3]); \
        w_.z = attn::cvtpk(bfbits2f(H[0]) * sB[0], bfbits2f(H[1]) * sB[1]); w_.w = attn::cvtpk(bfbits2f(H[2]) * sB[2], bfbits2f(H[3]) * sB[3]); *reinterpret_cast<bf16x8*>(&w_); })
#define SSD_PK(L, H) (bf16x8){L[0], L[1], L[2], L[3], H[0], H[1], H[2], H[3]}
    const bf16x8 a0 = SSD_SCL(xl0, xh0), a1 = SSD_SCL(xl1, xh1), b0 = SSD_PK(bl0, bh0), b1 = SSD_PK(bl1, bh1);
    acc[0][0] = __builtin_amdgcn_mfma_f32_32x32x16_bf16(a0, b0, acc[0][0], 0, 0, 0); acc[0][1] = __builtin_amdgcn_mfma_f32_32x32x16_bf16(a0, b1, acc[0][1], 0, 0, 0);
    acc[1][0] = __builtin_amdgcn_mfma_f32_32x32x16_bf16(a1, b0, acc[1][0], 0, 0, 0); acc[1][1] = __builtin_amdgcn_mfma_f32_32x32x16_bf16(a1, b1, acc[1][1], 0, 0, 0);
#undef SSD_SCL
}
__device__ __forceinline__ void states_item(const bf16_t* U, const float* DTS, const float* a_log, bf16_t* SST, float* CD, int b, int c, int g, char* lds) {
    const float T = load_chunk<false>(U, DTS, a_log, chunk_row(b, c), g, lds);
    __syncthreads();
    const int tid = TIDX, w = tid >> 6, lane = tid & 63, r32 = lane & 31, hi = lane >> 5, d = w >> 2, hh = w & 3, h = g * 4 + hh;
    const int vbx = (int)(uintptr_t)(lds + L_X + hh * 16384) + attn::v_rd_base(lane), vbb = (int)(uintptr_t)(lds + L_B) + attn::v_rd_base(lane);
    const float* SCw = (const float*)(lds + L_SC) + w * 128;
    f32x16 acc[2][2] = {};
    st1_step<0>(acc, vbx, vbb, SCw, hi); st1_step<1>(acc, vbx, vbb, SCw, hi); st1_step<2>(acc, vbx, vbb, SCw, hi); st1_step<3>(acc, vbx, vbb, SCw, hi);
    st1_step<4>(acc, vbx, vbb, SCw, hi); st1_step<5>(acc, vbx, vbb, SCw, hi); st1_step<6>(acc, vbx, vbb, SCw, hi); st1_step<7>(acc, vbx, vbb, SCw, hi);
    const size_t cidx = (((size_t)b * NCH + c) * 2 + d) * 8 + h;
    bf16_t* So = SST + cidx * 4096;
#pragma unroll
    for (int pb = 0; pb < 2; ++pb)
#pragma unroll
        for (int nb = 0; nb < 2; ++nb)
#pragma unroll
            for (int r = 0; r < 16; ++r) So[(pb * 32 + attn::crow(r, hi)) * 64 + nb * 32 + r32] = f2bf(acc[pb][nb][r]);
    if (lane == 0) CD[cidx] = exp2f(T);
    __syncthreads();
}
__device__ __forceinline__ void out_item(const bf16_t* U, const float* DTS, const float* a_log, const bf16_t* HIN, bf16_t* Y, int b, int j, int g, char* lds) {
    typedef float f32x4v __attribute__((ext_vector_type(4)));
    const int rowbase = b * SEQ + j * LC, c = j + 2;
    int tid_ = TIDX; asm volatile("" : "+v"(tid_));
    const int tid = tid_, w = tid >> 6, lane = tid & 63, r32 = lane & 31, hi = lane >> 5, hh = w & 3, lp = w >> 2, h = g * 4 + hh;
    bf16x8 hbn[4][2];
#define SSD_HLOAD(dd) do { const bf16_t* Hp_ = HIN + ((((size_t)b * NCH + c) * 2 + (dd)) * 8 + h) * 4096; \
    _Pragma("unroll") for (int ks = 0; ks < 4; ++ks) { const bf16_t* h0 = Hp_ + r32 * 64 + ks * 16 + hi * 8; hbn[ks][0] = *(const bf16x8*)h0; hbn[ks][1] = *(const bf16x8*)(h0 + 32 * 64); } } while (0)
    SSD_HLOAD(0);
    (void)load_chunk<true>(U, DTS, a_log, rowbase, g, lds);
    __syncthreads();
    const char* BR = lds + L_B; const char* CR = lds + L_C;
    const int vbx = (int)(uintptr_t)(lds + L_X + hh * 16384) + attn::v_rd_base(lane);
#pragma unroll
    for (int lti = 0; lti < 2; ++lti) { const int lt = 2 * lp + lti, l = 32 * lt + r32;
        f32x16 y0 = {}, y1 = {};
#pragma unroll
        for (int d = 0; d < 2; ++d) { const int combo = d * 4 + hh;
            const float* CSw = (const float*)(lds + L_CS) + combo * 128; const float* DTw = (const float*)(lds + L_DT) + combo * 128; const float* ELw = (const float*)(lds + L_SC) + combo * 128;
            f32x16 t0 = {}, t1 = {};
            bf16x8 hb[4][2];
#pragma unroll
            for (int ks = 0; ks < 4; ++ks) { hb[ks][0] = hbn[ks][0]; hb[ks][1] = hbn[ks][1]; }
            if (!(lti == 1 && d == 1)) SSD_HLOAD(1 - d);
#pragma unroll
            for (int ks = 0; ks < 4; ++ks) { const bf16x8 A = *(const bf16x8*)(CR + rimg(l, 2 * ks + hi));
                t0 = __builtin_amdgcn_mfma_f32_32x32x16_bf16(A, hb[ks][0], t0, 0, 0, 0);
                t1 = __builtin_amdgcn_mfma_f32_32x32x16_bf16(A, hb[ks][1], t1, 0, 0, 0); }
#pragma unroll
            for (int k4 = 0; k4 < 4; ++k4) { const f32x4v fv = *(const f32x4v*)(ELw + 32 * lt + 4 * hi + 8 * k4);
#pragma unroll
                for (int i = 0; i < 4; ++i) { t0[4 * k4 + i] *= fv[i]; t1[4 * k4 + i] *= fv[i]; } }
            const float fl = CSw[l];
#pragma unroll
            for (int st = 0; st < 2; ++st) {
                const bool need = d == 0 ? (64 * st <= 32 * lt + 31) : (64 * st + 63 >= 32 * lt);
                if (need) {
                    f32x16 p0 = {}, p1 = {};
#pragma unroll
                    for (int ks = 0; ks < 4; ++ks) { const bf16x8 q = *(const bf16x8*)(CR + rimg(l, 2 * ks + hi));
                        const bf16x8 b0 = *(const bf16x8*)(BR + rimg(64 * st + r32, 2 * ks + hi)), b1 = *(const bf16x8*)(BR + rimg(64 * st + 32 + r32, 2 * ks + hi));
                        p0 = __builtin_amdgcn_mfma_f32_32x32x16_bf16(b0, q, p0, 0, 0, 0); p1 = __builtin_amdgcn_mfma_f32_32x32x16_bf16(b1, q, p1, 0, 0, 0); }
#pragma unroll
                    for (int k4 = 0; k4 < 4; ++k4) {
                        const int sb = 64 * st + 8 * k4 + 4 * hi;
                        const f32x4v c0v = *(const f32x4v*)(CSw + sb), c1v = *(const f32x4v*)(CSw + sb + 32), d0v = *(const f32x4v*)(DTw + sb), d1v = *(const f32x4v*)(DTw + sb + 32);
#pragma unroll
                        for (int i = 0; i < 4; ++i) { const int r = 4 * k4 + i, s0 = sb + i, s1 = s0 + 32;
                            const bool m0 = d == 0 ? (s0 <= l) : (s0 >= l), m1 = d == 0 ? (s1 <= l) : (s1 >= l);
                            p0[r] = m0 ? p0[r] * (__builtin_amdgcn_exp2f(fl - c0v[i]) * d0v[i]) : 0.f; p1[r] = m1 ? p1[r] * (__builtin_amdgcn_exp2f(fl - c1v[i]) * d1v[i]) : 0.f; }
                        asm volatile("" ::: "memory"); }
                    bf16x8 pa0, pa1, pa2, pa3;
#define SSD_PK4(P, BASE, OUT) do { unsigned a0 = attn::cvtpk(P[BASE + 0], P[BASE + 1]), a1 = attn::cvtpk(P[BASE + 2], P[BASE + 3]);   \
    unsigned b0_ = attn::cvtpk(P[BASE + 4], P[BASE + 5]), b1_ = attn::cvtpk(P[BASE + 6], P[BASE + 7]);                              \
    auto r0 = __builtin_amdgcn_permlane32_swap(a0, b0_, false, false); auto r1 = __builtin_amdgcn_permlane32_swap(a1, b1_, false, false); \
    u32x4 w_ = {r0[0], r1[0], r0[1], r1[1]}; OUT = *reinterpret_cast<bf16x8*>(&w_); } while (0)
                    SSD_PK4(p0, 0, pa0); SSD_PK4(p0, 8, pa1); SSD_PK4(p1, 0, pa2); SSD_PK4(p1, 8, pa3);
#undef SSD_PK4
                    SSD_SBAR();
                    attn::pv_one<0>(t0, vbx + st * 8192, pa0, pa1, pa2, pa3); attn::pv_one<1>(t1, vbx + st * 8192, pa0, pa1, pa2, pa3);
                }
            }
            y0 += t0; y1 += t1;
        }
#pragma unroll
        for (int r = 0; r < 16; ++r) { bf16_t* yr = Y + (size_t)(rowbase + 32 * lt + attn::crow(r, hi)) * 512 + h * 64 + r32; yr[0] = f2bf(y0[r]); yr[32] = f2bf(y1[r]); }
    }
    __syncthreads();
#undef SSD_HLOAD
}
#undef SSD_PK
#undef SSD_SBAR
}

struct Ptrs {
    const float *x, *c, *ctx, *c_ctx, *mod_w, *mod_b, *norm_w, *w_in_mix, *q_norm, *w_uq, *kv_norm, *w_ukv, *conv_w, *conv_b, *a_log, *dt_bias, *d_skip, *ssd_norm,
        *w_out_mix, *w_in_pool, *pool_lin, *pool_scale, *w_out_pool, *final_norm;
    float* out; char* ws;
};


__device__ __forceinline__ unsigned pk2(float lo, float hi) { return (unsigned)f2bf(lo) | ((unsigned)f2bf(hi) << 16); }
typedef unsigned v4u __attribute__((ext_vector_type(4)));
__device__ __forceinline__ void tr_item(const float* W, int ldw, int Nsrc, int K, bf16_t* WT, int row_off, const float* kscale, int ks_off, const float* nscale, float gscale,
                                        LAS float* scr, int item, int nblk, int lane) {
    const int kb = item / nblk, nb = item % nblk, k0 = 64 * kb, n0 = 32 * nb;
    const int n4 = n0 + 4 * (lane & 7); const bool nin = n4 < Nsrc;
    f32x4 ns = {gscale, gscale, gscale, gscale};
    if (nscale && nin) { const f32x4 t = *(const f32x4*)(nscale + n4); ns = t * gscale; }
#pragma unroll
    for (int i = 0; i < 8; ++i) { const int kk = 8 * i + (lane >> 3);
        f32x4 w = nin ? *(const f32x4*)(W + (size_t)(k0 + kk) * ldw + n4) : (f32x4){0.f, 0.f, 0.f, 0.f};
        if (kscale && (k0 + kk) >= ks_off) w = w * kscale[k0 + kk - ks_off];
        w = w * ns;
        LAS float* d = scr + kk * 33 + 4 * (lane & 7); d[0] = w[0]; d[1] = w[1]; d[2] = w[2]; d[3] = w[3]; }
    asm volatile("s_waitcnt lgkmcnt(0)" ::: "memory");
    const int c = lane & 7;
#pragma unroll
    for (int j = 0; j < 4; ++j) { const int n = (lane >> 3) + 8 * j; const LAS float* sp = scr + (8 * c) * 33 + n;
        v4u o; o.x = pk2(sp[0 * 33], sp[1 * 33]); o.y = pk2(sp[2 * 33], sp[3 * 33]); o.z = pk2(sp[4 * 33], sp[5 * 33]); o.w = pk2(sp[6 * 33], sp[7 * 33]);
        *(v4u*)(WT + (size_t)(row_off + n0 + n) * K + k0 + 8 * c) = o; }
    asm volatile("s_waitcnt lgkmcnt(0)" ::: "memory");
}
__device__ __forceinline__ void ph_weights(const Ptrs& P, LAS unsigned char* L) {
    const int lane = TIDX & 63, wv = TIDX >> 6;
    LAS float* scr = (LAS float*)(L + wv * 16384);
    const int gw = blockIdx.x * (NT / 64) + wv, NGW = gridDim.x * (NT / 64);
    constexpr int I1 = 16 * 80, I2 = 6 * 24, I3 = 4 * 32, I4 = 16 * 32, I5 = 16 * 64, I6 = 4 * 32, I7 = 16 * 32;
    for (int it = gw; it < I1 + I2 + I3 + I4 + I5 + I6 + I7; it += NGW) {
        int r = it;
        if (r < I1) { tr_item(P.w_in_mix, 2480, 2480, 1024, (bf16_t*)(P.ws + WS_WT1), 0, nullptr, 0, nullptr, 1.f, scr, r, 80, lane); continue; } r -= I1;
        if (r < I2) { tr_item(P.w_uq, 768, 768, 384, (bf16_t*)(P.ws + WS_WTQ), 0, P.q_norm, 0, nullptr, QSCALE, scr, r, 24, lane); continue; } r -= I2;
        if (r < I3) { tr_item(P.w_ukv, 1024, 1024, 256, (bf16_t*)(P.ws + WS_WTKV), 0, P.kv_norm, 0, nullptr, 1.f, scr, r, 32, lane); continue; } r -= I3;
        if (r < I4) { tr_item(P.w_out_mix, 1024, 1024, 1024, (bf16_t*)(P.ws + WS_WTO), 0, P.ssd_norm, 512, nullptr, 1.f, scr, r, 32, lane); continue; } r -= I4;
        if (r < I5) { tr_item(P.w_in_pool, 2048, 2048, 1024, (bf16_t*)(P.ws + WS_WTP), 0, nullptr, 0, nullptr, 1.f, scr, r, 64, lane); continue; } r -= I5;
        if (r < I6) { const int g = r / 32; tr_item(P.pool_lin + (size_t)g * 65536, 256, 256, 256, (bf16_t*)(P.ws + WS_WTL), g * 256, nullptr, 0, P.pool_scale + g * 256, 1.f, scr, r % 32, 8, lane); continue; } r -= I6;
        tr_item(P.w_out_pool, 1024, 1024, 1024, (bf16_t*)(P.ws + WS_WTOP), 0, nullptr, 0, nullptr, 1.f, scr, r, 32, lane);
    }
}

__device__ __forceinline__ void ph_modvec(const Ptrs& P, LAS unsigned char* L) {
    float* modv = (float*)(P.ws + WS_MODV);
    LAS float* sv = (LAS float*)L;
    LAS float* red = (LAS float*)(L + 20480);
    const int tid = TIDX;
    for (int i = tid; i < 5 * 1024; i += NT) { const int v = i >> 10, k = i & 1023; sv[i] = siluf(v < 4 ? P.c[v * 1024 + k] : P.c_ctx[k]); }
    __syncthreads();
    for (int it = blockIdx.x; it < 2 * 128; it += gridDim.x) {
        const int layer = it >> 7, col0 = (it & 127) * 24;
        if (tid < 384) { const int c4 = tid % 6, kg = tid / 6;
            const float* wp = P.mod_w + ((size_t)layer * 1024 + kg * 16) * 3072 + col0 + c4 * 4;
            f32x4 w[16];
#pragma unroll
            for (int r = 0; r < 16; ++r) w[r] = *(const f32x4*)(wp + (size_t)r * 3072);
            f32x4 acc[5];
#pragma unroll
            for (int v = 0; v < 5; ++v) acc[v] = (f32x4){0.f, 0.f, 0.f, 0.f};
#pragma unroll
            for (int r = 0; r < 16; ++r)
#pragma unroll
                for (int v = 0; v < 5; ++v) acc[v] += w[r] * sv[v * 1024 + kg * 16 + r];
#pragma unroll
            for (int v = 0; v < 5; ++v) { LAS float* d = red + (kg * 5 + v) * 24 + c4 * 4; d[0] = acc[v][0]; d[1] = acc[v][1]; d[2] = acc[v][2]; d[3] = acc[v][3]; }
        }
        __syncthreads();
        if (tid < 120) { const int v = tid / 24, cc = tid % 24; float a = 0.f;
#pragma unroll 8
            for (int kg = 0; kg < 64; ++kg) a += red[(kg * 5 + v) * 24 + cc];
            modv[(layer * 5 + v) * 3072 + col0 + cc] = a + P.mod_b[layer * 3072 + col0 + cc]; }
        __syncthreads();
    }
    float* COS = (float*)(P.ws + WS_COS); float* SIN = (float*)(P.ws + WS_SIN);
    GSTRIDE(idx, SEQ * 16) {
        int t = (int)(idx / 16), j = (int)(idx % 16);
        float pos = (float)(j < 8 ? t / 64 : t % 64);
        float invf = 1.0f / powf(10000.0f, (float)(2 * (j & 7)) / 16.0f);
        float ang = pos * invf;
        COS[idx] = cosf(ang); SIN[idx] = sinf(ang);
    }
}
template <bool HAS_CTX> __device__ __forceinline__ void ph_norm_mod(const float* xl, const float* ctx, int nrows, const float* norm_w, const float* modv, bf16_t* H) {
    const int tid = TIDX, lane = tid & 63, gw = blockIdx.x * (NT / 64) + (tid >> 6), NGW = gridDim.x * (NT / 64);
    f32x4 nw[4];
#pragma unroll
    for (int j = 0; j < 4; ++j) nw[j] = *(const f32x4*)(norm_w + 4 * lane + 256 * j);
#define NM_SRC(r) ((!HAS_CTX || (r) < ML) ? xl + (size_t)(r) * DM : ctx + (size_t)((r) - ML) * DM)
    int vc = -1; f32x4 scv[4], shv[4];
    for (int row = 2 * gw; row < nrows; row += 2 * NGW) {
        f32x4 xv[2][4];
#pragma unroll
        for (int q = 0; q < 2; ++q) { const float* src = NM_SRC(row + q);
#pragma unroll
            for (int j = 0; j < 4; ++j) xv[q][j] = *(const f32x4*)(src + 4 * lane + 256 * j); }
        { const int v = (!HAS_CTX || row < ML) ? row / SEQ : 4;
          if (v != vc) { vc = v;
#pragma unroll
              for (int j = 0; j < 4; ++j) { const int k = 4 * lane + 256 * j; shv[j] = *(const f32x4*)(modv + v * 3072 + k); scv[j] = *(const f32x4*)(modv + v * 3072 + 1024 + k) + 1.f; } } }
#pragma unroll
        for (int q = 0; q < 2; ++q) { const int r = row + q; float ss = 0.f;
#pragma unroll
            for (int j = 0; j < 4; ++j) ss += (xv[q][j].x * xv[q][j].x + xv[q][j].y * xv[q][j].y) + (xv[q][j].z * xv[q][j].z + xv[q][j].w * xv[q][j].w);
            ss = wave_sum(ss);
            const float rstd = rsqrtf(ss * (1.f / DM) + RMS_EPS);
#pragma unroll
            for (int j = 0; j < 4; ++j) { const int k = 4 * lane + 256 * j;
                const f32x4 o = xv[q][j] * rstd * nw[j] * scv[j] + shv[j];
                uint2 w; w.x = pk2f(o.x, o.y); w.y = pk2f(o.z, o.w);
                *(uint2*)(H + (size_t)r * DM + k) = w; } }
    }
#undef NM_SRC
}
template <int RT, class Epi>
__device__ __forceinline__ void ph_gemm(const bf16_t* A, int lda, const float* W, int ldw, int M, int N, int K, const float* kscale, int ks_off, const Epi& E) {
    const int ncb = (N + NT - 1) / NT, nitems = ncb * (M / RT);
    for (int it = blockIdx.x; it < nitems; it += gridDim.x) {
        const int cb = it % ncb, rg = it / ncb; const int col = cb * NT + TIDX, row0 = rg * RT;
        float acc[RT];
#pragma unroll
        for (int r = 0; r < RT; ++r) acc[r] = 0.f;
        if (col < N) {
            for (int k = 0; k < K; ++k) {
                float w = W[(size_t)k * ldw + col];
                if (kscale && k >= ks_off) w *= kscale[k - ks_off];
#pragma unroll
                for (int r = 0; r < RT; ++r) acc[r] += bf2f(A[(size_t)(row0 + r) * lda + k]) * w;
            }
#pragma unroll
            for (int r = 0; r < RT; ++r) E(row0 + r, col, acc[r]);
        }
    }
}
struct EpiProj { bf16_t* P; float* DT;
    __device__ void operator()(int row, int col, float a) const { P[(size_t)row * PN + col] = f2bf(a); if (col >= C_DT) DT[row * 16 + col - C_DT] = a; } };
struct EpiRes { const float* res; const float* gate; float* out;
    __device__ void operator()(int row, int col, float a) const { int b = row / SEQ; out[(size_t)row * DM + col] = res[(size_t)row * DM + col] + gate[b * 3072 + 2048 + col] * a; } };
struct EpiBf { bf16_t* O; int ld;
    __device__ void operator()(int row, int col, float a) const { O[(size_t)row * ld + col] = f2bf(a); } };

__device__ __forceinline__ void ph_upproj(const Ptrs& P) {
    const bf16_t* PR = (const bf16_t*)(P.ws + WS_PROJ); const float* COS = (const float*)(P.ws + WS_COS); const float* SIN = (const float*)(P.ws + WS_SIN);
    bf16_t* Q = (bf16_t*)(P.ws + WS_Q); bf16_t* Kb = (bf16_t*)(P.ws + WS_K); bf16_t* Vb = (bf16_t*)(P.ws + WS_V);
    GSTRIDE(idx, MT * 16) {
        int jj = (int)(idx % 16), row = (int)(idx / 16); int b, t; bool isctx; row_info(row, b, t, isctx); int key = isctx ? t : CTXL + t;
        float k1 = bf2f(PR[(size_t)row * PN + C_KPE + jj]), k2 = bf2f(PR[(size_t)row * PN + C_KPE + 16 + jj]);
        float o1 = k1, o2 = k2;
        if (!isctx) { float cs = COS[t * 16 + jj], sn = SIN[t * 16 + jj]; o1 = k1 * cs - k2 * sn; o2 = k2 * cs + k1 * sn; }
        for (int h = 0; h < 8; ++h) { size_t kr = (size_t)(b * 8 + h) * NKEY + key; Kb[kr * 96 + 64 + jj] = f2bf(o1); Kb[kr * 96 + 80 + jj] = f2bf(o2); }
    }
    bf16_t* U = (bf16_t*)(P.ws + WS_U);
    GSTRIDE(idx, (long)(MT / 32) * 96) {
        const int cq = (int)(idx % 96), rb = (int)(idx / 96), row0 = rb * 32; int b, t0; bool isctx; row_info(row0, b, t0, isctx); const int n = isctx ? CTXL : SEQ;
        const bf16_t* p = PR + (size_t)row0 * PN + C_XBC + cq * 8; bf16_t* uo = U + (size_t)row0 * 768 + cq * 8;
        float w0[8], w1[8], w2[8], bs[8];
#pragma unroll
        for (int i = 0; i < 8; ++i) { w0[i] = P.conv_w[cq * 8 + i]; w1[i] = P.conv_w[768 + cq * 8 + i]; w2[i] = P.conv_w[1536 + cq * 8 + i]; bs[i] = P.conv_b[cq * 8 + i]; }
        typedef unsigned v4u_ __attribute__((ext_vector_type(4)));
        v4u_ rows[34];
#pragma unroll
        for (int r = 0; r < 34; ++r) { const int t = t0 - 1 + r; rows[r] = (t >= 0 && t < n) ? *(const v4u_*)(p + (long)(r - 1) * PN) : (v4u_){0u, 0u, 0u, 0u}; }
#pragma unroll
        for (int r = 0; r < 32; ++r) { v4u_ o;
#pragma unroll
            for (int i = 0; i < 4; ++i) {
                const float a0 = __uint_as_float(rows[r][i] << 16), a1 = __uint_as_float(rows[r][i] & 0xffff0000u);
                const float c0 = __uint_as_float(rows[r + 1][i] << 16), c1 = __uint_as_float(rows[r + 1][i] & 0xffff0000u);
                const float n0 = __uint_as_float(rows[r + 2][i] << 16), n1 = __uint_as_float(rows[r + 2][i] & 0xffff0000u);
                const float v0 = bs[2 * i] + w0[2 * i] * a0 + w1[2 * i] * c0 + w2[2 * i] * n0, v1 = bs[2 * i + 1] + w0[2 * i + 1] * a1 + w1[2 * i + 1] * c1 + w2[2 * i + 1] * n1;
                o[i] = pk2(siluf(v0), siluf(v1)); }
            *(v4u_*)(uo + (size_t)r * 768) = o; }
    }
    const float* DT = (const float*)(P.ws + WS_DT); float* DTS = (float*)(P.ws + WS_DTS);
    GSTRIDE(idx, MT * 16) DTS[idx] = softplusf(DT[idx] + P.dt_bias[idx % 16]);
}
__device__ __forceinline__ void ph_ssd_states(const Ptrs& P, unsigned char* lds) {
    const bf16_t* U = (const bf16_t*)(P.ws + WS_U); const float* DTS = (const float*)(P.ws + WS_DTS);
    for (int it = blockIdx.x; it < NB * ssd::NCH * 2; it += gridDim.x) { const int b = it / (ssd::NCH * 2), rem = it % (ssd::NCH * 2);
        ssd::states_item(U, DTS, P.a_log, (bf16_t*)(P.ws + WS_SST), (float*)(P.ws + WS_CD), b, rem >> 1, rem & 1, (char*)lds); }
}
__device__ __forceinline__ void ph_ssd_chunkscan(const Ptrs& P) {
    bf16_t* SST = (bf16_t*)(P.ws + WS_SST); const float* CD = (const float*)(P.ws + WS_CD);
    GSTRIDE(idx, NB * 2 * 8 * 2048) {
        const int e2 = (int)(idx & 2047); const int bdh = __builtin_amdgcn_readfirstlane((int)(idx >> 11));
        const int h = bdh & 7, d = (bdh >> 3) & 1, b = bdh >> 4;
        unsigned Sv[ssd::NCH];
#pragma unroll
        for (int k = 0; k < ssd::NCH; ++k) { const int c = d == 0 ? k : (k < 2 ? 1 - k : 67 - k); const size_t ci = (((size_t)b * ssd::NCH + c) * 2 + d) * 8 + h; Sv[k] = *(const unsigned*)(SST + ci * 4096 + 2 * e2); }
        float h0 = 0.f, h1 = 0.f;
#pragma unroll
        for (int k = 0; k < ssd::NCH; ++k) { const int c = d == 0 ? k : (k < 2 ? 1 - k : 67 - k); const size_t ci = (((size_t)b * ssd::NCH + c) * 2 + d) * 8 + h;
            if (k >= 2) *(unsigned*)(SST + ci * 4096 + 2 * e2) = pk2f(h0, h1);
            const float dec = CD[ci];
            h0 = h0 * dec + __uint_as_float(Sv[k] << 16); h1 = h1 * dec + __uint_as_float(Sv[k] & 0xffff0000u); }
    }
}
__device__ __forceinline__ void ph_ssd_out(const Ptrs& P, unsigned char* lds);
template <int VAR> __device__ __forceinline__ void ph_attn_mfma(const Ptrs& P, unsigned char* lds) {
    const bf16_t* Q = (const bf16_t*)(P.ws + WS_Q); const bf16_t* Kb = (const bf16_t*)(P.ws + WS_K); const bf16_t* Vb = (const bf16_t*)(P.ws + WS_V);
    const bf16_t* PR = (const bf16_t*)(P.ws + WS_PROJ); bf16_t* CAT = (bf16_t*)P.out;
    const int G = gridDim.x, c = blockIdx.x; const int vcu = (G % 8 == 0) ? (c % 8) * (G / 8) + c / 8 : c;
    for (int unit = vcu; unit < NB * 8 * 32; unit += G) {
        const int bh = unit >> 5, qb = unit & 31; const int b = bh >> 3, h = bh & 7; const int row0 = b * SEQ + qb * 256;
        attn::attn_unit_st<VAR>(Q + ((size_t)bh * SEQ + qb * 256) * 96, Kb + (size_t)bh * NKEY * 96, Vb + (size_t)bh * NKEY * 64, NKEY,
                        CAT + (size_t)row0 * DM + h * 64, DM, PR + (size_t)row0 * PN + C_GA + h * 64, PN, (char*)lds, (LAS unsigned char*)lds);
    }
}

__device__ __forceinline__ void merge_rows(const Ptrs& P, int row_begin, int row_end, int gw, int NGW) {
    const bf16_t* Y = (const bf16_t*)(P.ws + WS_H); const bf16_t* U = (const bf16_t*)(P.ws + WS_U); const bf16_t* PR = (const bf16_t*)(P.ws + WS_PROJ); bf16_t* CAT = (bf16_t*)P.out;
    int lane = lane_id_(); asm volatile("" : "+v"(lane));
    typedef unsigned v4u_ __attribute__((ext_vector_type(4)));
    const int h = lane >> 3; const float sk = P.d_skip[h] + P.d_skip[8 + h];
    for (int row = row_begin + 4 * gw; row < row_end; row += 4 * NGW) {
        v4u_ yv[4], xv[4], zv[4];
#pragma unroll
        for (int q = 0; q < 4; ++q) { const size_t r = (size_t)(row + q);
            yv[q] = *(const v4u_*)(Y + r * 512 + 8 * lane); xv[q] = *(const v4u_*)(U + r * 768 + 8 * lane); zv[q] = *(const v4u_*)(PR + r * PN + C_Z + 8 * lane); }
#pragma unroll
        for (int q = 0; q < 4; ++q) { float v[8]; float ss = 0.f;
#pragma unroll
            for (int i = 0; i < 4; ++i) {
                const float y0 = __uint_as_float(yv[q][i] << 16), y1 = __uint_as_float(yv[q][i] & 0xffff0000u), x0 = __uint_as_float(xv[q][i] << 16), x1 = __uint_as_float(xv[q][i] & 0xffff0000u);
                const float z0 = __uint_as_float(zv[q][i] << 16), z1 = __uint_as_float(zv[q][i] & 0xffff0000u);
                v[2 * i] = (y0 + sk * x0) * siluf(z0); v[2 * i + 1] = (y1 + sk * x1) * siluf(z1); ss += v[2 * i] * v[2 * i] + v[2 * i + 1] * v[2 * i + 1]; }
            ss = wave_sum(ss);
            const float rstd = rsqrtf(ss * (1.f / 512.f) + RMS_EPS);
            v4u_ o;
#pragma unroll
            for (int i = 0; i < 4; ++i) o[i] = pk2f(v[2 * i] * rstd, v[2 * i + 1] * rstd);
            *(v4u_*)(CAT + (size_t)(row + q) * DM + 512 + 8 * lane) = o; }
    }
}
__device__ __forceinline__ void ph_merge(const Ptrs& P) { const int tid = TIDX; merge_rows(P, 0, ML, blockIdx.x * (NT / 64) + (tid >> 6), gridDim.x * (NT / 64)); }

__device__ __forceinline__ void ph_ssd_out(const Ptrs& P, unsigned char* lds) {
    const bf16_t* U = (const bf16_t*)(P.ws + WS_U); const float* DTS = (const float*)(P.ws + WS_DTS);
    for (int it = blockIdx.x; it < NB * 64; it += gridDim.x) { const int b = it >> 6, j = it & 63;
#pragma unroll 1
        for (int g = 0; g < 2; ++g) ssd::out_item(U, DTS, P.a_log, (const bf16_t*)(P.ws + WS_SST), (bf16_t*)(P.ws + WS_H), b, j, g, (char*)lds);
        asm volatile("s_waitcnt vmcnt(0)" ::: "memory"); __syncthreads();
        const int row0 = b * SEQ + j * ssd::LC; merge_rows(P, row0, row0 + ssd::LC, TIDX >> 6, NT / 64); }
}

template <int W, int R> __device__ __forceinline__ void pool_item(const bf16_t* __restrict__ UG, bf16_t* __restrict__ MP, int row0, int t0, int ch) {
    typedef unsigned v4u_ __attribute__((ext_vector_type(4)));
    constexpr int NR = R + W - 1, LO = W / 2;
    v4u_ v[NR];
#pragma unroll
    for (int r = 0; r < NR; ++r) { const int t = t0 - LO + r; v[r] = (t >= 0 && t < SEQ) ? *(const v4u_*)(UG + (size_t)(row0 - LO + r) * 2048 + ch) : (v4u_){0u, 0u, 0u, 0u}; }
    float S[8];
#pragma unroll
    for (int i = 0; i < 8; ++i) S[i] = 0.f;
#pragma unroll
    for (int r = 0; r < W; ++r)
#pragma unroll
        for (int i = 0; i < 4; ++i) { S[2 * i] += __uint_as_float(v[r][i] << 16); S[2 * i + 1] += __uint_as_float(v[r][i] & 0xffff0000u); }
#pragma unroll
    for (int r = 0; r < R; ++r) { const int t = t0 + r; int lo = t - LO; if (lo < 0) lo = 0; int hi = t + (W - LO - 1); if (hi > SEQ - 1) hi = SEQ - 1;
        const float inv = 1.f / (float)(hi - lo + 1); v4u_ o;
#pragma unroll
        for (int i = 0; i < 4; ++i) { const float u0 = __uint_as_float(v[r + LO][i] << 16), u1 = __uint_as_float(v[r + LO][i] & 0xffff0000u);
            o[i] = pk2(S[2 * i] * inv - u0, S[2 * i + 1] * inv - u1); }
        *(v4u_*)(MP + (size_t)(row0 + r) * 1024 + ch) = o;
        if (r < R - 1) {
#pragma unroll
            for (int i = 0; i < 4; ++i) { S[2 * i] += __uint_as_float(v[r + W][i] << 16) - __uint_as_float(v[r][i] << 16); S[2 * i + 1] += __uint_as_float(v[r + W][i] & 0xffff0000u) - __uint_as_float(v[r][i] & 0xffff0000u); } } }
}
__device__ __forceinline__ void ph_pool(const Ptrs& P) {
    const bf16_t* UG = (const bf16_t*)(P.ws + WS_Q); bf16_t* MP = (bf16_t*)(P.ws + WS_H);
    GSTRIDE(idx, (long)(ML / 32) * 4 * 64) {
        const int cg = (int)(idx & 31), rsub = (int)((idx >> 5) & 1), g = (int)((idx >> 6) & 3), rp = (int)(idx >> 8);
        const int row0 = rp * 32 + rsub * 16, t0 = row0 & (SEQ - 1), ch = g * 256 + cg * 8;
        if (g == 0) pool_item<2, 16>(UG, MP, row0, t0, ch); else if (g == 1) pool_item<4, 16>(UG, MP, row0, t0, ch); else if (g == 2) pool_item<8, 16>(UG, MP, row0, t0, ch);
        else { pool_item<16, 8>(UG, MP, row0, t0, ch); asm volatile("" ::: "memory"); pool_item<16, 8>(UG, MP, row0 + 8, t0 + 8, ch); }
    }
}
__device__ __forceinline__ void ph_final(const Ptrs& P) {
    const int lane = TIDX & 63, gw = blockIdx.x * (NT / 64) + (TIDX >> 6), NGW = gridDim.x * (NT / 64);
    f32x4 nx[4]; f32x4 fw[4];
#pragma unroll
    for (int j = 0; j < 4; ++j) fw[j] = *(const f32x4*)(P.final_norm + 4 * lane + 256 * j);
    if (gw < ML) {
#pragma unroll
        for (int j = 0; j < 4; ++j) nx[j] = *(const f32x4*)(P.out + (size_t)gw * DM + 4 * lane + 256 * j); }
    for (int row = gw; row < ML; row += NGW) {
        float* xr = P.out + (size_t)row * DM; f32x4 xv[4]; float ss = 0.f;
#pragma unroll
        for (int j = 0; j < 4; ++j) xv[j] = nx[j];
        if (row + NGW < ML) {
#pragma unroll
            for (int j = 0; j < 4; ++j) nx[j] = *(const f32x4*)(xr + (size_t)NGW * DM + 4 * lane + 256 * j); }
#pragma unroll
        for (int j = 0; j < 4; ++j) ss += (xv[j].x * xv[j].x + xv[j].y * xv[j].y) + (xv[j].z * xv[j].z + xv[j].w * xv[j].w);
        ss = wave_sum(ss);
        const float rstd = rsqrtf(ss * (1.f / DM) + RMS_EPS);
#pragma unroll
        for (int j = 0; j < 4; ++j) { const int k = 4 * lane + 256 * j; *(f32x4*)(xr + k) = xv[j] * rstd * fw[j]; }
    }
}


template <int W, int R> __device__ __forceinline__ void pool_to_lds(const bf16_t* __restrict__ UG, int grow0, int t0, int ch, LAS unsigned char* dst, int r0, int cc) {
    typedef unsigned v4u_ __attribute__((ext_vector_type(4)));
    constexpr int NR = R + W - 1, LO = W / 2;
    v4u_ v[NR];
#pragma unroll
    for (int r = 0; r < NR; ++r) { const int t = t0 - LO + r; v[r] = (t >= 0 && t < SEQ) ? *(const v4u_*)(UG + (size_t)(grow0 - LO + r) * 2048 + ch) : (v4u_){0u, 0u, 0u, 0u}; }
    float S[8];
#pragma unroll
    for (int i = 0; i < 8; ++i) S[i] = 0.f;
#pragma unroll
    for (int r = 0; r < W; ++r)
#pragma unroll
        for (int i = 0; i < 4; ++i) { S[2 * i] += __uint_as_float(v[r][i] << 16); S[2 * i + 1] += __uint_as_float(v[r][i] & 0xffff0000u); }
#pragma unroll
    for (int r = 0; r < R; ++r) { const int t = t0 + r; int lo = t - LO; if (lo < 0) lo = 0; int hi = t + (W - LO - 1); if (hi > SEQ - 1) hi = SEQ - 1;
        const float inv = 1.f / (float)(hi - lo + 1); v4u_ o;
#pragma unroll
        for (int i = 0; i < 4; ++i) { const float u0 = __uint_as_float(v[r + LO][i] << 16), u1 = __uint_as_float(v[r + LO][i] & 0xffff0000u);
            o[i] = pk2f(S[2 * i] * inv - u0, S[2 * i + 1] * inv - u1); }
        *(LAS v4u_*)(dst + pg8::lds_byte(r0 + r, cc)) = o;
        if (r < R - 1) {
#pragma unroll
            for (int i = 0; i < 4; ++i) { S[2 * i] += __uint_as_float(v[r + W][i] << 16) - __uint_as_float(v[r][i] << 16); S[2 * i + 1] += __uint_as_float(v[r + W][i] & 0xffff0000u) - __uint_as_float(v[r][i] & 0xffff0000u); } } }
}
__device__ __forceinline__ void ph_pool_lin_fused(const Ptrs& P, LAS unsigned char* L) {
    using pg8::f32x4; using pg8::bf16x8;
    const bf16_t* UG = (const bf16_t*)(P.ws + WS_Q); const bf16_t* Wtl = (const bf16_t*)(P.ws + WS_WTL); bf16_t* T = (bf16_t*)(P.ws + WS_U);
    pg8::StaticOrder S; S.init(ML, 1024, (int)gridDim.x, (int)blockIdx.x);
    const pg8::EpiPL E{T, UG};
    pg8::Unit u;
    for (int ui = 0; S.next(ui, u); ++ui) {
        int tid_ = TIDX; asm volatile("" : "+v"(tid_));
        const int tid = tid_, wid = __builtin_amdgcn_readfirstlane(tid >> 6), lane = tid & 63, wr = wid >> 2, wc = wid & 3, fr = lane & 15, fq = lane >> 4;
        const int g = u.pn;
        { const int chunk = tid & 31, run = tid >> 5; const int kt = chunk >> 3, cc = (chunk & 7) * 8, ai = run >> 3, r0 = (run & 7) * 16;
          const int grow0 = u.pm * 256 + run * 16, t0 = grow0 & (SEQ - 1), ch = g * 256 + chunk * 8;
          LAS unsigned char* dst = L + (ai * 4 + kt) * 16384;
          if (g == 0) pool_to_lds<2, 16>(UG, grow0, t0, ch, dst, r0, cc); else if (g == 1) pool_to_lds<4, 16>(UG, grow0, t0, ch, dst, r0, cc); else if (g == 2) pool_to_lds<8, 16>(UG, grow0, t0, ch, dst, r0, cc);
          else { pool_to_lds<16, 8>(UG, grow0, t0, ch, dst, r0, cc); asm volatile("" ::: "memory"); pool_to_lds<16, 8>(UG, grow0 + 8, t0 + 8, ch, dst, r0 + 8, cc); } }
        __syncthreads();
        f32x4 acc[2][2][4][2];
#pragma unroll
        for (int a = 0; a < 2; ++a)
#pragma unroll
            for (int b = 0; b < 2; ++b)
#pragma unroll
                for (int m = 0; m < 4; ++m)
#pragma unroll
                    for (int n = 0; n < 2; ++n) acc[a][b][m][n] = (f32x4){0.f, 0.f, 0.f, 0.f};
        const int aoff = pg8::lds_byte(wr * 64 + fr, fq * 8);
        const bf16_t* Bg = Wtl + (size_t)(g * 256) * 256 + fq * 8;
        const int brow = 32 * wc + 8 * (fr >> 2) + (fr & 3);
#pragma unroll 1
        for (int kt = 0; kt < 4; ++kt) {
            bf16x8 Bf[2][2][2];
#pragma unroll
            for (int bj = 0; bj < 2; ++bj)
#pragma unroll
                for (int n = 0; n < 2; ++n)
#pragma unroll
                    for (int k = 0; k < 2; ++k) Bf[bj][n][k] = *(const bf16x8*)(Bg + (size_t)(128 * bj + brow + 4 * n) * 256 + kt * 64 + k * 32);
#pragma unroll
            for (int ai = 0; ai < 2; ++ai) { bf16x8 At[4][2];
#pragma unroll
                for (int m = 0; m < 4; ++m)
#pragma unroll
                    for (int k = 0; k < 2; ++k) At[m][k] = *(const LAS bf16x8*)(L + (ai * 4 + kt) * 16384 + aoff + m * 2048 + k * 1024);
#pragma unroll
                for (int bj = 0; bj < 2; ++bj)
#pragma unroll
                    for (int m = 0; m < 4; ++m)
#pragma unroll
                        for (int n = 0; n < 2; ++n)
#pragma unroll
                            for (int k = 0; k < 2; ++k) acc[ai][bj][m][n] = __builtin_amdgcn_mfma_f32_16x16x32_bf16(Bf[bj][n][k], At[m][k], acc[ai][bj][m][n], 0, 0, 0); }
        }
        E(acc, u, wr, wc, fr, fq);
        __syncthreads();
    }
}

#ifndef ATTN_PROBE
#define ATTN_PROBE 0
#endif
struct Args { const float* in[24]; float* out; char* ws; int ph_lo, ph_hi; };
constexpr int N_PHASES = 15;
__global__ void __launch_bounds__(NT, 2) mk_fwd(Args a) {
    unsigned char* lds = g_lds;
    LAS unsigned char* L = (LAS unsigned char*)lds;
    for (int u = threadIdx.x; u < (LDS_BYTES - LDSCTL_OFF) / 4; u += NT) ((LAS unsigned*)(L + LDSCTL_OFF))[u] = 0u;
    __syncthreads();
    if ((threadIdx.x & 63) == 0) ((LAS int*)(L + WIDTAB_OFF))[hw_slot_()] = (int)(threadIdx.x >> 6);
    __syncthreads();
    Ptrs P;
    P.x = a.in[0]; P.c = a.in[1]; P.ctx = a.in[2]; P.c_ctx = a.in[3]; P.mod_w = a.in[4]; P.mod_b = a.in[5]; P.norm_w = a.in[6]; P.w_in_mix = a.in[7];
    P.q_norm = a.in[8]; P.w_uq = a.in[9]; P.kv_norm = a.in[10]; P.w_ukv = a.in[11]; P.conv_w = a.in[12]; P.conv_b = a.in[13]; P.a_log = a.in[14];
    P.dt_bias = a.in[15]; P.d_skip = a.in[16]; P.ssd_norm = a.in[17]; P.w_out_mix = a.in[18]; P.w_in_pool = a.in[19]; P.pool_lin = a.in[20];
    P.pool_scale = a.in[21]; P.w_out_pool = a.in[22]; P.final_norm = a.in[23]; P.out = a.out; P.ws = a.ws;
    unsigned* ctl = (unsigned*)(a.ws + WS_CTL);
    const bool one_launch = (a.ph_hi - a.ph_lo) > 1;
    XcdBarrier bar; bar.bar = ctl + CW_BAR; bar.x = 0; bar.st = nullptr;
    if (one_launch) bar = xcd_barrier_post(ctl + CW_BAR, (volatile LAS unsigned*)(L + MISC_OFF) + 8);
    const int lo = a.ph_lo, hi = a.ph_hi;
#define IN(k) (lo <= (k) && (k) < hi)
#define SEAM(k) do { if (IN(k) && IN((k) + 1)) xcd_barrier(bar); } while (0)
    float* MODV = (float*)(a.ws + WS_MODV);
    bf16_t* H = (bf16_t*)(a.ws + WS_H); bf16_t* PROJ = (bf16_t*)(a.ws + WS_PROJ); float* X1 = (float*)(a.ws + WS_PROJ);
    bf16_t* UG = (bf16_t*)(a.ws + WS_Q); bf16_t* T = (bf16_t*)(a.ws + WS_U); bf16_t* CAT = (bf16_t*)a.out;
    if (IN(0)) { ph_modvec(P, L); } SEAM(0);
    if (IN(1)) { ph_weights(P, L); ph_norm_mod<true>(P.x, P.ctx, MT, P.norm_w, MODV, H); } SEAM(1);
    if (IN(2)) { pg8::Gemm g{H, (const bf16_t*)(a.ws + WS_WT1), MT, 2560, 1024, 1024, 0}; pg8::StaticOrder S; S.init(MT, 2560, (int)gridDim.x, (int)blockIdx.x);
        pg8::EpiProjM E{PROJ, (float*)(a.ws + WS_SS), (float*)(a.ws + WS_DT)};
        pg8::gemm_phase<pg8::EpiProjM, pg8::StaticOrder, true, true>(L, g, S, E); } SEAM(2);
    if (IN(3)) {
        { pg8::Gemm g{PROJ + C_QA, (const bf16_t*)(a.ws + WS_WTQ), ML, 768, 384, PN, 0}; pg8::StaticOrder S; S.init(ML, 768, (int)gridDim.x, (int)blockIdx.x);
          pg8::EpiQ E{(bf16_t*)(a.ws + WS_Q), (const float*)(a.ws + WS_SS), (const float*)(a.ws + WS_COS), (const float*)(a.ws + WS_SIN)};
          pg8::gemm_phase<pg8::EpiQ, pg8::StaticOrder, true, true>(L, g, S, E); }
        { pg8::Gemm g{PROJ + C_KVA, (const bf16_t*)(a.ws + WS_WTKV), MT, 1024, 256, PN, 0}; pg8::StaticOrder S; S.init(MT, 1024, (int)gridDim.x, (int)((blockIdx.x + gridDim.x / 2) % gridDim.x));
          pg8::EpiKV E{(bf16_t*)(a.ws + WS_K), (bf16_t*)(a.ws + WS_V), (const float*)(a.ws + WS_SS)};
          pg8::gemm_phase<pg8::EpiKV, pg8::StaticOrder, true, true>(L, g, S, E); }
        ph_upproj(P); } SEAM(3);
    if (IN(4)) { ph_ssd_states(P, lds); } SEAM(4);
    if (IN(5)) { ph_ssd_chunkscan(P); ph_attn_mfma<ATTN_PROBE>(P, lds); if (ATTN_PROBE != 0) ph_attn_mfma<0>(P, lds); } SEAM(5);
    if (IN(6)) { ph_ssd_out(P, lds); } SEAM(6);
    const bool fusedn = gridDim.x == 256 && one_launch;
    if (IN(8)) {
        if (fusedn) {
#pragma unroll 1
            for (int half = 0; half < 2; ++half) { pg8::Gemm g{CAT + (size_t)half * 16384 * 1024, (const bf16_t*)(a.ws + WS_WTO), 16384, 1024, 1024, 1024, 0}; pg8::StaticOrder S; S.init(16384, 1024, (int)gridDim.x, (int)blockIdx.x);
                pg8::PanelRms st{(unsigned*)(a.ws + WS_XB), ctl + CW_PANEL, half * 64, RMS_EPS};
                pg8::EpiResNorm E{P.x, MODV, (_Float16*)X1, H, P.norm_w + DM, MODV + 5 * 3072, st, SEQ, 0};
                pg8::gemm_phase<pg8::EpiResNorm, pg8::StaticOrder, false, true>(L, g, S, E); __syncthreads(); }
        } else {
            pg8::Gemm g{CAT, (const bf16_t*)(a.ws + WS_WTO), ML, 1024, 1024, 1024, 0}; pg8::StaticOrder S; S.init(ML, 1024, (int)gridDim.x, (int)blockIdx.x);
            pg8::EpiResM E{P.x, MODV, X1, SEQ, 0};
            pg8::gemm_phase<pg8::EpiResM, pg8::StaticOrder, true, true>(L, g, S, E); } } SEAM(8);
    if (IN(9) && !fusedn) { ph_norm_mod<false>(X1, nullptr, ML, P.norm_w + DM, MODV + 5 * 3072, H); } if (!fusedn) SEAM(9);
    if (IN(10)) { pg8::Gemm g{H, (const bf16_t*)(a.ws + WS_WTP), ML, 2048, 1024, 1024, 0}; pg8::StaticOrder S; S.init(ML, 2048, (int)gridDim.x, (int)blockIdx.x);
        pg8::EpiBf16<0> E{UG, 2048, nullptr, 0, 0, 1.f};
        pg8::gemm_phase<pg8::EpiBf16<0>, pg8::StaticOrder, true, true>(L, g, S, E); } SEAM(10);
    if (IN(11)) { ph_pool_lin_fused(P, L); } SEAM(11);
    if (IN(13)) {
        if (fusedn) {
#pragma unroll 1
            for (int half = 0; half < 2; ++half) { pg8::Gemm g{T + (size_t)half * 16384 * 1024, (const bf16_t*)(a.ws + WS_WTOP), 16384, 1024, 1024, 1024, 0}; pg8::StaticOrder S; S.init(16384, 1024, (int)gridDim.x, (int)blockIdx.x);
                pg8::PanelRms st{(unsigned*)(a.ws + WS_XB) + 32768 * 4, ctl + CW_PANEL + 8192, half * 64, RMS_EPS};
                pg8::EpiResFinal E{(const _Float16*)X1, MODV + 5 * 3072, P.out, P.final_norm, st, SEQ, 0};
                pg8::gemm_phase<pg8::EpiResFinal, pg8::StaticOrder, false, true>(L, g, S, E); __syncthreads(); }
        } else {
            pg8::Gemm g{T, (const bf16_t*)(a.ws + WS_WTOP), ML, 1024, 1024, 1024, 0}; pg8::StaticOrder S; S.init(ML, 1024, (int)gridDim.x, (int)blockIdx.x);
            pg8::EpiResM E{X1, MODV + 5 * 3072, P.out, SEQ, 0};
            pg8::gemm_phase<pg8::EpiResM, pg8::StaticOrder, true, true>(L, g, S, E); } } if (!fusedn) SEAM(13);
    if (IN(14) && !fusedn) { ph_final(P); }
#undef IN
#undef SEAM
}

#ifndef MK_PER_PHASE
#define MK_PER_PHASE 0
#endif
extern "C" void kernel_launch(void* const* d_in, const int* in_sizes, int n_in, void* d_out, int out_size, void* d_ws, size_t ws_size, hipStream_t stream) {
    static int grid = 0;
    if (grid == 0) {
        if (n_in != 24 || out_size != ML * DM || ws_size < WS_END) { fprintf(stderr, "kernel_launch: unexpected shapes n_in %d out %d ws %zu\n", n_in, out_size, ws_size); grid = -1; return; }
        int dev = 0, cus = 0;
        if (hipGetDevice(&dev) != hipSuccess || hipDeviceGetAttribute(&cus, hipDeviceAttributeMultiprocessorCount, dev) != hipSuccess) { grid = -1; return; }
        if (hipFuncSetAttribute((const void*)mk_fwd, hipFuncAttributeMaxDynamicSharedMemorySize, LDS_BYTES) != hipSuccess) { fprintf(stderr, "kernel_launch: hipFuncSetAttribute failed\n"); grid = -1; return; }
        grid = cus;
    }
    if (grid < 0) return;
    (void)hipMemsetAsync((char*)d_ws + WS_CTL, 0, CTL_ZERO_BYTES, stream);
    Args a{};
    for (int i = 0; i < 24; ++i) a.in[i] = (const float*)d_in[i];
    a.out = (float*)d_out; a.ws = (char*)d_ws;
#if MK_PER_PHASE
    for (int p = 0; p < N_PHASES; ++p) { a.ph_lo = p; a.ph_hi = p + 1; hipLaunchKernelGGL(mk_fwd, dim3(grid), dim3(NT), LDS_BYTES, stream, a); }
#else
    a.ph_lo = 0; a.ph_hi = N_PHASES;
    hipLaunchKernelGGL(mk_fwd, dim3(grid), dim3(NT), LDS_BYTES, stream, a);
#endif
}
```

```cpp
#include <hip/hip_runtime.h>
#include <cstdint>
#include <cstdio>

typedef unsigned short bf16_t;
#define LAS __attribute__((address_space(3)))
__device__ __forceinline__ float bf2f(bf16_t v) { return __uint_as_float(((unsigned)v) << 16); }
typedef float f32x2_c __attribute__((ext_vector_type(2))); typedef __bf16 bf16x2_c __attribute__((ext_vector_type(2)));
__device__ __forceinline__ unsigned pk2f(float lo, float hi) { f32x2_c v = {lo, hi}; return __builtin_bit_cast(unsigned, __builtin_convertvector(v, bf16x2_c)); }
__device__ __forceinline__ bf16_t f2bf(float f) { return (bf16_t)(pk2f(f, 0.f) & 0xffffu); }
__device__ __forceinline__ float siluf(float x) { return x * __builtin_amdgcn_rcpf(1.f + __expf(-x)); }
__device__ __forceinline__ float softplusf(float x) { return fmaxf(x, 0.f) + log1pf(__expf(-fabsf(x))); }

constexpr int NB = 4, SEQ = 8192, DM = 1024, CTXL = 256, NKEY = SEQ + CTXL;
constexpr int ML = NB * SEQ, MC = NB * CTXL, MT = ML + MC;
constexpr int PN = 2560;
constexpr int C_QA = 0, C_KVA = 384, C_KPE = 640, C_GA = 672, C_Z = 1184, C_XBC = 1696, C_DT = 2464;
constexpr float RMS_EPS = 1e-6f;
constexpr float QSCALE = 0.10206207261596575f * 1.4426950408889634f;
constexpr int NT = 512;

constexpr size_t MiB = 1u << 20;
constexpr size_t WS_CTL = 0, CTL_ZERO_BYTES = 128 * 1024;
constexpr size_t WS_MODV = 1 * MiB;
constexpr size_t WS_COS = 3 * MiB, WS_SIN = 3 * MiB + 512 * 1024;
constexpr size_t WS_WT1 = 4 * MiB;
constexpr size_t WS_WTQ = 9 * MiB;
constexpr size_t WS_WTKV = 10 * MiB;
constexpr size_t WS_WTO = 11 * MiB;
constexpr size_t WS_WTP = 13 * MiB;
constexpr size_t WS_WTL = 17 * MiB;
constexpr size_t WS_WTOP = 18 * MiB;
constexpr size_t WS_H = 20 * MiB;
constexpr size_t WS_PROJ = 86 * MiB;
constexpr size_t WS_SS = 251 * MiB;
constexpr size_t WS_DT = 254 * MiB;
constexpr size_t WS_Q = 257 * MiB;
constexpr size_t WS_K = 305 * MiB;
constexpr size_t WS_V = 355 * MiB;
constexpr size_t WS_U = 388 * MiB;
constexpr size_t WS_DTS = 438 * MiB;
constexpr size_t WS_SST = 441 * MiB;
constexpr size_t WS_CD = 1 * MiB + 512 * 1024;
constexpr size_t WS_END = 507 * MiB;
constexpr int CW_PANEL = 16384;
constexpr size_t WS_XB = 2 * MiB;
constexpr int CW_BAR = 4096;

constexpr int RING_BYTES = 131072, LDSCTL_OFF = RING_BYTES, MISC_OFF = LDSCTL_OFF + 320, LDS_BYTES = 147456;


extern __shared__ __attribute__((aligned(16))) unsigned char g_lds[];
constexpr int WIDTAB_OFF = LDSCTL_OFF + 64;
__device__ __forceinline__ int lane_id_() { return (int)__builtin_amdgcn_mbcnt_hi(~0u, __builtin_amdgcn_mbcnt_lo(~0u, 0u)); }
__device__ __forceinline__ int hw_slot_() { return (int)(__builtin_amdgcn_s_getreg((5 << 11) | 4) & 0x3Fu); }
__device__ __forceinline__ int wave_id_() { return __builtin_amdgcn_readfirstlane(((volatile LAS int*)((LAS unsigned char*)g_lds + WIDTAB_OFF))[hw_slot_()]); }
#define TIDX (wave_id_() * 64 + lane_id_())

#define XB_TMO      128
#define XB_XCNT(j)  (256  + 64 * (j))
#define XB_XSUB(j)  (1280 + 64 * (j))
#define XB_XGEN(j)  (2304 + 64 * (j))
#define XB_TOP      3328
#define XB_TOPGEN   3392
#define XCD_BAR_WORDS 3456
#define XB_SPIN_CAP (1u << 18)
__device__ __forceinline__ unsigned xb_ld(unsigned* p)              { return __hip_atomic_load(p, __ATOMIC_RELAXED, __HIP_MEMORY_SCOPE_AGENT); }
__device__ __forceinline__ unsigned xb_add(unsigned* p, unsigned v) { return __hip_atomic_fetch_add(p, v, __ATOMIC_RELAXED, __HIP_MEMORY_SCOPE_AGENT); }
__device__ __forceinline__ unsigned xb_xcc_id() { return (unsigned)__builtin_amdgcn_s_getreg((3 << 11) | 20) & 0xFu; }
#define XB_SPIN(cond, bar) do { unsigned _sp = 0; while (cond) { __builtin_amdgcn_s_sleep(1); \
    if ((++_sp & 255u) == 0u) { if (xb_ld(&(bar)[XB_TMO])) break; if (_sp > XB_SPIN_CAP) { atomicAdd(&(bar)[XB_TMO], 1u); break; } } } } while (0)
struct XcdBarrier { unsigned* bar; unsigned x; volatile LAS unsigned* st; };
__device__ __forceinline__ XcdBarrier xcd_barrier_post(unsigned* bar, volatile LAS unsigned* st) {
    XcdBarrier b; b.bar = bar; b.x = xb_xcc_id(); b.st = st;
    if (TIDX == 0) (void)xb_add(&bar[XB_XCNT(b.x)], 1u);
    return b;
}
__device__ __forceinline__ void xcd_barrier_complete(unsigned* bar, unsigned x, unsigned& nloc, unsigned& nx) {
    const unsigned G = gridDim.x * gridDim.y * gridDim.z;
    unsigned sum, cnt, mine, sp = 0u;
    for (;;) {
        sum = 0u; cnt = 0u; mine = 0u;
#pragma unroll
        for (unsigned j = 0; j < 16; ++j) { const unsigned c = xb_ld(&bar[XB_XCNT(j)]); sum += c; cnt += (c > 0u) ? 1u : 0u; mine = (j == x) ? c : mine; }
        if (sum == G) break;
        __builtin_amdgcn_s_sleep(1);
        if ((++sp & 255u) == 0u) { if (xb_ld(&bar[XB_TMO])) break; if (sp > XB_SPIN_CAP) { atomicAdd(&bar[XB_TMO], 1u); break; } }
    }
    nloc = mine > 0u ? mine : 1u; nx = cnt > 0u ? cnt : 1u;
}
__device__ __forceinline__ void xcd_barrier(const XcdBarrier& b) {
    asm volatile("s_waitcnt vmcnt(0)" ::: "memory");
    __syncthreads();
    if (TIDX == 0) {
        unsigned* bar = b.bar;
        __builtin_amdgcn_s_waitcnt(0);
        unsigned nloc = b.st[0], nx = b.st[1];
        if (nloc == 0u) { xcd_barrier_complete(bar, b.x, nloc, nx); b.st[0] = nloc; b.st[1] = nx; }
        const unsigned old = xb_add(&bar[XB_XSUB(b.x)], 1u);
        const unsigned gen = old / nloc;
        if (old + 1u == (gen + 1u) * nloc) {
            __builtin_amdgcn_fence(__ATOMIC_RELEASE, "agent");
            asm volatile("s_waitcnt vmcnt(0)" ::: "memory");
            const unsigned og = xb_add(&bar[XB_TOP], 1u);
            const unsigned tg = og / nx;
            if (og + 1u == (tg + 1u) * nx) xb_add(&bar[XB_TOPGEN], 1u);
            else XB_SPIN(xb_ld(&bar[XB_TOPGEN]) == tg, bar);
            __builtin_amdgcn_fence(__ATOMIC_ACQUIRE, "agent");
            xb_add(&bar[XB_XGEN(b.x)], 1u);
            asm volatile("s_waitcnt vmcnt(0)" ::: "memory");
        } else {
            XB_SPIN(xb_ld(&bar[XB_XGEN(b.x)]) == gen, bar);
            __builtin_amdgcn_fence(__ATOMIC_ACQUIRE, "agent");
            asm volatile("s_waitcnt vmcnt(0)" ::: "memory");
        }
    }
    __syncthreads();
}

__device__ __forceinline__ void row_info(int row, int& b, int& t, bool& isctx) {
    if (row < ML) { b = row / SEQ; t = row % SEQ; isctx = false; } else { int rc = row - ML; b = rc / CTXL; t = rc % CTXL; isctx = true; }
}
__device__ __forceinline__ float wave_sum(float v) {
#define WS_SWZ(x, k) __int_as_float(__builtin_amdgcn_ds_swizzle(__float_as_int(x), 0x1F | ((k) << 10)))
    v += WS_SWZ(v, 1); v += WS_SWZ(v, 2); v += WS_SWZ(v, 4); v += WS_SWZ(v, 8); v += WS_SWZ(v, 16);
#undef WS_SWZ
    auto rr = __builtin_amdgcn_permlane32_swap(__float_as_uint(v), __float_as_uint(v), false, false);
    return __uint_as_float(rr[0]) + __uint_as_float(rr[1]);
}
typedef float f32x4 __attribute__((ext_vector_type(4)));
#define GSTRIDE(idx, n) for (long idx = (long)blockIdx.x * NT + TIDX; idx < (long)(n); idx += (long)gridDim.x * NT)

namespace pg8 {
#define PG8_LAS __attribute__((address_space(3)))
typedef unsigned short bf16_t;
typedef short bf16x8 __attribute__((ext_vector_type(8)));
typedef float f32x4 __attribute__((ext_vector_type(4)));
typedef unsigned u32x4 __attribute__((ext_vector_type(4)));
constexpr int BM = 256, BK = 64, HALF = 128, HTB = HALF * BK * 2  , STAGE_BYTES = 8 * HTB, NXCD = 8, WGM = 8;

__host__ __device__ __forceinline__ int lds_byte(int r, int c) { const int st = (r >> 4) * 2 + (c >> 5), rr = r & 15, cc = c & 31, ob = rr * 64 + cc * 2; return st * 1024 + (ob ^ (((ob >> 9) & 1) << 5)); }
__host__ __device__ __forceinline__ void stage_rc(int b, int& R, int& C) { const int st = b / 1024, sb = b % 1024, swz = sb ^ (((sb >> 9) & 1) << 5); R = (st >> 1) * 16 + swz / 64; C = (st & 1) * 32 + (swz % 64) / 2; }
__host__ __device__ __forceinline__ int perm32(int rho) { const int n = rho >> 4, i = rho & 15; return 8 * (i >> 2) + 4 * n + (i & 3); }

struct Unit { int pm, pn; };
struct Gemm { const bf16_t* A; const bf16_t* Bt; int M, N, K, lda, a_pn_off; };

struct StaticOrder {
    int nM, nN, nwg, G, c;
    __host__ __device__ void init(int M, int N, int G_, int c_) { nM = M / BM; nN = N / BM; nwg = nM * nN; G = G_; c = c_; }
    __host__ __device__ bool next(int i, Unit& u) const {
        const long L = (long)i * G + c; if (L >= nwg) return false;
        int wgid = (int)L; { const int q = nwg / NXCD, r = nwg % NXCD, xcd = wgid % NXCD, off = wgid / NXCD; wgid = (xcd < r ? xcd * (q + 1) : r * (q + 1) + (xcd - r) * q) + off; }
        const int nig = WGM * nN, gid = wgid / nig, fm = gid * WGM, gsz = (nM - fm) < WGM ? (nM - fm) : WGM;
        u.pm = fm + ((wgid % nig) % gsz); u.pn = (wgid % nig) / gsz; return true;
    }
    __device__ __forceinline__ void a_ready(const Unit&) const {}
    __device__ __forceinline__ void done(const Unit&) const {}
};

__device__ __forceinline__ unsigned cvt_pk_bf16(float lo, float hi) { unsigned r; asm volatile("v_cvt_pk_bf16_f32 %0, %1, %2" : "=v"(r) : "v"(lo), "v"(hi)); return r; }
typedef float f32x2 __attribute__((ext_vector_type(2)));
__device__ __forceinline__ f32x2 gelu_pk(f32x2 v) {
    const f32x2 av = __builtin_elementwise_abs(v), d = av * 0.2316418882f + 1.0f;
    f32x2 t; t.x = __builtin_amdgcn_rcpf(d.x); t.y = __builtin_amdgcn_rcpf(d.y);
    f32x2 q = t * 0.5307027145f + (-0.7265760135f); q = q * t + 0.7107068705f; q = q * t + (-0.142248368f); q = q * t + 0.127414796f; q = q * t;
    const f32x2 s = (v * v) * (-0.72134752044f);
    f32x2 e; e.x = __builtin_amdgcn_exp2f(s.x); e.y = __builtin_amdgcn_exp2f(s.y);
    const f32x2 m = v * (q * e), r = v - m;
    f32x2 o; o.x = v.x < 0.f ? m.x : r.x; o.y = v.y < 0.f ? m.y : r.y; return o;
}

template <int ACT  > struct EpiBf16 {
    static constexpr bool PERM = true, AFTER_DRAIN = false; static_assert(ACT == 0 || ACT == 1, "EpiBf16: ACT is 0 (none) or 1 (gelu_pk)");
    bf16_t* O; int ldc; const float* bias; int split_cols; size_t split_stride; float scale0;
    __device__ __forceinline__ void operator()(const f32x4 (&acc)[2][2][4][2], const Unit& u, int wr, int wc, int fr, int fq) const {
        const int row0 = u.pm * BM + wr * 64 + fr; int colt = u.pn * BM; bf16_t* base = O;
        float sc = 1.f; if (split_cols) { const int t = colt / split_cols; base += (size_t)t * split_stride; colt -= t * split_cols; if (t == 0) sc = scale0; }
        const int col0 = colt + wc * 32 + 8 * fq, bcol0 = u.pn * BM + wc * 32 + 8 * fq;
        f32x4 bv[2][2];
#pragma unroll
        for (int bj = 0; bj < 2; ++bj)
#pragma unroll
            for (int n = 0; n < 2; ++n) bv[bj][n] = bias ? *(const f32x4*)(bias + bcol0 + bj * HALF + 4 * n) : (f32x4){0.f, 0.f, 0.f, 0.f};
#pragma unroll
        for (int ai = 0; ai < 2; ++ai)
#pragma unroll
            for (int m = 0; m < 4; ++m) { bf16_t* rowp = base + (size_t)(row0 + ai * HALF + m * 16) * ldc + col0;
#pragma unroll
                for (int bj = 0; bj < 2; ++bj) { f32x4 v0 = acc[ai][bj][m][0] + bv[bj][0], v1 = acc[ai][bj][m][1] + bv[bj][1];
                    if (ACT == 1) { f32x2 a = gelu_pk((f32x2){v0[0], v0[1]}), b = gelu_pk((f32x2){v0[2], v0[3]}), c = gelu_pk((f32x2){v1[0], v1[1]}), d = gelu_pk((f32x2){v1[2], v1[3]});
                        v0 = (f32x4){a.x, a.y, b.x, b.y}; v1 = (f32x4){c.x, c.y, d.x, d.y}; }
                    v0 = v0 * sc; v1 = v1 * sc; u32x4 w; w.x = cvt_pk_bf16(v0[0], v0[1]); w.y = cvt_pk_bf16(v0[2], v0[3]); w.z = cvt_pk_bf16(v1[0], v1[1]); w.w = cvt_pk_bf16(v1[2], v1[3]);
                    *(u32x4*)(rowp + bj * HALF) = w; } }
    }
};

struct EpiProjM { static constexpr bool PERM = true, AFTER_DRAIN = false;
    bf16_t* O; float* SS; float* DT;
    __device__ __forceinline__ void operator()(const f32x4 (&acc)[2][2][4][2], const Unit& u, int wr, int wc, int fr, int fq) const {
        const int row0 = u.pm * BM + wr * 64 + fr, colt = u.pn * BM, col0 = colt + wc * 32 + 8 * fq;
#pragma unroll
        for (int ai = 0; ai < 2; ++ai)
#pragma unroll
            for (int m = 0; m < 4; ++m) { const int row = row0 + ai * HALF + m * 16; bf16_t* rowp = O + (size_t)row * 2560 + col0;
#pragma unroll
                for (int bj = 0; bj < 2; ++bj) { const f32x4 v0 = acc[ai][bj][m][0], v1 = acc[ai][bj][m][1];
                    u32x4 w; w.x = cvt_pk_bf16(v0[0], v0[1]); w.y = cvt_pk_bf16(v0[2], v0[3]); w.z = cvt_pk_bf16(v1[0], v1[1]); w.w = cvt_pk_bf16(v1[2], v1[3]);
                    *(u32x4*)(rowp + bj * HALF) = w;
                    const int cs = colt + bj * HALF + wc * 32;
                    if (cs < 640) { float q = (v0[0] * v0[0] + v0[1] * v0[1]) + (v0[2] * v0[2] + v0[3] * v0[3]) + (v1[0] * v1[0] + v1[1] * v1[1]) + (v1[2] * v1[2] + v1[3] * v1[3]);
                        q += __shfl_xor(q, 16); q += __shfl_xor(q, 32); if (fq == 0) SS[(size_t)row * 20 + (cs >> 5)] = q; }
                    if (cs == 2464 && fq < 2) { *(f32x4*)(DT + (size_t)row * 16 + 8 * fq) = v0; *(f32x4*)(DT + (size_t)row * 16 + 8 * fq + 4) = v1; } } }
    }
};

struct EpiQ { static constexpr bool PERM = true, AFTER_DRAIN = false;
    bf16_t* Q; const float* SS; const float* COS; const float* SIN;
    __device__ __forceinline__ void operator()(const f32x4 (&acc)[2][2][4][2], const Unit& u, int wr, int wc, int fr, int fq) const {
        asm volatile("" : "+v"(fr), "+v"(fq));
        const int row0 = u.pm * BM + wr * 64 + fr, colt = u.pn * BM;
#pragma unroll
        for (int ai = 0; ai < 2; ++ai)
#pragma unroll
            for (int m = 0; m < 4; ++m) { const int row = row0 + ai * HALF + m * 16; const int b = row >> 13, t = row & 8191;
                const f32x4 s0 = *(const f32x4*)(SS + (size_t)row * 20), s1 = *(const f32x4*)(SS + (size_t)row * 20 + 4), s2 = *(const f32x4*)(SS + (size_t)row * 20 + 8);
                const float ssq = ((s0[0] + s0[1]) + (s0[2] + s0[3])) + ((s1[0] + s1[1]) + (s1[2] + s1[3])) + ((s2[0] + s2[1]) + (s2[2] + s2[3]));
                const float rstd = rsqrtf(ssq * (1.f / 384.f) + 1e-6f);
#pragma unroll
                for (int bj = 0; bj < 2; ++bj) { const int cs = colt + bj * HALF + wc * 32, c0 = cs + 8 * fq; const int h = c0 / 96, j = c0 - h * 96;
                    float v[8];
#pragma unroll
                    for (int i = 0; i < 4; ++i) { v[i] = acc[ai][bj][m][0][i] * rstd; v[4 + i] = acc[ai][bj][m][1][i] * rstd; }
                    if ((cs % 96) == 64) {
                        const int jj0 = 8 * (fq & 1);
                        const f32x4 c0v = *(const f32x4*)(COS + t * 16 + jj0), c1v = *(const f32x4*)(COS + t * 16 + jj0 + 4), s0v = *(const f32x4*)(SIN + t * 16 + jj0), s1v = *(const f32x4*)(SIN + t * 16 + jj0 + 4);
#pragma unroll
                        for (int i = 0; i < 8; ++i) { const float pv = __shfl_xor(v[i], 32); const float cc = i < 4 ? c0v[i & 3] : c1v[i & 3], sn = i < 4 ? s0v[i & 3] : s1v[i & 3];
                            v[i] = fq < 2 ? v[i] * cc - pv * sn : v[i] * cc + pv * sn; }
                    }
                    u32x4 w; w.x = cvt_pk_bf16(v[0], v[1]); w.y = cvt_pk_bf16(v[2], v[3]); w.z = cvt_pk_bf16(v[4], v[5]); w.w = cvt_pk_bf16(v[6], v[7]);
                    *(u32x4*)(Q + ((size_t)(b * 8 + h) * 8192 + t) * 96 + j) = w; }
                asm volatile("" ::: "memory"); }
    }
};
struct EpiKV { static constexpr bool PERM = true, AFTER_DRAIN = false;
    bf16_t* Kb; bf16_t* Vb; const float* SS;
    __device__ __forceinline__ void operator()(const f32x4 (&acc)[2][2][4][2], const Unit& u, int wr, int wc, int fr, int fq) const {
        asm volatile("" : "+v"(fr), "+v"(fq));
        const int colt = u.pn * BM; int b, key0; if (u.pm < 128) { b = u.pm >> 5; key0 = 256 + (u.pm & 31) * 256; } else { b = u.pm - 128; key0 = 0; }
        float rs[2][4];
#pragma unroll
        for (int ai = 0; ai < 2; ++ai) { f32x4 t[4][2];
#pragma unroll
            for (int m = 0; m < 4; ++m) { const float* sp = SS + (size_t)(u.pm * BM + wr * 64 + fr + ai * HALF + m * 16) * 20 + 12; t[m][0] = *(const f32x4*)sp; t[m][1] = *(const f32x4*)(sp + 4); }
#pragma unroll
            for (int m = 0; m < 4; ++m) { const f32x4 s0 = t[m][0], s1 = t[m][1];
                const float ssq = ((s0[0] + s0[1]) + (s0[2] + s0[3])) + ((s1[0] + s1[1]) + (s1[2] + s1[3]));
                rs[ai][m] = rsqrtf(ssq * (1.f / 256.f) + 1e-6f); }
            asm volatile("" ::: "memory"); }
#pragma unroll
        for (int ai = 0; ai < 2; ++ai)
#pragma unroll
            for (int m = 0; m < 4; ++m) { const int lr = wr * 64 + fr + ai * HALF + m * 16; const int key = key0 + lr;
                const float rstd = rs[ai][m];
#pragma unroll
                for (int bj = 0; bj < 2; ++bj) { const int c0 = colt + bj * HALF + wc * 32 + 8 * fq; const int h = c0 >> 7, j = c0 & 127; const size_t kr = (size_t)(b * 8 + h) * 8448 + key;
                    const f32x4 v0 = acc[ai][bj][m][0] * rstd, v1 = acc[ai][bj][m][1] * rstd;
                    u32x4 w; w.x = cvt_pk_bf16(v0[0], v0[1]); w.y = cvt_pk_bf16(v0[2], v0[3]); w.z = cvt_pk_bf16(v1[0], v1[1]); w.w = cvt_pk_bf16(v1[2], v1[3]);
                    if (wc < 2) *(u32x4*)(Kb + kr * 96 + j) = w; else *(u32x4*)(Vb + kr * 64 + (j - 64)) = w; }
                asm volatile("" ::: "memory"); }
    }
};
struct EpiPL { static constexpr bool PERM = true, AFTER_DRAIN = false;
    bf16_t* T; const bf16_t* UG;
    __device__ __forceinline__ void operator()(const f32x4 (&acc)[2][2][4][2], const Unit& u, int wr, int wc, int fr, int fq) const {
        const int row0 = u.pm * BM + wr * 64 + fr, col0 = u.pn * BM + wc * 32 + 8 * fq;
        u32x4 g8[2][4][2];
#pragma unroll
        for (int ai = 0; ai < 2; ++ai)
#pragma unroll
            for (int m = 0; m < 4; ++m)
#pragma unroll
                for (int bj = 0; bj < 2; ++bj) g8[ai][m][bj] = *(const u32x4*)(UG + (size_t)(row0 + ai * HALF + m * 16) * 2048 + 1024 + col0 + bj * HALF);
#pragma unroll
        for (int ai = 0; ai < 2; ++ai)
#pragma unroll
            for (int m = 0; m < 4; ++m) { const int row = row0 + ai * HALF + m * 16;
#pragma unroll
                for (int bj = 0; bj < 2; ++bj) { const int c0 = col0 + bj * HALF; const u32x4 gq = g8[ai][m][bj];
                    float v[8];
#pragma unroll
                    for (int i = 0; i < 4; ++i) { const float glo = __uint_as_float(gq[i] << 16), ghi = __uint_as_float(gq[i] & 0xffff0000u);
                        const float a0 = i < 2 ? acc[ai][bj][m][0][2 * i] : acc[ai][bj][m][1][2 * i - 4], a1 = i < 2 ? acc[ai][bj][m][0][2 * i + 1] : acc[ai][bj][m][1][2 * i - 3];
                        v[2 * i] = a0 * (glo * __builtin_amdgcn_rcpf(1.f + __expf(-glo))); v[2 * i + 1] = a1 * (ghi * __builtin_amdgcn_rcpf(1.f + __expf(-ghi))); }
                    u32x4 w; w.x = cvt_pk_bf16(v[0], v[1]); w.y = cvt_pk_bf16(v[2], v[3]); w.z = cvt_pk_bf16(v[4], v[5]); w.w = cvt_pk_bf16(v[6], v[7]);
                    *(u32x4*)(T + (size_t)row * 1024 + c0) = w; } }
    }
};
struct EpiResM { static constexpr bool PERM = false, AFTER_DRAIN = false;
    const float* res; const float* gate; float* out; int rows_per_batch; int pad;
    __device__ __forceinline__ void operator()(const f32x4 (&acc)[2][2][4][2], const Unit& u, int wr, int wc, int fr, int fq) const {
        const int row0 = u.pm * BM + wr * 64 + fr, col0 = u.pn * BM + wc * 32 + 4 * fq; const int b = (u.pm * BM) / rows_per_batch;
        f32x4 gv[2][2];
#pragma unroll
        for (int bj = 0; bj < 2; ++bj)
#pragma unroll
            for (int n = 0; n < 2; ++n) gv[bj][n] = *(const f32x4*)(gate + b * 3072 + 2048 + col0 + bj * HALF + n * 16);
#pragma unroll
        for (int ai = 0; ai < 2; ++ai)
#pragma unroll
            for (int m = 0; m < 4; ++m) { const size_t off = (size_t)(row0 + ai * HALF + m * 16) * 1024 + col0;
#pragma unroll
                for (int bj = 0; bj < 2; ++bj)
#pragma unroll
                    for (int n = 0; n < 2; ++n) { const f32x4 r = *(const f32x4*)(res + off + bj * HALF + n * 16); *(f32x4*)(out + off + bj * HALF + n * 16) = r + gv[bj][n] * acc[ai][bj][m][n]; }
                if (m == 3) asm volatile("" ::: "memory"); }
    }
};

struct PanelRms {
    unsigned* xbuf;
    unsigned* cnt;
    int pm_off; float eps;
    __device__ __forceinline__ void run(const f32x4 (&v)[2][2][4][2], const Unit& u, int wr, int wc, int fr, int fq, PG8_LAS unsigned char* lds, int wid, int lane) const { publish(v, u, wr, wc, fr, fq, lds, wid, lane); collect(u, lds, wid, lane); }
    __device__ __forceinline__ void publish(const f32x4 (&v)[2][2][4][2], const Unit& u, int wr, int wc, int fr, int fq, PG8_LAS unsigned char* lds, int wid, int lane) const {
        PG8_LAS float* Pq = (PG8_LAS float*)lds;
        PG8_LAS float* S = (PG8_LAS float*)(lds + 8192);
        const int gpm = u.pm + pm_off;
#pragma unroll
        for (int ai = 0; ai < 2; ++ai)
#pragma unroll
            for (int m = 0; m < 4; ++m) { float q = 0.f;
#pragma unroll
                for (int bj = 0; bj < 2; ++bj)
#pragma unroll
                    for (int n = 0; n < 2; ++n) { const f32x4 x = v[ai][bj][m][n]; q += (x[0] * x[0] + x[1] * x[1]) + (x[2] * x[2] + x[3] * x[3]); }
                q += __shfl_xor(q, 16); q += __shfl_xor(q, 32);
                if (fq == 0) Pq[(ai * HALF + wr * 64 + m * 16 + fr) * 4 + wc] = q; }
        asm volatile("s_waitcnt lgkmcnt(0)" ::: "memory"); __builtin_amdgcn_s_barrier(); asm volatile("" ::: "memory");
        const int row = wid * 32 + (lane & 31);
        if (lane < 32) { const float sq = (Pq[row * 4 + 0] + Pq[row * 4 + 1]) + (Pq[row * 4 + 2] + Pq[row * 4 + 3]);
            __hip_atomic_store(xbuf + ((size_t)(gpm * BM + row) * 4 + u.pn), __float_as_uint(sq), __ATOMIC_RELAXED, __HIP_MEMORY_SCOPE_AGENT); }
        asm volatile("s_waitcnt vmcnt(0)" ::: "memory");
        if (lane == 0) __hip_atomic_fetch_add(cnt + 64 * gpm, 1u, __ATOMIC_RELAXED, __HIP_MEMORY_SCOPE_AGENT);
    }
    __device__ __forceinline__ void collect(const Unit& u, PG8_LAS unsigned char* lds, int wid, int lane) const {
        PG8_LAS float* S = (PG8_LAS float*)(lds + 8192);
        const int gpm = u.pm + pm_off; const int row = wid * 32 + (lane & 31);
        if (wid == 0) {
            for (unsigned sp = 0; sp < (1u << 22); ++sp) {
                if ((unsigned)__builtin_amdgcn_readfirstlane(__hip_atomic_load(cnt + 64 * gpm, __ATOMIC_RELAXED, __HIP_MEMORY_SCOPE_AGENT)) >= 32u) break;
                __builtin_amdgcn_s_sleep(2); }
            __builtin_amdgcn_fence(__ATOMIC_ACQUIRE, "agent");
        }
        asm volatile("s_waitcnt vmcnt(0) lgkmcnt(0)" ::: "memory"); __builtin_amdgcn_s_barrier(); asm volatile("" ::: "memory");
        if (lane < 32) { const unsigned* slot = xbuf + (size_t)(gpm * BM + row) * 4; float tot = 0.f;
#pragma unroll
            for (int t = 0; t < 4; ++t) tot += __uint_as_float(__hip_atomic_load(slot + t, __ATOMIC_RELAXED, __HIP_MEMORY_SCOPE_AGENT));
            S[row] = rsqrtf(tot * (1.f / 1024.f) + eps); }
        asm volatile("s_waitcnt lgkmcnt(0)" ::: "memory"); __builtin_amdgcn_s_barrier(); asm volatile("" ::: "memory");
    }
};
typedef _Float16 h16x4 __attribute__((ext_vector_type(4)));
struct EpiResNorm { static constexpr bool PERM = false, AFTER_DRAIN = true;
    const float* res; const float* gate; _Float16* X1; bf16_t* Hn; const float* nw; const float* modn; PanelRms st; int rows_per_batch; int pad;
    __device__ __forceinline__ void operator()(const f32x4 (&)[2][2][4][2], const Unit&, int, int, int, int) const {}
    __device__ __forceinline__ void fused(f32x4 (&acc)[2][2][4][2], const Unit& u, int wr, int wc, int fr, int fq, PG8_LAS unsigned char* lds, int wid, int lane) const {
        typedef unsigned u32x2v __attribute__((ext_vector_type(2)));
        const PG8_LAS float* S = (const PG8_LAS float*)(lds + 8192);
        const int grow0 = (u.pm + st.pm_off) * BM, col0 = u.pn * BM + wc * 32 + 4 * fq; const int b = grow0 / rows_per_batch;
#pragma unroll
        for (int bj = 0; bj < 2; ++bj)
#pragma unroll
            for (int n = 0; n < 2; ++n) { const f32x4 gv = *(const f32x4*)(gate + b * 3072 + 2048 + col0 + bj * HALF + n * 16);
#pragma unroll
                for (int ai = 0; ai < 2; ++ai)
#pragma unroll
                    for (int m = 0; m < 4; ++m) acc[ai][bj][m][n] *= gv; }
#pragma unroll
        for (int ai = 0; ai < 2; ++ai)
#pragma unroll
            for (int m = 0; m < 4; ++m) { const size_t off = (size_t)(grow0 + ai * HALF + wr * 64 + m * 16 + fr) * 1024 + col0;
#pragma unroll
                for (int bj = 0; bj < 2; ++bj)
#pragma unroll
                    for (int n = 0; n < 2; ++n) acc[ai][bj][m][n] += *(const f32x4*)(res + off + bj * HALF + n * 16);
                asm volatile("" : "+v"(acc[ai][0][m][0]), "+v"(acc[ai][0][m][1]), "+v"(acc[ai][1][m][0]), "+v"(acc[ai][1][m][1]));
                if (m == 3) asm volatile("" ::: "memory"); }
        f32x4 gn[2][2], shn[2][2];
#pragma unroll
        for (int bj = 0; bj < 2; ++bj)
#pragma unroll
            for (int n = 0; n < 2; ++n) { const int c = col0 + bj * HALF + n * 16;
                gn[bj][n] = *(const f32x4*)(nw + c) * (*(const f32x4*)(modn + b * 3072 + 1024 + c) + 1.f); shn[bj][n] = *(const f32x4*)(modn + b * 3072 + c); }
        st.publish(acc, u, wr, wc, fr, fq, lds, wid, lane);
#pragma unroll
        for (int ai = 0; ai < 2; ++ai)
#pragma unroll
            for (int m = 0; m < 4; ++m) { const size_t off = (size_t)(grow0 + ai * HALF + wr * 64 + m * 16 + fr) * 1024 + col0;
#pragma unroll
                for (int bj = 0; bj < 2; ++bj)
#pragma unroll
                    for (int n = 0; n < 2; ++n) *(h16x4*)(X1 + off + bj * HALF + n * 16) = __builtin_convertvector(acc[ai][bj][m][n], h16x4); }
        st.collect(u, lds, wid, lane);
#pragma unroll
        for (int ai = 0; ai < 2; ++ai)
#pragma unroll
            for (int m = 0; m < 4; ++m) { const int r = ai * HALF + wr * 64 + m * 16 + fr; const float rstd = S[r]; const size_t off = (size_t)(grow0 + r) * 1024 + col0;
#pragma unroll
                for (int bj = 0; bj < 2; ++bj)
#pragma unroll
                    for (int n = 0; n < 2; ++n) { const f32x4 x1 = acc[ai][bj][m][n];
                        const f32x4 o = x1 * rstd * gn[bj][n] + shn[bj][n];
                        u32x2v pk; pk.x = cvt_pk_bf16(o[0], o[1]); pk.y = cvt_pk_bf16(o[2], o[3]);
                        *(u32x2v*)(Hn + off + bj * HALF + n * 16) = pk; }
                asm volatile("" ::: "memory"); }
    }
};
struct EpiResFinal { static constexpr bool PERM = false, AFTER_DRAIN = true;
    const _Float16* res; const float* gate; float* out; const float* fw; PanelRms st; int rows_per_batch; int pad;
    __device__ __forceinline__ void operator()(const f32x4 (&)[2][2][4][2], const Unit&, int, int, int, int) const {}
    __device__ __forceinline__ void fused(f32x4 (&acc)[2][2][4][2], const Unit& u, int wr, int wc, int fr, int fq, PG8_LAS unsigned char* lds, int wid, int lane) const {
        const PG8_LAS float* S = (const PG8_LAS float*)(lds + 8192);
        const int grow0 = (u.pm + st.pm_off) * BM, col0 = u.pn * BM + wc * 32 + 4 * fq; const int b = grow0 / rows_per_batch;
#pragma unroll
        for (int bj = 0; bj < 2; ++bj)
#pragma unroll
            for (int n = 0; n < 2; ++n) { const f32x4 gv = *(const f32x4*)(gate + b * 3072 + 2048 + col0 + bj * HALF + n * 16);
#pragma unroll
                for (int ai = 0; ai < 2; ++ai)
#pragma unroll
                    for (int m = 0; m < 4; ++m) acc[ai][bj][m][n] *= gv; }
#pragma unroll
        for (int ai = 0; ai < 2; ++ai)
#pragma unroll
            for (int m = 0; m < 4; ++m) { const size_t off = (size_t)(grow0 + ai * HALF + wr * 64 + m * 16 + fr) * 1024 + col0;
#pragma unroll
                for (int bj = 0; bj < 2; ++bj)
#pragma unroll
                    for (int n = 0; n < 2; ++n) acc[ai][bj][m][n] += __builtin_convertvector(*(const h16x4*)(res + off + bj * HALF + n * 16), f32x4);
                asm volatile("" : "+v"(acc[ai][0][m][0]), "+v"(acc[ai][0][m][1]), "+v"(acc[ai][1][m][0]), "+v"(acc[ai][1][m][1]));
                if (m == 3) asm volatile("" ::: "memory"); }
        f32x4 fwv[2][2];
#pragma unroll
        for (int bj = 0; bj < 2; ++bj)
#pragma unroll
            for (int n = 0; n < 2; ++n) fwv[bj][n] = *(const f32x4*)(fw + col0 + bj * HALF + n * 16);
        st.run(acc, u, wr, wc, fr, fq, lds, wid, lane);
#pragma unroll
        for (int ai = 0; ai < 2; ++ai)
#pragma unroll
            for (int m = 0; m < 4; ++m) { const int r = ai * HALF + wr * 64 + m * 16 + fr; const float rstd = S[r]; const size_t off = (size_t)(grow0 + r) * 1024 + col0;
#pragma unroll
                for (int bj = 0; bj < 2; ++bj)
#pragma unroll
                    for (int n = 0; n < 2; ++n) *(f32x4*)(out + off + bj * HALF + n * 16) = acc[ai][bj][m][n] * rstd * fwv[bj][n];
                asm volatile("" ::: "memory"); }
    }
};
template <class Epi, class Sched, bool ALIGN_EPI = false, bool SP2 = false>
__device__ __forceinline__ void gemm_phase(PG8_LAS unsigned char* lds, const Gemm g, const Sched& S, const Epi& E) {
    int tid_ = TIDX; asm volatile("" : "+v"(tid_));
    const int tid = tid_, wid = __builtin_amdgcn_readfirstlane(tid >> 6), lane = tid & 63, wr = wid >> 2, wc = wid & 3, fr = lane & 15, fq = lane >> 4;
    const int K = g.K, nt = K / BK;
    unsigned voffA[2], voffB[2];
#pragma unroll
    for (int i = 0; i < 2; ++i) { int R, C; stage_rc(tid * 16 + i * 8192, R, C); const int Rb = Epi::PERM ? ((R & ~31) + perm32(R & 31)) : R;
        voffA[i] = (unsigned)(R * g.lda + C) * 2u; voffB[i] = (unsigned)(Rb * K + C) * 2u; }
    const unsigned kstep = (unsigned)(BK * 2);
    const unsigned hsA = (unsigned)HALF * g.lda * 2u, hsB = (unsigned)HALF * K * 2u;
    const unsigned tsA = 2 * hsA, tsB = 2 * hsB, apo = (unsigned)g.a_pn_off * 2u;
    const unsigned ldsw = (unsigned)wid * 1024u;
    const int aoff = lds_byte(wr * 64 + fr, fq * 8), boff = lds_byte(wc * 32 + fr, fq * 8);
#define PG8_SA(b, h) (((b) * 2 + (h)) * HTB)
#define PG8_SB(b, h) ((4 + (b) * 2 + (h)) * HTB)
#define PG8_STAGEX(rs, bufoff, goff, voff) do { _Pragma("unroll") for (int _i = 0; _i < 2; ++_i) \
        __builtin_amdgcn_raw_ptr_buffer_load_lds((rs), (PG8_LAS void*)(lds + (bufoff) + ldsw + _i * 8192), 16, (int)(voff)[_i], (int)(goff), 0, 0); } while (0)
#define PG8_STAGEA(bufoff, goff, voff) PG8_STAGEX(rsA, bufoff, goff, voff)
#define PG8_STAGEB(bufoff, goff, voff) PG8_STAGEX(rsB, bufoff, goff, voff)
#define PG8_LDA(dst, b, h) do { _Pragma("unroll") for (int m = 0; m < 4; ++m) _Pragma("unroll") for (int k = 0; k < 2; ++k) dst[m][k] = *(const PG8_LAS bf16x8*)(lds + PG8_SA(b, h) + aoff + m * 2048 + k * 1024); } while (0)
#define PG8_LDB(dst, b, h) do { _Pragma("unroll") for (int n = 0; n < 2; ++n) _Pragma("unroll") for (int k = 0; k < 2; ++k) dst[n][k] = *(const PG8_LAS bf16x8*)(lds + PG8_SB(b, h) + boff + n * 2048 + k * 1024); } while (0)
#define PG8_MMA(ai, bj, At, Bt) do { __builtin_amdgcn_s_setprio(1); _Pragma("unroll") for (int m = 0; m < 4; ++m) _Pragma("unroll") for (int n = 0; n < 2; ++n) _Pragma("unroll") for (int k = 0; k < 2; ++k) \
        acc[ai][bj][m][n] = __builtin_amdgcn_mfma_f32_16x16x32_bf16(Bt[n][k], At[m][k], acc[ai][bj][m][n], 0, 0, 0); __builtin_amdgcn_s_setprio(0); } while (0)
#define PG8_WAIT_V(n) asm volatile("s_waitcnt vmcnt(" #n ")" ::: "memory")
#define PG8_WAIT_L(n) asm volatile("s_waitcnt lgkmcnt(" #n ")" ::: "memory")
#define PG8_BAR __builtin_amdgcn_s_barrier()
#define PG8_SCHED __builtin_amdgcn_sched_barrier(0)
    Unit cur, nxt; int ui = 0;
    if (!S.next(0, cur)) return;
    f32x4 acc[2][2][4][2];
#pragma unroll
    for (int a = 0; a < 2; ++a)
#pragma unroll
        for (int b = 0; b < 2; ++b)
#pragma unroll
            for (int m = 0; m < 4; ++m)
#pragma unroll
                for (int n = 0; n < 2; ++n) acc[a][b][m][n] = (f32x4){0.f, 0.f, 0.f, 0.f};
    bf16x8 At[4][2], B0[2][2], B1[2][2];
    const __amdgpu_buffer_rsrc_t rsA = __builtin_amdgcn_make_buffer_rsrc((void*)g.A, 0, 0x7ffffff0, 0x00020000), rsB = __builtin_amdgcn_make_buffer_rsrc((void*)g.Bt, 0, 0x7ffffff0, 0x00020000);
    unsigned cA = (unsigned)cur.pm * tsA + (unsigned)cur.pn * apo, cB = (unsigned)cur.pn * tsB;
    S.a_ready(cur);
    if constexpr (SP2) {
        PG8_STAGEB(PG8_SB(0, 0), cB, voffB); PG8_STAGEB(PG8_SB(0, 1), cB + hsB, voffB); PG8_STAGEA(PG8_SA(0, 0), cA, voffA); PG8_STAGEA(PG8_SA(0, 1), cA + hsA, voffA);
        if (wr == 1) PG8_BAR;
        PG8_WAIT_V(2); PG8_BAR;
        PG8_STAGEB(PG8_SB(1, 0), cB + kstep, voffB); PG8_STAGEA(PG8_SA(1, 0), cA + kstep, voffA); PG8_STAGEB(PG8_SB(1, 1), cB + hsB + kstep, voffB);
        PG8_WAIT_V(6); PG8_BAR;
    } else {
        PG8_STAGEB(PG8_SB(0, 0), cB, voffB); PG8_STAGEA(PG8_SA(0, 0), cA, voffA); PG8_STAGEB(PG8_SB(0, 1), cB + hsB, voffB); PG8_STAGEA(PG8_SA(0, 1), cA + hsA, voffA);
        if (wr == 1) PG8_BAR;
        PG8_WAIT_V(4); PG8_BAR;
        PG8_STAGEB(PG8_SB(1, 0), cB + kstep, voffB); PG8_STAGEA(PG8_SA(1, 0), cA + kstep, voffA); PG8_STAGEB(PG8_SB(1, 1), cB + hsB + kstep, voffB);
        PG8_WAIT_V(6); PG8_BAR;
    }
    for (;;) {
        const bool has_next = S.next(ui + 1, nxt);
        const unsigned nA = has_next ? (unsigned)nxt.pm * tsA + (unsigned)nxt.pn * apo : cA, nB = has_next ? (unsigned)nxt.pn * tsB : cB;
        for (int t = 0; t < nt; t += 2) {
            const bool last = (t == nt - 2);
            const unsigned a1 = cA + (unsigned)(t + 1) * kstep;
            const unsigned a2 = last ? nA : cA + (unsigned)(t + 2) * kstep, b2 = last ? nB : cB + (unsigned)(t + 2) * kstep;
            const unsigned a3 = a2 + kstep, b3 = b2 + kstep;
            if (last && has_next) S.a_ready(nxt);
            if constexpr (SP2) {
            PG8_LDB(B0, 0, 0); PG8_LDB(B1, 0, 1); PG8_SCHED; PG8_LDA(At, 0, 0); PG8_STAGEA(PG8_SA(1, 1), a1 + hsA, voffA);
            PG8_WAIT_V(8); PG8_WAIT_L(0); PG8_BAR; PG8_MMA(0, 0, At, B0); PG8_MMA(0, 1, At, B1); PG8_BAR; PG8_SCHED;
            PG8_LDA(At, 0, 1); PG8_STAGEB(PG8_SB(0, 0), b2, voffB); PG8_STAGEB(PG8_SB(0, 1), b2 + hsB, voffB); PG8_STAGEA(PG8_SA(0, 0), a2, voffA);
            PG8_WAIT_V(8); PG8_WAIT_L(0); PG8_BAR; PG8_MMA(1, 0, At, B0); PG8_MMA(1, 1, At, B1); PG8_BAR; PG8_SCHED;
            PG8_LDB(B0, 1, 0); PG8_LDB(B1, 1, 1); PG8_SCHED; PG8_LDA(At, 1, 0); PG8_STAGEA(PG8_SA(0, 1), a2 + hsA, voffA);
            PG8_WAIT_V(8); PG8_WAIT_L(0); PG8_BAR; PG8_MMA(0, 0, At, B0); PG8_MMA(0, 1, At, B1); PG8_BAR; PG8_SCHED;
            PG8_LDA(At, 1, 1); PG8_STAGEB(PG8_SB(1, 0), b3, voffB); PG8_STAGEB(PG8_SB(1, 1), b3 + hsB, voffB); PG8_STAGEA(PG8_SA(1, 0), a3, voffA);
            PG8_WAIT_V(8); PG8_WAIT_L(0); PG8_BAR; PG8_MMA(1, 0, At, B0); PG8_MMA(1, 1, At, B1); PG8_BAR; PG8_SCHED;
            } else {
            PG8_LDB(B0, 0, 0); PG8_SCHED; PG8_LDA(At, 0, 0); PG8_STAGEA(PG8_SA(1, 1), a1 + hsA, voffA);
            PG8_WAIT_L(8); PG8_BAR; PG8_WAIT_L(0); PG8_MMA(0, 0, At, B0); PG8_BAR; PG8_SCHED;
            PG8_LDB(B1, 0, 1); PG8_STAGEB(PG8_SB(0, 0), b2, voffB);
            PG8_BAR; PG8_WAIT_L(0); PG8_MMA(0, 1, At, B1); PG8_BAR;
            PG8_LDA(At, 0, 1); PG8_STAGEA(PG8_SA(0, 0), a2, voffA);
            PG8_BAR; PG8_WAIT_L(0); PG8_MMA(1, 0, At, B0); PG8_BAR; PG8_SCHED;
            PG8_STAGEB(PG8_SB(0, 1), b2 + hsB, voffB);
            PG8_WAIT_V(6); PG8_BAR; PG8_MMA(1, 1, At, B1); PG8_BAR;
            PG8_LDB(B0, 1, 0); PG8_SCHED; PG8_LDA(At, 1, 0); PG8_STAGEA(PG8_SA(0, 1), a2 + hsA, voffA);
            PG8_WAIT_L(8); PG8_BAR; PG8_WAIT_L(0); PG8_MMA(0, 0, At, B0); PG8_BAR; PG8_SCHED;
            PG8_LDB(B1, 1, 1); PG8_STAGEB(PG8_SB(1, 0), b3, voffB);
            PG8_BAR; PG8_WAIT_L(0); PG8_MMA(0, 1, At, B1); PG8_BAR;
            PG8_LDA(At, 1, 1); PG8_STAGEA(PG8_SA(1, 0), a3, voffA);
            PG8_BAR; PG8_WAIT_L(0); PG8_MMA(1, 0, At, B0); PG8_BAR; PG8_SCHED;
            PG8_STAGEB(PG8_SB(1, 1), b3 + hsB, voffB);
            PG8_WAIT_V(6); PG8_BAR; PG8_MMA(1, 1, At, B1); PG8_BAR;
            }
        }
        if constexpr (ALIGN_EPI) { if (wr == 0) PG8_BAR; }
        if constexpr (!Epi::AFTER_DRAIN) { E(acc, cur, wr, wc, fr, fq); S.done(cur); }
        if (!has_next) break;
#pragma unroll
        for (int a = 0; a < 2; ++a)
#pragma unroll
            for (int b = 0; b < 2; ++b)
#pragma unroll
                for (int m = 0; m < 4; ++m)
#pragma unroll
                    for (int n = 0; n < 2; ++n) acc[a][b][m][n] = (f32x4){0.f, 0.f, 0.f, 0.f};
        cur = nxt; cA = nA; cB = nB; ++ui;
        if constexpr (ALIGN_EPI) { if (wr == 1) PG8_BAR; }
    }
    PG8_WAIT_V(0);
    if constexpr (!ALIGN_EPI) { if (wr == 0) PG8_BAR; }
    PG8_BAR;
    if constexpr (Epi::AFTER_DRAIN) { E.fused(acc, cur, wr, wc, fr, fq, lds, wid, lane); S.done(cur); }
#undef PG8_SA
#undef PG8_SB
#undef PG8_STAGEX
#undef PG8_STAGEA
#undef PG8_STAGEB
#undef PG8_LDA
#undef PG8_LDB
#undef PG8_MMA
#undef PG8_WAIT_V
#undef PG8_WAIT_L
#undef PG8_BAR
#undef PG8_SCHED
}
}


namespace attn {
using bf16x8 = __attribute__((ext_vector_type(8))) short;
using s16x4  = __attribute__((ext_vector_type(4))) short;
using f32x16 = __attribute__((ext_vector_type(16))) float;
using u32x4  = __attribute__((ext_vector_type(4))) unsigned;
constexpr int DQK = 96, DV = 64, NW = 8, QBLK = 32, KVBLK = 64;
constexpr float THR = 8.f;
constexpr int SHM_V = KVBLK * DV * 2, SHM_K = KVBLK * 256;
constexpr int SHM_ATTN = 2 * SHM_V + 2 * SHM_K + NW * 64 * 4;
#define AT_KSWZ(row, colB) ((row) * 256 + ((colB) ^ (((row) & 7) << 4)))
#define AT_SBAR() __builtin_amdgcn_sched_barrier(0)
__device__ __forceinline__ int crow(int r, int hi) { return (r & 3) + 8 * (r >> 2) + 4 * hi; }
__device__ __forceinline__ unsigned cvtpk(float lo, float hi) { unsigned r; asm volatile("v_cvt_pk_bf16_f32 %0, %1, %2" : "=v"(r) : "v"(lo), "v"(hi)); return r; }
__device__ __forceinline__ float rowmax32(const f32x16& p0, const f32x16& p1) {
  float a = fmaxf(fmaxf(p0[0], p0[1]), p1[0]), b = fmaxf(fmaxf(p0[2], p0[3]), p1[1]); a = fmaxf(fmaxf(a, p1[2]), p1[3]);
#pragma unroll
  for (int r = 4; r < 16; r += 4) { a = fmaxf(fmaxf(a, p0[r]), p0[r + 1]); b = fmaxf(fmaxf(b, p0[r + 2]), p0[r + 3]); a = fmaxf(fmaxf(a, p1[r]), p1[r + 1]); b = fmaxf(fmaxf(b, p1[r + 2]), p1[r + 3]); }
  float pm = fmaxf(a, b);
  auto rr = __builtin_amdgcn_permlane32_swap(__float_as_uint(pm), __float_as_uint(pm), false, false);
  return fmaxf(__uint_as_float(rr[0]), __uint_as_float(rr[1]));
}
template <int VAR, bool FIRST> __device__ __forceinline__ void partialSM(f32x16& p0, f32x16& p1, float& m_reg, f32x16& negm, float& alpha) {
  const float pmax = rowmax32(p0, p1);
  alpha = 1.f;
  if (FIRST || !__builtin_expect(__all(pmax <= THR), 1)) {
    const float dl = FIRST ? pmax : fmaxf(pmax, 0.f);
    m_reg += dl; alpha = FIRST ? 0.f : __builtin_amdgcn_exp2f(-dl);
#pragma unroll
    for (int r = 0; r < 16; ++r) { p0[r] -= dl; p1[r] -= dl; negm[r] = -m_reg; }
  }
#pragma unroll
  for (int r = 0; r < 16; ++r) p0[r] = VAR == 2 ? p0[r] * 0.5f : __builtin_amdgcn_exp2f(p0[r]);
}
template <int VAR> __device__ __forceinline__ void finishSM(f32x16& p0, f32x16& p1, float alpha, float& l_reg, bf16x8& pa0, bf16x8& pa1, bf16x8& pa2, bf16x8& pa3) {
#pragma unroll
  for (int r = 0; r < 16; ++r) p1[r] = VAR == 2 ? p1[r] * 0.5f : __builtin_amdgcn_exp2f(p1[r]);
  float ps = 0;
#pragma unroll
  for (int r = 0; r < 16; ++r) ps += p0[r];
#pragma unroll
  for (int r = 0; r < 16; ++r) ps += p1[r];
  { auto rr = __builtin_amdgcn_permlane32_swap(__float_as_uint(ps), __float_as_uint(ps), false, false);
    ps = __uint_as_float(rr[0]) + __uint_as_float(rr[1]); }
  l_reg = l_reg * alpha + ps;
#define AT_PK4(P, BASE, OUT) do { unsigned a0 = cvtpk(P[BASE + 0], P[BASE + 1]), a1 = cvtpk(P[BASE + 2], P[BASE + 3]);   \
    unsigned b0 = cvtpk(P[BASE + 4], P[BASE + 5]), b1 = cvtpk(P[BASE + 6], P[BASE + 7]);                              \
    auto r0 = __builtin_amdgcn_permlane32_swap(a0, b0, false, false); auto r1 = __builtin_amdgcn_permlane32_swap(a1, b1, false, false); \
    u32x4 w = {r0[0], r1[0], r0[1], r1[1]}; OUT = *reinterpret_cast<bf16x8*>(&w); } while (0)
  AT_PK4(p0, 0, pa0); AT_PK4(p0, 8, pa1); AT_PK4(p1, 0, pa2); AT_PK4(p1, 8, pa3);
#undef AT_PK4
}
__device__ __forceinline__ void qkt(f32x16& p0, f32x16& p1, const char* Ks, const bf16x8* qr, int r32, int hi) {
  p0 = f32x16{}; p1 = f32x16{};
#pragma unroll
  for (int d0 = 0; d0 < DQK / 16; ++d0) { int cb = (d0 * 16 + hi * 8) * 2;
    bf16x8 b0 = *reinterpret_cast<const bf16x8*>(Ks + AT_KSWZ(r32, cb));
    bf16x8 b1 = *reinterpret_cast<const bf16x8*>(Ks + AT_KSWZ(32 + r32, cb));
    p0 = __builtin_amdgcn_mfma_f32_32x32x16_bf16(b0, qr[d0], p0, 0, 0, 0);
    p1 = __builtin_amdgcn_mfma_f32_32x32x16_bf16(b1, qr[d0], p1, 0, 0, 0); }
}
__device__ __forceinline__ int v_st(int k, int c) { const int kk = (k & ~0xC) | ((k & 4) << 1) | ((k & 8) >> 1); return ((kk >> 3) * 2 + (c >> 5)) * 512 + ((kk & 7) * 32 + (c & 31)) * 2; }
__device__ __forceinline__ int v_rd_base(int lane) { return ((lane & 3) << 3) | (((lane >> 2) & 3) << 6) | (((lane >> 4) & 1) << 5) | (((lane >> 5) & 1) << 8); }
constexpr int v_rd_off(int d0, int ks, int half) { return d0 * 512 + ks * 2048 + half * 1024; }
template <int OFF> __device__ __forceinline__ s16x4 tr_read(int vb) {
  s16x4 r; asm volatile("ds_read_b64_tr_b16 %0, %1 offset:%2" : "=&v"(r) : "v"(vb), "i"(OFF) : "memory"); return r;
}
template <int D0> __device__ __forceinline__ void pv_one(f32x16& od, int vb, bf16x8 pa0, bf16x8 pa1, bf16x8 pa2, bf16x8 pa3) {
  const s16x4 l0 = tr_read<v_rd_off(D0, 0, 0)>(vb), h0 = tr_read<v_rd_off(D0, 0, 1)>(vb), l1 = tr_read<v_rd_off(D0, 1, 0)>(vb), h1 = tr_read<v_rd_off(D0, 1, 1)>(vb);
  const s16x4 l2 = tr_read<v_rd_off(D0, 2, 0)>(vb), h2 = tr_read<v_rd_off(D0, 2, 1)>(vb), l3 = tr_read<v_rd_off(D0, 3, 0)>(vb), h3 = tr_read<v_rd_off(D0, 3, 1)>(vb);
  asm volatile("s_waitcnt lgkmcnt(0)" ::: "memory"); AT_SBAR();
#define AT_PK(L, H) (bf16x8){L[0], L[1], L[2], L[3], H[0], H[1], H[2], H[3]}
  od = __builtin_amdgcn_mfma_f32_32x32x16_bf16(pa0, AT_PK(l0, h0), od, 0, 0, 0);
  od = __builtin_amdgcn_mfma_f32_32x32x16_bf16(pa1, AT_PK(l1, h1), od, 0, 0, 0);
  od = __builtin_amdgcn_mfma_f32_32x32x16_bf16(pa2, AT_PK(l2, h2), od, 0, 0, 0);
  od = __builtin_amdgcn_mfma_f32_32x32x16_bf16(pa3, AT_PK(l3, h3), od, 0, 0, 0);
}
struct VFrag { s16x4 l[2][4], h[2][4]; };
__device__ __forceinline__ void vfrag_issue(VFrag& f, int vb) {
  f.l[0][0] = tr_read<v_rd_off(0, 0, 0)>(vb); f.h[0][0] = tr_read<v_rd_off(0, 0, 1)>(vb); f.l[1][0] = tr_read<v_rd_off(1, 0, 0)>(vb); f.h[1][0] = tr_read<v_rd_off(1, 0, 1)>(vb);
  f.l[0][1] = tr_read<v_rd_off(0, 1, 0)>(vb); f.h[0][1] = tr_read<v_rd_off(0, 1, 1)>(vb); f.l[1][1] = tr_read<v_rd_off(1, 1, 0)>(vb); f.h[1][1] = tr_read<v_rd_off(1, 1, 1)>(vb);
  f.l[0][2] = tr_read<v_rd_off(0, 2, 0)>(vb); f.h[0][2] = tr_read<v_rd_off(0, 2, 1)>(vb); f.l[1][2] = tr_read<v_rd_off(1, 2, 0)>(vb); f.h[1][2] = tr_read<v_rd_off(1, 2, 1)>(vb);
  f.l[0][3] = tr_read<v_rd_off(0, 3, 0)>(vb); f.h[0][3] = tr_read<v_rd_off(0, 3, 1)>(vb); f.l[1][3] = tr_read<v_rd_off(1, 3, 0)>(vb); f.h[1][3] = tr_read<v_rd_off(1, 3, 1)>(vb);
}
__device__ __forceinline__ void pv_mma(f32x16* o, const VFrag& f, bf16x8 pa0, bf16x8 pa1, bf16x8 pa2, bf16x8 pa3) {
  asm volatile("s_waitcnt lgkmcnt(0)" ::: "memory"); AT_SBAR();
  o[0] = __builtin_amdgcn_mfma_f32_32x32x16_bf16(pa0, AT_PK(f.l[0][0], f.h[0][0]), o[0], 0, 0, 0); o[1] = __builtin_amdgcn_mfma_f32_32x32x16_bf16(pa0, AT_PK(f.l[1][0], f.h[1][0]), o[1], 0, 0, 0);
  o[0] = __builtin_amdgcn_mfma_f32_32x32x16_bf16(pa1, AT_PK(f.l[0][1], f.h[0][1]), o[0], 0, 0, 0); o[1] = __builtin_amdgcn_mfma_f32_32x32x16_bf16(pa1, AT_PK(f.l[1][1], f.h[1][1]), o[1], 0, 0, 0);
  o[0] = __builtin_amdgcn_mfma_f32_32x32x16_bf16(pa2, AT_PK(f.l[0][2], f.h[0][2]), o[0], 0, 0, 0); o[1] = __builtin_amdgcn_mfma_f32_32x32x16_bf16(pa2, AT_PK(f.l[1][2], f.h[1][2]), o[1], 0, 0, 0);
  o[0] = __builtin_amdgcn_mfma_f32_32x32x16_bf16(pa3, AT_PK(f.l[0][3], f.h[0][3]), o[0], 0, 0, 0); o[1] = __builtin_amdgcn_mfma_f32_32x32x16_bf16(pa3, AT_PK(f.l[1][3], f.h[1][3]), o[1], 0, 0, 0);
}
#undef AT_PK
__device__ __forceinline__ void pv_d0(f32x16* o, int vb, bf16x8 pa0, bf16x8 pa1, bf16x8 pa2, bf16x8 pa3) {
  pv_one<0>(o[0], vb, pa0, pa1, pa2, pa3); pv_one<1>(o[1], vb, pa0, pa1, pa2, pa3);
}
constexpr int NSLOT = 4, KROWB = 208, SLOT_KB = 64 * KROWB, SLOT_VB = 8192, SLOT_B = SLOT_KB + SLOT_VB, LDS_WS = NSLOT * SLOT_B;
template <int VAR> __device__ __forceinline__ void attn_unit(const bf16_t* __restrict__ Qb, const bf16_t* __restrict__ Kh, const bf16_t* __restrict__ Vh, int seq,
                                          bf16_t* __restrict__ Ob, int o_pitch, const bf16_t* __restrict__ GA, int ga_pitch, char* lds, LAS unsigned char* L3) {
  int tid_ = TIDX; asm volatile("" : "+v"(tid_));
  const int tid = tid_, lane = tid & 63, r32 = lane & 31, hi = lane >> 5; const int wid = __builtin_amdgcn_readfirstlane(tid >> 6);
  float* ws = (float*)(lds + LDS_WS) + wid * 64; float* li_l = ws; float* al_l = ws + 32;
  float m_reg = 0.f, l_reg = 0; f32x16 o[2] = {}; bf16x8 qr[6]; f32x16 negm = {}; VFrag vf;
  int koff0, koff1, voff;
  { const int s0 = 64 * wid + lane, row0 = s0 / 13, c0 = s0 - row0 * 13; koff0 = row0 * 192 + (c0 < 12 ? c0 : 0) * 16;
    const int s1 = s0 + 512, row1 = s1 / 13, c1 = s1 - row1 * 13; koff1 = row1 * 192 + (c1 < 12 ? c1 : 0) * 16;
    const int sub = s0 >> 5, kk = (sub >> 1) * 8 + ((s0 & 31) >> 2), k = (kk & ~0xC) | ((kk & 4) << 1) | ((kk & 8) >> 1), c = (sub & 1) * 32 + (s0 & 3) * 8; voff = k * 128 + c * 2; }
  const bool k2 = wid < 5;
  const __amdgpu_buffer_rsrc_t rsK = __builtin_amdgcn_make_buffer_rsrc((void*)Kh, 0, 0x7ffffff0, 0x00020000), rsV = __builtin_amdgcn_make_buffer_rsrc((void*)Vh, 0, 0x7ffffff0, 0x00020000);
#define AT_DMA(t) do { const int so_ = ((t) & 3) * SLOT_B; \
    __builtin_amdgcn_raw_ptr_buffer_load_lds(rsK, (LAS void*)(L3 + so_ + wid * 1024), 16, koff0, (t) * (64 * 192), 0, 0); \
    if (k2) __builtin_amdgcn_raw_ptr_buffer_load_lds(rsK, (LAS void*)(L3 + so_ + (wid + 8) * 1024), 16, koff1, (t) * (64 * 192), 0, 0); \
    __builtin_amdgcn_raw_ptr_buffer_load_lds(rsV, (LAS void*)(L3 + so_ + SLOT_KB + wid * 1024), 16, voff, (t) * (64 * 128), 0, 0); } while (0)
#define AT_WAITBAR(n) do { if (k2) asm volatile("s_waitcnt vmcnt(" #n "*3) lgkmcnt(0)" ::: "memory"); else asm volatile("s_waitcnt vmcnt(" #n "*2) lgkmcnt(0)" ::: "memory"); __builtin_amdgcn_s_barrier(); } while (0)
  const int NTL = seq / KVBLK;
  const bf16_t* Qw = Qb + (long)(wid * QBLK + r32) * DQK + hi * 8;
#pragma unroll
  for (int d0 = 0; d0 < 6; ++d0) qr[d0] = *reinterpret_cast<const bf16x8*>(Qw + d0 * 16);
  AT_DMA(0); AT_DMA(1); AT_DMA(2);
  const int kb = r32 * KROWB + hi * 16;
  const int vb0 = (int)(uintptr_t)lds + SLOT_KB + v_rd_base(lane);
#define AT_QKT(P0, P1, t) do { const char* ks_ = lds + ((t) & 3) * SLOT_B + kb; \
    _Pragma("unroll") for (int d0 = 0; d0 < 6; ++d0) { const bf16x8 b0 = *reinterpret_cast<const bf16x8*>(ks_ + d0 * 32), b1 = *reinterpret_cast<const bf16x8*>(ks_ + 32 * KROWB + d0 * 32); \
      if (d0 == 0) { P0 = __builtin_amdgcn_mfma_f32_32x32x16_bf16(b0, qr[0], negm, 0, 0, 0); P1 = __builtin_amdgcn_mfma_f32_32x32x16_bf16(b1, qr[0], negm, 0, 0, 0); } \
      else { P0 = __builtin_amdgcn_mfma_f32_32x32x16_bf16(b0, qr[d0], P0, 0, 0, 0); P1 = __builtin_amdgcn_mfma_f32_32x32x16_bf16(b1, qr[d0], P1, 0, 0, 0); } } } while (0)
#define AT_RESC(a) do { if (__any((a) < 1.f)) { if (hi == 0) al_l[r32] = (a); asm volatile("s_waitcnt lgkmcnt(0)" ::: "memory"); \
    _Pragma("unroll") for (int d = 0; d < 2; ++d) _Pragma("unroll") for (int r = 0; r < 16; ++r) o[d][r] *= al_l[crow(r, hi)]; } } while (0)
  f32x16 pA0, pA1, pB0, pB1; float alA, alB; bf16x8 pa0, pa1, pa2, pa3;
  if (k2) asm volatile("s_waitcnt vmcnt(6)" ::: "memory"); else asm volatile("s_waitcnt vmcnt(4)" ::: "memory");
  __builtin_amdgcn_s_barrier();
  AT_QKT(pA0, pA1, 0); partialSM<VAR, true>(pA0, pA1, m_reg, negm, alA);
  AT_WAITBAR(1);
  for (int j = 1; j + 1 < NTL; j += 2) {
    AT_DMA(j + 2);
    vfrag_issue(vf, vb0 + ((j - 1) & 3) * SLOT_B);
    AT_SBAR(); AT_QKT(pB0, pB1, j);
    finishSM<VAR>(pA0, pA1, alA, l_reg, pa0, pa1, pa2, pa3); AT_SBAR();
    pv_mma(o, vf, pa0, pa1, pa2, pa3); partialSM<VAR, false>(pB0, pB1, m_reg, negm, alB);
    AT_RESC(alB);
    AT_WAITBAR(1);
    if (j + 3 < NTL) AT_DMA(j + 3);
    vfrag_issue(vf, vb0 + (j & 3) * SLOT_B);
    AT_SBAR(); AT_QKT(pA0, pA1, j + 1);
    finishSM<VAR>(pB0, pB1, alB, l_reg, pa0, pa1, pa2, pa3); AT_SBAR();
    pv_mma(o, vf, pa0, pa1, pa2, pa3); partialSM<VAR, false>(pA0, pA1, m_reg, negm, alA);
    AT_RESC(alA);
    if (j + 3 < NTL) AT_WAITBAR(1); else AT_WAITBAR(0);
  }
  vfrag_issue(vf, vb0 + ((NTL - 2) & 3) * SLOT_B);
  AT_SBAR(); AT_QKT(pB0, pB1, NTL - 1);
  finishSM<VAR>(pA0, pA1, alA, l_reg, pa0, pa1, pa2, pa3); AT_SBAR();
  pv_mma(o, vf, pa0, pa1, pa2, pa3); partialSM<VAR, false>(pB0, pB1, m_reg, negm, alB);
  AT_RESC(alB);
  finishSM<VAR>(pB0, pB1, alB, l_reg, pa0, pa1, pa2, pa3); AT_SBAR();
  pv_d0(o, vb0 + ((NTL - 1) & 3) * SLOT_B, pa0, pa1, pa2, pa3);
  if (hi == 0) li_l[r32] = l_reg; asm volatile("s_waitcnt lgkmcnt(0)" ::: "memory");
  float rli[16];
#pragma unroll
  for (int r = 0; r < 16; ++r) rli[r] = __builtin_amdgcn_rcpf(li_l[crow(r, hi)]);
#pragma unroll
  for (int r = 0; r < 16; ++r) { const int orow = wid * QBLK + crow(r, hi);
#pragma unroll
    for (int d0 = 0; d0 < 2; ++d0) { if (VAR != 0 && seq >= 0) continue; const float ga = bf2f(GA[(long)orow * ga_pitch + d0 * 32 + r32]);
      Ob[(long)orow * o_pitch + d0 * 32 + r32] = f2bf(o[d0][r] * rli[r] * (ga * __builtin_amdgcn_rcpf(1.f + __expf(-ga)))); } }
  asm volatile("s_waitcnt vmcnt(0) lgkmcnt(0)" ::: "memory"); __builtin_amdgcn_s_barrier();
#undef AT_DMA
#undef AT_WAITBAR
#undef AT_QKT
#undef AT_RESC
}

__device__ __forceinline__ void pv_mma_nw(f32x16* o, const VFrag& f, bf16x8 pa0, bf16x8 pa1, bf16x8 pa2, bf16x8 pa3) {
#define AT_PK(L, H) (bf16x8){L[0], L[1], L[2], L[3], H[0], H[1], H[2], H[3]}
  o[0] = __builtin_amdgcn_mfma_f32_32x32x16_bf16(pa0, AT_PK(f.l[0][0], f.h[0][0]), o[0], 0, 0, 0); o[1] = __builtin_amdgcn_mfma_f32_32x32x16_bf16(pa0, AT_PK(f.l[1][0], f.h[1][0]), o[1], 0, 0, 0);
  o[0] = __builtin_amdgcn_mfma_f32_32x32x16_bf16(pa1, AT_PK(f.l[0][1], f.h[0][1]), o[0], 0, 0, 0); o[1] = __builtin_amdgcn_mfma_f32_32x32x16_bf16(pa1, AT_PK(f.l[1][1], f.h[1][1]), o[1], 0, 0, 0);
  o[0] = __builtin_amdgcn_mfma_f32_32x32x16_bf16(pa2, AT_PK(f.l[0][2], f.h[0][2]), o[0], 0, 0, 0); o[1] = __builtin_amdgcn_mfma_f32_32x32x16_bf16(pa2, AT_PK(f.l[1][2], f.h[1][2]), o[1], 0, 0, 0);
  o[0] = __builtin_amdgcn_mfma_f32_32x32x16_bf16(pa3, AT_PK(f.l[0][3], f.h[0][3]), o[0], 0, 0, 0); o[1] = __builtin_amdgcn_mfma_f32_32x32x16_bf16(pa3, AT_PK(f.l[1][3], f.h[1][3]), o[1], 0, 0, 0);
#undef AT_PK
}
__device__ __forceinline__ float max3_(float a, float b, float c) { float r; asm("v_max3_f32 %0, %1, %2, %3" : "=v"(r) : "v"(a), "v"(b), "v"(c)); return r; }
__device__ __forceinline__ float rowmax32_fast(const f32x16& p0, const f32x16& p1) {
  float a = max3_(p0[0], p0[1], p1[0]), b = max3_(p0[2], p0[3], p1[1]); a = max3_(a, p1[2], p1[3]);
#pragma unroll
  for (int r = 4; r < 16; r += 4) { a = max3_(a, p0[r], p0[r + 1]); b = max3_(b, p0[r + 2], p0[r + 3]); a = max3_(a, p1[r], p1[r + 1]); b = max3_(b, p1[r + 2], p1[r + 3]); }
  const float pm = max3_(a, b, b);
  auto rr = __builtin_amdgcn_permlane32_swap(__float_as_uint(pm), __float_as_uint(pm), false, false);
  return max3_(__uint_as_float(rr[0]), __uint_as_float(rr[1]), __uint_as_float(rr[1]));
}
__device__ __forceinline__ void softmax_seg(f32x16& p0, f32x16& p1, float& m_reg, f32x16& negm, float& l_reg, f32x16* o, float* al_l, int r32, int hi, bool first,
                                            bf16x8& pa0, bf16x8& pa1, bf16x8& pa2, bf16x8& pa3) {
  const float pmax = rowmax32_fast(p0, p1);
  float alpha = 1.f;
  if (first || !__builtin_expect(__all(pmax <= THR), 1)) {
    const float dl = first ? pmax : fmaxf(pmax, 0.f);
    m_reg += dl; alpha = first ? 0.f : __builtin_amdgcn_exp2f(-dl);
#pragma unroll
    for (int r = 0; r < 16; ++r) { p0[r] -= dl; p1[r] -= dl; negm[r] = -m_reg; }
    if (!first) { if (hi == 0) al_l[r32] = alpha; asm volatile("s_waitcnt lgkmcnt(0)" ::: "memory");
#pragma unroll
      for (int d = 0; d < 2; ++d)
#pragma unroll
        for (int r = 0; r < 16; ++r) o[d][r] *= al_l[crow(r, hi)]; }
  }
#pragma unroll
  for (int r = 0; r < 16; ++r) p0[r] = __builtin_amdgcn_exp2f(p0[r]);
#pragma unroll
  for (int r = 0; r < 16; ++r) p1[r] = __builtin_amdgcn_exp2f(p1[r]);
  float ps = 0;
#pragma unroll
  for (int r = 0; r < 16; ++r) ps += p0[r];
#pragma unroll
  for (int r = 0; r < 16; ++r) ps += p1[r];
  { auto rr = __builtin_amdgcn_permlane32_swap(__float_as_uint(ps), __float_as_uint(ps), false, false);
    ps = __uint_as_float(rr[0]) + __uint_as_float(rr[1]); }
  l_reg = l_reg * alpha + ps;
#define AT_PK4(P, BASE, OUT) do { unsigned a0 = cvtpk(P[BASE + 0], P[BASE + 1]), a1 = cvtpk(P[BASE + 2], P[BASE + 3]);   \
    unsigned b0 = cvtpk(P[BASE + 4], P[BASE + 5]), b1 = cvtpk(P[BASE + 6], P[BASE + 7]);                              \
    auto r0 = __builtin_amdgcn_permlane32_swap(a0, b0, false, false); auto r1 = __builtin_amdgcn_permlane32_swap(a1, b1, false, false); \
    u32x4 w = {r0[0], r1[0], r0[1], r1[1]}; OUT = *reinterpret_cast<bf16x8*>(&w); } while (0)
  AT_PK4(p0, 0, pa0); AT_PK4(p0, 8, pa1); AT_PK4(p1, 0, pa2); AT_PK4(p1, 8, pa3);
#undef AT_PK4
}
template <int VAR> __device__ __forceinline__ void attn_unit_st(const bf16_t* __restrict__ Qb, const bf16_t* __restrict__ Kh, const bf16_t* __restrict__ Vh, int seq,
                                          bf16_t* __restrict__ Ob, int o_pitch, const bf16_t* __restrict__ GA, int ga_pitch, char* lds, LAS unsigned char* L3) {
  int tid_ = TIDX; asm volatile("" : "+v"(tid_));
  const int tid = tid_, lane = tid & 63, r32 = lane & 31, hi = lane >> 5; const int wid = __builtin_amdgcn_readfirstlane(tid >> 6);
  const bool grpA = wid < 4;
  float* ws = (float*)(lds + LDS_WS) + wid * 64; float* li_l = ws; float* al_l = ws + 32;
  float m_reg = 0.f, l_reg = 0; f32x16 o[2] = {}; bf16x8 qr[6]; f32x16 negm = {}; VFrag vf; f32x16 p0 = {}, p1 = {}; bf16x8 pa0 = {}, pa1 = {}, pa2 = {}, pa3 = {};
  int koff0, koff1, voff;
  { const int s0 = 64 * wid + lane, row0 = s0 / 13, c0 = s0 - row0 * 13; koff0 = row0 * 192 + (c0 < 12 ? c0 : 0) * 16;
    const int s1 = s0 + 512, row1 = s1 / 13, c1 = s1 - row1 * 13; koff1 = row1 * 192 + (c1 < 12 ? c1 : 0) * 16;
    const int sub = s0 >> 5, kk = (sub >> 1) * 8 + ((s0 & 31) >> 2), k = (kk & ~0xC) | ((kk & 4) << 1) | ((kk & 8) >> 1), c = (sub & 1) * 32 + (s0 & 3) * 8; voff = k * 128 + c * 2; }
  const bool k2 = wid < 5;
  const __amdgpu_buffer_rsrc_t rsK = __builtin_amdgcn_make_buffer_rsrc((void*)Kh, 0, 0x7ffffff0, 0x00020000), rsV = __builtin_amdgcn_make_buffer_rsrc((void*)Vh, 0, 0x7ffffff0, 0x00020000);
#define AT_DMA(t) do { const int so_ = ((t) & 3) * SLOT_B; \
    __builtin_amdgcn_raw_ptr_buffer_load_lds(rsK, (LAS void*)(L3 + so_ + wid * 1024), 16, koff0, (t) * (64 * 192), 0, 0); \
    if (k2) __builtin_amdgcn_raw_ptr_buffer_load_lds(rsK, (LAS void*)(L3 + so_ + (wid + 8) * 1024), 16, koff1, (t) * (64 * 192), 0, 0); \
    __builtin_amdgcn_raw_ptr_buffer_load_lds(rsV, (LAS void*)(L3 + so_ + SLOT_KB + wid * 1024), 16, voff, (t) * (64 * 128), 0, 0); } while (0)
#define AT_WAITBAR(n) do { if (k2) asm volatile("s_waitcnt vmcnt(" #n "*3) lgkmcnt(0)" ::: "memory"); else asm volatile("s_waitcnt vmcnt(" #n "*2) lgkmcnt(0)" ::: "memory"); AT_SBAR(); __builtin_amdgcn_s_barrier(); AT_SBAR(); } while (0)
#define AT_BAR() do { AT_SBAR(); __builtin_amdgcn_s_barrier(); AT_SBAR(); } while (0)
  const int NTL = seq / KVBLK;
  const bf16_t* Qw = Qb + (long)(wid * QBLK + r32) * DQK + hi * 8;
#pragma unroll
  for (int d0 = 0; d0 < 6; ++d0) qr[d0] = *reinterpret_cast<const bf16x8*>(Qw + d0 * 16);
  AT_DMA(0); AT_DMA(1);
  const int kb = r32 * KROWB + hi * 16;
  const int vb0 = (int)(uintptr_t)lds + SLOT_KB + v_rd_base(lane);
#define AT_SEG_M(t) do { const char* ks_ = lds + ((t) & 3) * SLOT_B + kb; bf16x8 kf0[6], kf1[6]; \
    _Pragma("unroll") for (int d0 = 0; d0 < 6; ++d0) { kf0[d0] = *reinterpret_cast<const bf16x8*>(ks_ + d0 * 32); kf1[d0] = *reinterpret_cast<const bf16x8*>(ks_ + 32 * KROWB + d0 * 32); } \
    AT_SBAR(); __builtin_amdgcn_s_setprio(1); if ((t) >= 1) pv_mma_nw(o, vf, pa0, pa1, pa2, pa3); \
    p0 = __builtin_amdgcn_mfma_f32_32x32x16_bf16(kf0[0], qr[0], negm, 0, 0, 0); p1 = __builtin_amdgcn_mfma_f32_32x32x16_bf16(kf1[0], qr[0], negm, 0, 0, 0); \
    _Pragma("unroll") for (int d0 = 1; d0 < 6; ++d0) { p0 = __builtin_amdgcn_mfma_f32_32x32x16_bf16(kf0[d0], qr[d0], p0, 0, 0, 0); p1 = __builtin_amdgcn_mfma_f32_32x32x16_bf16(kf1[d0], qr[d0], p1, 0, 0, 0); } __builtin_amdgcn_s_setprio(0); } while (0)
#define AT_SEG_V(t) do { vfrag_issue(vf, vb0 + ((t) & 3) * SLOT_B); AT_SBAR(); \
    softmax_seg(p0, p1, m_reg, negm, l_reg, o, al_l, r32, hi, (t) == 0, pa0, pa1, pa2, pa3); asm volatile("s_waitcnt lgkmcnt(0)" ::: "memory"); } while (0)
  if (k2) asm volatile("s_waitcnt vmcnt(3)" ::: "memory"); else asm volatile("s_waitcnt vmcnt(2)" ::: "memory");
  AT_BAR();
  if (!grpA) AT_BAR();
  for (int t = 0; t < NTL; ++t) {
    if (t + 2 < NTL) AT_DMA(t + 2);
    AT_SEG_M(t);
    if (t + 2 < NTL) AT_WAITBAR(1); else AT_WAITBAR(0);
    AT_SEG_V(t);
    AT_BAR();
  }
  pv_mma_nw(o, vf, pa0, pa1, pa2, pa3);
  if (grpA) AT_BAR();
  if (hi == 0) li_l[r32] = l_reg; asm volatile("s_waitcnt lgkmcnt(0)" ::: "memory");
  float rli[16];
#pragma unroll
  for (int r = 0; r < 16; ++r) rli[r] = __builtin_amdgcn_rcpf(li_l[crow(r, hi)]);
#pragma unroll
  for (int r = 0; r < 16; ++r) { const int orow = wid * QBLK + crow(r, hi);
#pragma unroll
    for (int d0 = 0; d0 < 2; ++d0) { const float ga = bf2f(GA[(long)orow * ga_pitch + d0 * 32 + r32]);
      Ob[(long)orow * o_pitch + d0 * 32 + r32] = f2bf(o[d0][r] * rli[r] * (ga * __builtin_amdgcn_rcpf(1.f + __expf(-ga)))); } }
  asm volatile("s_waitcnt vmcnt(0) lgkmcnt(0)" ::: "memory"); __builtin_amdgcn_s_barrier();
#undef AT_DMA
#undef AT_WAITBAR
#undef AT_BAR
#undef AT_SEG_M
#undef AT_SEG_V
}
#undef AT_KSWZ
#undef AT_SBAR
}


namespace ssd {
using attn::bf16x8; using attn::s16x4; using attn::f32x16; using attn::u32x4;
constexpr int LC = 128, NCH = 66;
constexpr int L_X = 0, L_B = 65536, L_C = 81920, L_CS = 98304, L_DT = L_CS + 4096, L_SC = L_DT + 4096;
constexpr float LOG2E = 1.4426950408889634f;
__device__ __forceinline__ int rimg(int row, int c) { return row * 128 + ((c ^ (row & 7)) << 4); }
__device__ __forceinline__ int chunk_row(int b, int c) { return c < 2 ? ML + b * CTXL + c * LC : b * SEQ + (c - 2) * LC; }
__device__ __forceinline__ float bfbits2f(short v) { return __uint_as_float(((unsigned)(unsigned short)v) << 16); }
template <bool STEP3> __device__ __forceinline__ float load_chunk(const bf16_t* __restrict__ U, const float* __restrict__ DTS, const float* __restrict__ a_log, int rowbase, int g, char* lds) {
    int tid_ = TIDX; asm volatile("" : "+v"(tid_)); const int tid = tid_;
    constexpr int NLD = STEP3 ? 12 : 10, NB2 = NLD / 2;
#pragma unroll
    for (int hb = 0; hb < 2; ++hb) {
        bf16x8 stg[NB2];
#pragma unroll
        for (int q = 0; q < NB2; ++q) { const int it = hb * NB2 + q; const int i = tid + it * NT;
            if (it < 8) { const int s = i >> 5, cc = i & 31; stg[q] = *(const bf16x8*)(U + (size_t)(rowbase + s) * 768 + g * 256 + cc * 8); }
            else if (it < 10) { const int j = i - 4096, s = j >> 3, c = j & 7; stg[q] = *(const bf16x8*)(U + (size_t)(rowbase + s) * 768 + 512 + g * 64 + c * 8); }
            else { const int j = i - 5120, s = j >> 3, c = j & 7; stg[q] = *(const bf16x8*)(U + (size_t)(rowbase + s) * 768 + 640 + g * 64 + c * 8); } }
#pragma unroll
        for (int q = 0; q < NB2; ++q) { const int it = hb * NB2 + q; const int i = tid + it * NT;
            if (it < 8) { const int s = i >> 5, cc = i & 31, hh = cc >> 3, c8 = (cc & 7) * 8; *(bf16x8*)(lds + L_X + hh * 16384 + attn::v_st(s, c8)) = stg[q]; }
            else if (it < 10) { const int j = i - 4096, s = j >> 3, c = j & 7; *(bf16x8*)(lds + L_B + (STEP3 ? rimg(s, c) : attn::v_st(s, c * 8))) = stg[q]; }
            else { const int j = i - 5120, s = j >> 3, c = j & 7; *(bf16x8*)(lds + L_C + rimg(s, c)) = stg[q]; } }
    }
    const int w = tid >> 6, lane = tid & 63, d = w >> 2, hh = w & 3, h = g * 4 + hh;
    const float A2 = -__expf(a_log[d * 8 + h]) * LOG2E;
    const int s0 = d ? 127 - lane : lane, s1 = d ? 63 - lane : 64 + lane;
    const float dt0 = DTS[(size_t)(rowbase + s0) * 16 + d * 8 + h], dt1 = DTS[(size_t)(rowbase + s1) * 16 + d * 8 + h];
    float x0 = dt0 * A2, x1 = dt1 * A2;
    { int ln = lane; asm volatile("" : "+v"(ln));
#pragma unroll
      for (int off = 1; off < 64; off <<= 1) { const int src = (ln - off) << 2;
          const float t0 = __int_as_float(__builtin_amdgcn_ds_bpermute(src, __float_as_int(x0))), t1 = __int_as_float(__builtin_amdgcn_ds_bpermute(src, __float_as_int(x1)));
          if (ln >= off) { x0 += t0; x1 += t1; } } }
    x1 += __int_as_float(__builtin_amdgcn_readlane(__float_as_int(x0), 63)); const float T = __int_as_float(__builtin_amdgcn_readlane(__float_as_int(x1), 63));
    float* CS = (float*)(lds + L_CS) + w * 128; float* DTL = (float*)(lds + L_DT) + w * 128; float* SC = (float*)(lds + L_SC) + w * 128;
    CS[s0] = x0; CS[s1] = x1; DTL[s0] = dt0; DTL[s1] = dt1;
    if (STEP3) { SC[s0] = exp2f(x0); SC[s1] = exp2f(x1); } else { SC[s0] = dt0 * exp2f(T - x0); SC[s1] = dt1 * exp2f(T - x1); }
    return T;
}
#define SSD_SBAR() __builtin_amdgcn_sched_barrier(0)
template <int KS> __device__ __forceinline__ void st1_step(f32x16 (&acc)[2][2], int vbx, int vbb, const float* SCw, int hi) {
    typedef float f32x4v __attribute__((ext_vector_type(4)));
    const f32x4v sA = *(const f32x4v*)(SCw + 16 * KS + 8 * hi), sB = *(const f32x4v*)(SCw + 16 * KS + 8 * hi + 4);
    const s16x4 xl0 = attn::tr_read<attn::v_rd_off(0, KS, 0)>(vbx), xh0 = attn::tr_read<attn::v_rd_off(0, KS, 1)>(vbx);
    const s16x4 xl1 = attn::tr_read<attn::v_rd_off(1, KS, 0)>(vbx), xh1 = attn::tr_read<attn::v_rd_off(1, KS, 1)>(vbx);
    const s16x4 bl0 = attn::tr_read<attn::v_rd_off(0, KS, 0)>(vbb), bh0 = attn::tr_read<attn::v_rd_off(0, KS, 1)>(vbb);
    const s16x4 bl1 = attn::tr_read<attn::v_rd_off(1, KS, 0)>(vbb), bh1 = attn::tr_read<attn::v_rd_off(1, KS, 1)>(vbb);
    asm volatile("s_waitcnt lgkmcnt(0)" ::: "memory"); SSD_SBAR();
#define SSD_SCL(L, H) ({ u32x4 w_; w_.x = attn::cvtpk(bfbits2f(L[0]) * sA[0], bfbits2f(L[1]) * sA[1]); w_.y = attn::cvtpk(bfbits2f(L[2]) * sA[2], bfbits2f(L[3]) * sA[3]); \
        w_.z = attn::cvtpk(bfbits2f(H[0]) * sB[0], bfbits2f(H[1]) * sB[1]); w_.w = attn::cvtpk(bfbits2f(H[2]) * sB[2], bfbits2f(H[3]) * sB[3]); *reinterpret_cast<bf16x8*>(&w_); })
#define SSD_PK(L, H) (bf16x8){L[0], L[1], L[2], L[3], H[0], H[1], H[2], H[3]}
    const bf16x8 a0 = SSD_SCL(xl0, xh0), a1 = SSD_SCL(xl1, xh1), b0 = SSD_PK(bl0, bh0), b1 = SSD_PK(bl1, bh1);
    acc[0][0] = __builtin_amdgcn_mfma_f32_32x32x16_bf16(a0, b0, acc[0][0], 0, 0, 0); acc[0][1] = __builtin_amdgcn_mfma_f32_32x32x16_bf16(a0, b1, acc[0][1], 0, 0, 0);
    acc[1][0] = __builtin_amdgcn_mfma_f32_32x32x16_bf16(a1, b0, acc[1][0], 0, 0, 0); acc[1][1] = __builtin_amdgcn_mfma_f32_32x32x16_bf16(a1, b1, acc[1][1], 0, 0, 0);
#undef SSD_SCL
}
__device__ __forceinline__ void states_item(const bf16_t* U, const float* DTS, const float* a_log, bf16_t* SST, float* CD, int b, int c, int g, char* lds) {
    const float T = load_chunk<false>(U, DTS, a_log, chunk_row(b, c), g, lds);
    __syncthreads();
    const int tid = TIDX, w = tid >> 6, lane = tid & 63, r32 = lane & 31, hi = lane >> 5, d = w >> 2, hh = w & 3, h = g * 4 + hh;
    const int vbx = (int)(uintptr_t)(lds + L_X + hh * 16384) + attn::v_rd_base(lane), vbb = (int)(uintptr_t)(lds + L_B) + attn::v_rd_base(lane);
    const float* SCw = (const float*)(lds + L_SC) + w * 128;
    f32x16 acc[2][2] = {};
    st1_step<0>(acc, vbx, vbb, SCw, hi); st1_step<1>(acc, vbx, vbb, SCw, hi); st1_step<2>(acc, vbx, vbb, SCw, hi); st1_step<3>(acc, vbx, vbb, SCw, hi);
    st1_step<4>(acc, vbx, vbb, SCw, hi); st1_step<5>(acc, vbx, vbb, SCw, hi); st1_step<6>(acc, vbx, vbb, SCw, hi); st1_step<7>(acc, vbx, vbb, SCw, hi);
    const size_t cidx = (((size_t)b * NCH + c) * 2 + d) * 8 + h;
    bf16_t* So = SST + cidx * 4096;
#pragma unroll
    for (int pb = 0; pb < 2; ++pb)
#pragma unroll
        for (int nb = 0; nb < 2; ++nb)
#pragma unroll
            for (int r = 0; r < 16; ++r) So[(pb * 32 + attn::crow(r, hi)) * 64 + nb * 32 + r32] = f2bf(acc[pb][nb][r]);
    if (lane == 0) CD[cidx] = exp2f(T);
    __syncthreads();
}
__device__ __forceinline__ void out_item(const bf16_t* U, const float* DTS, const float* a_log, const bf16_t* HIN, bf16_t* Y, int b, int j, int g, char* lds) {
    typedef float f32x4v __attribute__((ext_vector_type(4)));
    const int rowbase = b * SEQ + j * LC, c = j + 2;
    int tid_ = TIDX; asm volatile("" : "+v"(tid_));
    const int tid = tid_, w = tid >> 6, lane = tid & 63, r32 = lane & 31, hi = lane >> 5, hh = w & 3, lp = w >> 2, h = g * 4 + hh;
    bf16x8 hbn[4][2];
#define SSD_HLOAD(dd) do { const bf16_t* Hp_ = HIN + ((((size_t)b * NCH + c) * 2 + (dd)) * 8 + h) * 4096; \
    _Pragma("unroll") for (int ks = 0; ks < 4; ++ks) { const bf16_t* h0 = Hp_ + r32 * 64 + ks * 16 + hi * 8; hbn[ks][0] = *(const bf16x8*)h0; hbn[ks][1] = *(const bf16x8*)(h0 + 32 * 64); } } while (0)
    SSD_HLOAD(0);
    (void)load_chunk<true>(U, DTS, a_log, rowbase, g, lds);
    __syncthreads();
    const char* BR = lds + L_B; const char* CR = lds + L_C;
    const int vbx = (int)(uintptr_t)(lds + L_X + hh * 16384) + attn::v_rd_base(lane);
#pragma unroll
    for (int lti = 0; lti < 2; ++lti) { const int lt = 2 * lp + lti, l = 32 * lt + r32;
        f32x16 y0 = {}, y1 = {};
#pragma unroll
        for (int d = 0; d < 2; ++d) { const int combo = d * 4 + hh;
            const float* CSw = (const float*)(lds + L_CS) + combo * 128; const float* DTw = (const float*)(lds + L_DT) + combo * 128; const float* ELw = (const float*)(lds + L_SC) + combo * 128;
            f32x16 t0 = {}, t1 = {};
            bf16x8 hb[4][2];
#pragma unroll
            for (int ks = 0; ks < 4; ++ks) { hb[ks][0] = hbn[ks][0]; hb[ks][1] = hbn[ks][1]; }
            if (!(lti == 1 && d == 1)) SSD_HLOAD(1 - d);
#pragma unroll
            for (int ks = 0; ks < 4; ++ks) { const bf16x8 A = *(const bf16x8*)(CR + rimg(l, 2 * ks + hi));
                t0 = __builtin_amdgcn_mfma_f32_32x32x16_bf16(A, hb[ks][0], t0, 0, 0, 0);
                t1 = __builtin_amdgcn_mfma_f32_32x32x16_bf16(A, hb[ks][1], t1, 0, 0, 0); }
#pragma unroll
            for (int k4 = 0; k4 < 4; ++k4) { const f32x4v fv = *(const f32x4v*)(ELw + 32 * lt + 4 * hi + 8 * k4);
#pragma unroll
                for (int i = 0; i < 4; ++i) { t0[4 * k4 + i] *= fv[i]; t1[4 * k4 + i] *= fv[i]; } }
            const float fl = CSw[l];
#pragma unroll
            for (int st = 0; st < 2; ++st) {
                const bool need = d == 0 ? (64 * st <= 32 * lt + 31) : (64 * st + 63 >= 32 * lt);
                if (need) {
                    f32x16 p0 = {}, p1 = {};
#pragma unroll
                    for (int ks = 0; ks < 4; ++ks) { const bf16x8 q = *(const bf16x8*)(CR + rimg(l, 2 * ks + hi));
                        const bf16x8 b0 = *(const bf16x8*)(BR + rimg(64 * st + r32, 2 * ks + hi)), b1 = *(const bf16x8*)(BR + rimg(64 * st + 32 + r32, 2 * ks + hi));
                        p0 = __builtin_amdgcn_mfma_f32_32x32x16_bf16(b0, q, p0, 0, 0, 0); p1 = __builtin_amdgcn_mfma_f32_32x32x16_bf16(b1, q, p1, 0, 0, 0); }
#pragma unroll
                    for (int k4 = 0; k4 < 4; ++k4) {
                        const int sb = 64 * st + 8 * k4 + 4 * hi;
                        const f32x4v c0v = *(const f32x4v*)(CSw + sb), c1v = *(const f32x4v*)(CSw + sb + 32), d0v = *(const f32x4v*)(DTw + sb), d1v = *(const f32x4v*)(DTw + sb + 32);
#pragma unroll
                        for (int i = 0; i < 4; ++i) { const int r = 4 * k4 + i, s0 = sb + i, s1 = s0 + 32;
                            const bool m0 = d == 0 ? (s0 <= l) : (s0 >= l), m1 = d == 0 ? (s1 <= l) : (s1 >= l);
                            p0[r] = m0 ? p0[r] * (__builtin_amdgcn_exp2f(fl - c0v[i]) * d0v[i]) : 0.f; p1[r] = m1 ? p1[r] * (__builtin_amdgcn_exp2f(fl - c1v[i]) * d1v[i]) : 0.f; }
                        asm volatile("" ::: "memory"); }
                    bf16x8 pa0, pa1, pa2, pa3;
#define SSD_PK4(P, BASE, OUT) do { unsigned a0 = attn::cvtpk(P[BASE + 0], P[BASE + 1]), a1 = attn::cvtpk(P[BASE + 2], P[BASE + 3]);   \
    unsigned b0_ = attn::cvtpk(P[BASE + 4], P[BASE + 5]), b1_ = attn::cvtpk(P[BASE + 6], P[BASE + 7]);                              \
    auto r0 = __builtin_amdgcn_permlane32_swap(a0, b0_, false, false); auto r1 = __builtin_amdgcn_permlane32_swap(a1, b1_, false, false); \
    u32x4 w_ = {r0[0], r1[0], r0[1], r1[1]}; OUT = *reinterpret_cast<bf16x8*>(&w_); } while (0)
                    SSD_PK4(p0, 0, pa0); SSD_PK4(p0, 8, pa1); SSD_PK4(p1, 0, pa2); SSD_PK4(p1, 8, pa3);
#undef SSD_PK4
                    SSD_SBAR();
                    attn::pv_one<0>(t0, vbx + st * 8192, pa0, pa1, pa2, pa3); attn::pv_one<1>(t1, vbx + st * 8192, pa0, pa1, pa2, pa3);
                }
            }
            y0 += t0; y1 += t1;
        }
#pragma unroll
        for (int r = 0; r < 16; ++r) { bf16_t* yr = Y + (size_t)(rowbase + 32 * lt + attn::crow(r, hi)) * 512 + h * 64 + r32; yr[0] = f2bf(y0[r]); yr[32] = f2bf(y1[r]); }
    }
    __syncthreads();
#undef SSD_HLOAD
}
#undef SSD_PK
#undef SSD_SBAR
}

struct Ptrs {
    const float *x, *c, *ctx, *c_ctx, *mod_w, *mod_b, *norm_w, *w_in_mix, *q_norm, *w_uq, *kv_norm, *w_ukv, *conv_w, *conv_b, *a_log, *dt_bias, *d_skip, *ssd_norm,
        *w_out_mix, *w_in_pool, *pool_lin, *pool_scale, *w_out_pool, *final_norm;
    float* out; char* ws;
};


__device__ __forceinline__ unsigned pk2(float lo, float hi) { return (unsigned)f2bf(lo) | ((unsigned)f2bf(hi) << 16); }
typedef unsigned v4u __attribute__((ext_vector_type(4)));
__device__ __forceinline__ void tr_item(const float* W, int ldw, int Nsrc, int K, bf16_t* WT, int row_off, const float* kscale, int ks_off, const float* nscale, float gscale,
                                        LAS float* scr, int item, int nblk, int lane) {
    const int kb = item / nblk, nb = item % nblk, k0 = 64 * kb, n0 = 32 * nb;
    const int n4 = n0 + 4 * (lane & 7); const bool nin = n4 < Nsrc;
    f32x4 ns = {gscale, gscale, gscale, gscale};
    if (nscale && nin) { const f32x4 t = *(const f32x4*)(nscale + n4); ns = t * gscale; }
#pragma unroll
    for (int i = 0; i < 8; ++i) { const int kk = 8 * i + (lane >> 3);
        f32x4 w = nin ? *(const f32x4*)(W + (size_t)(k0 + kk) * ldw + n4) : (f32x4){0.f, 0.f, 0.f, 0.f};
        if (kscale && (k0 + kk) >= ks_off) w = w * kscale[k0 + kk - ks_off];
        w = w * ns;
        LAS float* d = scr + kk * 33 + 4 * (lane & 7); d[0] = w[0]; d[1] = w[1]; d[2] = w[2]; d[3] = w[3]; }
    asm volatile("s_waitcnt lgkmcnt(0)" ::: "memory");
    const int c = lane & 7;
#pragma unroll
    for (int j = 0; j < 4; ++j) { const int n = (lane >> 3) + 8 * j; const LAS float* sp = scr + (8 * c) * 33 + n;
        v4u o; o.x = pk2(sp[0 * 33], sp[1 * 33]); o.y = pk2(sp[2 * 33], sp[3 * 33]); o.z = pk2(sp[4 * 33], sp[5 * 33]); o.w = pk2(sp[6 * 33], sp[7 * 33]);
        *(v4u*)(WT + (size_t)(row_off + n0 + n) * K + k0 + 8 * c) = o; }
    asm volatile("s_waitcnt lgkmcnt(0)" ::: "memory");
}
__device__ __forceinline__ void ph_weights(const Ptrs& P, LAS unsigned char* L) {
    const int lane = TIDX & 63, wv = TIDX >> 6;
    LAS float* scr = (LAS float*)(L + wv * 16384);
    const int gw = blockIdx.x * (NT / 64) + wv, NGW = gridDim.x * (NT / 64);
    constexpr int I1 = 16 * 80, I2 = 6 * 24, I3 = 4 * 32, I4 = 16 * 32, I5 = 16 * 64, I6 = 4 * 32, I7 = 16 * 32;
    for (int it = gw; it < I1 + I2 + I3 + I4 + I5 + I6 + I7; it += NGW) {
        int r = it;
        if (r < I1) { tr_item(P.w_in_mix, 2480, 2480, 1024, (bf16_t*)(P.ws + WS_WT1), 0, nullptr, 0, nullptr, 1.f, scr, r, 80, lane); continue; } r -= I1;
        if (r < I2) { tr_item(P.w_uq, 768, 768, 384, (bf16_t*)(P.ws + WS_WTQ), 0, P.q_norm, 0, nullptr, QSCALE, scr, r, 24, lane); continue; } r -= I2;
        if (r < I3) { tr_item(P.w_ukv, 1024, 1024, 256, (bf16_t*)(P.ws + WS_WTKV), 0, P.kv_norm, 0, nullptr, 1.f, scr, r, 32, lane); continue; } r -= I3;
        if (r < I4) { tr_item(P.w_out_mix, 1024, 1024, 1024, (bf16_t*)(P.ws + WS_WTO), 0, P.ssd_norm, 512, nullptr, 1.f, scr, r, 32, lane); continue; } r -= I4;
        if (r < I5) { tr_item(P.w_in_pool, 2048, 2048, 1024, (bf16_t*)(P.ws + WS_WTP), 0, nullptr, 0, nullptr, 1.f, scr, r, 64, lane); continue; } r -= I5;
        if (r < I6) { const int g = r / 32; tr_item(P.pool_lin + (size_t)g * 65536, 256, 256, 256, (bf16_t*)(P.ws + WS_WTL), g * 256, nullptr, 0, P.pool_scale + g * 256, 1.f, scr, r % 32, 8, lane); continue; } r -= I6;
        tr_item(P.w_out_pool, 1024, 1024, 1024, (bf16_t*)(P.ws + WS_WTOP), 0, nullptr, 0, nullptr, 1.f, scr, r, 32, lane);
    }
}

__device__ __forceinline__ void ph_modvec(const Ptrs& P, LAS unsigned char* L) {
    float* modv = (float*)(P.ws + WS_MODV);
    LAS float* sv = (LAS float*)L;
    LAS float* red = (LAS float*)(L + 20480);
    const int tid = TIDX;
    for (int i = tid; i < 5 * 1024; i += NT) { const int v = i >> 10, k = i & 1023; sv[i] = siluf(v < 4 ? P.c[v * 1024 + k] : P.c_ctx[k]); }
    __syncthreads();
    for (int it = blockIdx.x; it < 2 * 128; it += gridDim.x) {
        const int layer = it >> 7, col0 = (it & 127) * 24;
        if (tid < 384) { const int c4 = tid % 6, kg = tid / 6;
            const float* wp = P.mod_w + ((size_t)layer * 1024 + kg * 16) * 3072 + col0 + c4 * 4;
            f32x4 w[16];
#pragma unroll
            for (int r = 0; r < 16; ++r) w[r] = *(const f32x4*)(wp + (size_t)r * 3072);
            f32x4 acc[5];
#pragma unroll
            for (int v = 0; v < 5; ++v) acc[v] = (f32x4){0.f, 0.f, 0.f, 0.f};
#pragma unroll
            for (int r = 0; r < 16; ++r)
#pragma unroll
                for (int v = 0; v < 5; ++v) acc[v] += w[r] * sv[v * 1024 + kg * 16 + r];
#pragma unroll
            for (int v = 0; v < 5; ++v) { LAS float* d = red + (kg * 5 + v) * 24 + c4 * 4; d[0] = acc[v][0]; d[1] = acc[v][1]; d[2] = acc[v][2]; d[3] = acc[v][3]; }
        }
        __syncthreads();
        if (tid < 120) { const int v = tid / 24, cc = tid % 24; float a = 0.f;
#pragma unroll 8
            for (int kg = 0; kg < 64; ++kg) a += red[(kg * 5 + v) * 24 + cc];
            modv[(layer * 5 + v) * 3072 + col0 + cc] = a + P.mod_b[layer * 3072 + col0 + cc]; }
        __syncthreads();
    }
    float* COS = (float*)(P.ws + WS_COS); float* SIN = (float*)(P.ws + WS_SIN);
    GSTRIDE(idx, SEQ * 16) {
        int t = (int)(idx / 16), j = (int)(idx % 16);
        float pos = (float)(j < 8 ? t / 64 : t % 64);
        float invf = 1.0f / powf(10000.0f, (float)(2 * (j & 7)) / 16.0f);
        float ang = pos * invf;
        COS[idx] = cosf(ang); SIN[idx] = sinf(ang);
    }
}
template <bool HAS_CTX> __device__ __forceinline__ void ph_norm_mod(const float* xl, const float* ctx, int nrows, const float* norm_w, const float* modv, bf16_t* H) {
    const int tid = TIDX, lane = tid & 63, gw = blockIdx.x * (NT / 64) + (tid >> 6), NGW = gridDim.x * (NT / 64);
    f32x4 nw[4];
#pragma unroll
    for (int j = 0; j < 4; ++j) nw[j] = *(const f32x4*)(norm_w + 4 * lane + 256 * j);
#define NM_SRC(r) ((!HAS_CTX || (r) < ML) ? xl + (size_t)(r) * DM : ctx + (size_t)((r) - ML) * DM)
    int vc = -1; f32x4 scv[4], shv[4];
    for (int row = 2 * gw; row < nrows; row += 2 * NGW) {
        f32x4 xv[2][4];
#pragma unroll
        for (int q = 0; q < 2; ++q) { const float* src = NM_SRC(row + q);
#pragma unroll
            for (int j = 0; j < 4; ++j) xv[q][j] = *(const f32x4*)(src + 4 * lane + 256 * j); }
        { const int v = (!HAS_CTX || row < ML) ? row / SEQ : 4;
          if (v != vc) { vc = v;
#pragma unroll
              for (int j = 0; j < 4; ++j) { const int k = 4 * lane + 256 * j; shv[j] = *(const f32x4*)(modv + v * 3072 + k); scv[j] = *(const f32x4*)(modv + v * 3072 + 1024 + k) + 1.f; } } }
#pragma unroll
        for (int q = 0; q < 2; ++q) { const int r = row + q; float ss = 0.f;
#pragma unroll
            for (int j = 0; j < 4; ++j) ss += (xv[q][j].x * xv[q][j].x + xv[q][j].y * xv[q][j].y) + (xv[q][j].z * xv[q][j].z + xv[q][j].w * xv[q][j].w);
            ss = wave_sum(ss);
            const float rstd = rsqrtf(ss * (1.f / DM) + RMS_EPS);
#pragma unroll
            for (int j = 0; j < 4; ++j) { const int k = 4 * lane + 256 * j;
                const f32x4 o = xv[q][j] * rstd * nw[j] * scv[j] + shv[j];
                uint2 w; w.x = pk2f(o.x, o.y); w.y = pk2f(o.z, o.w);
                *(uint2*)(H + (size_t)r * DM + k) = w; } }
    }
#undef NM_SRC
}
template <int RT, class Epi>
__device__ __forceinline__ void ph_gemm(const bf16_t* A, int lda, const float* W, int ldw, int M, int N, int K, const float* kscale, int ks_off, const Epi& E) {
    const int ncb = (N + NT - 1) / NT, nitems = ncb * (M / RT);
    for (int it = blockIdx.x; it < nitems; it += gridDim.x) {
        const int cb = it % ncb, rg = it / ncb; const int col = cb * NT + TIDX, row0 = rg * RT;
        float acc[RT];
#pragma unroll
        for (int r = 0; r < RT; ++r) acc[r] = 0.f;
        if (col < N) {
            for (int k = 0; k < K; ++k) {
                float w = W[(size_t)k * ldw + col];
                if (kscale && k >= ks_off) w *= kscale[k - ks_off];
#pragma unroll
                for (int r = 0; r < RT; ++r) acc[r] += bf2f(A[(size_t)(row0 + r) * lda + k]) * w;
            }
#pragma unroll
            for (int r = 0; r < RT; ++r) E(row0 + r, col, acc[r]);
        }
    }
}
struct EpiProj { bf16_t* P; float* DT;
    __device__ void operator()(int row, int col, float a) const { P[(size_t)row * PN + col] = f2bf(a); if (col >= C_DT) DT[row * 16 + col - C_DT] = a; } };
struct EpiRes { const float* res; const float* gate; float* out;
    __device__ void operator()(int row, int col, float a) const { int b = row / SEQ; out[(size_t)row * DM + col] = res[(size_t)row * DM + col] + gate[b * 3072 + 2048 + col] * a; } };
struct EpiBf { bf16_t* O; int ld;
    __device__ void operator()(int row, int col, float a) const { O[(size_t)row * ld + col] = f2bf(a); } };

__device__ __forceinline__ void ph_upproj(const Ptrs& P) {
    const bf16_t* PR = (const bf16_t*)(P.ws + WS_PROJ); const float* COS = (const float*)(P.ws + WS_COS); const float* SIN = (const float*)(P.ws + WS_SIN);
    bf16_t* Q = (bf16_t*)(P.ws + WS_Q); bf16_t* Kb = (bf16_t*)(P.ws + WS_K); bf16_t* Vb = (bf16_t*)(P.ws + WS_V);
    GSTRIDE(idx, MT * 16) {
        int jj = (int)(idx % 16), row = (int)(idx / 16); int b, t; bool isctx; row_info(row, b, t, isctx); int key = isctx ? t : CTXL + t;
        float k1 = bf2f(PR[(size_t)row * PN + C_KPE + jj]), k2 = bf2f(PR[(size_t)row * PN + C_KPE + 16 + jj]);
        float o1 = k1, o2 = k2;
        if (!isctx) { float cs = COS[t * 16 + jj], sn = SIN[t * 16 + jj]; o1 = k1 * cs - k2 * sn; o2 = k2 * cs + k1 * sn; }
        for (int h = 0; h < 8; ++h) { size_t kr = (size_t)(b * 8 + h) * NKEY + key; Kb[kr * 96 + 64 + jj] = f2bf(o1); Kb[kr * 96 + 80 + jj] = f2bf(o2); }
    }
    bf16_t* U = (bf16_t*)(P.ws + WS_U);
    GSTRIDE(idx, (long)(MT / 32) * 96) {
        const int cq = (int)(idx % 96), rb = (int)(idx / 96), row0 = rb * 32; int b, t0; bool isctx; row_info(row0, b, t0, isctx); const int n = isctx ? CTXL : SEQ;
        const bf16_t* p = PR + (size_t)row0 * PN + C_XBC + cq * 8; bf16_t* uo = U + (size_t)row0 * 768 + cq * 8;
        float w0[8], w1[8], w2[8], bs[8];
#pragma unroll
        for (int i = 0; i < 8; ++i) { w0[i] = P.conv_w[cq * 8 + i]; w1[i] = P.conv_w[768 + cq * 8 + i]; w2[i] = P.conv_w[1536 + cq * 8 + i]; bs[i] = P.conv_b[cq * 8 + i]; }
        typedef unsigned v4u_ __attribute__((ext_vector_type(4)));
        v4u_ rows[34];
#pragma unroll
        for (int r = 0; r < 34; ++r) { const int t = t0 - 1 + r; rows[r] = (t >= 0 && t < n) ? *(const v4u_*)(p + (long)(r - 1) * PN) : (v4u_){0u, 0u, 0u, 0u}; }
#pragma unroll
        for (int r = 0; r < 32; ++r) { v4u_ o;
#pragma unroll
            for (int i = 0; i < 4; ++i) {
                const float a0 = __uint_as_float(rows[r][i] << 16), a1 = __uint_as_float(rows[r][i] & 0xffff0000u);
                const float c0 = __uint_as_float(rows[r + 1][i] << 16), c1 = __uint_as_float(rows[r + 1][i] & 0xffff0000u);
                const float n0 = __uint_as_float(rows[r + 2][i] << 16), n1 = __uint_as_float(rows[r + 2][i] & 0xffff0000u);
                const float v0 = bs[2 * i] + w0[2 * i] * a0 + w1[2 * i] * c0 + w2[2 * i] * n0, v1 = bs[2 * i + 1] + w0[2 * i + 1] * a1 + w1[2 * i + 1] * c1 + w2[2 * i + 1] * n1;
                o[i] = pk2(siluf(v0), siluf(v1)); }
            *(v4u_*)(uo + (size_t)r * 768) = o; }
    }
    const float* DT = (const float*)(P.ws + WS_DT); float* DTS = (float*)(P.ws + WS_DTS);
    GSTRIDE(idx, MT * 16) DTS[idx] = softplusf(DT[idx] + P.dt_bias[idx % 16]);
}
__device__ __forceinline__ void ph_ssd_states(const Ptrs& P, unsigned char* lds) {
    const bf16_t* U = (const bf16_t*)(P.ws + WS_U); const float* DTS = (const float*)(P.ws + WS_DTS);
    for (int it = blockIdx.x; it < NB * ssd::NCH * 2; it += gridDim.x) { const int b = it / (ssd::NCH * 2), rem = it % (ssd::NCH * 2);
        ssd::states_item(U, DTS, P.a_log, (bf16_t*)(P.ws + WS_SST), (float*)(P.ws + WS_CD), b, rem >> 1, rem & 1, (char*)lds); }
}
__device__ __forceinline__ void ph_ssd_chunkscan(const Ptrs& P) {
    bf16_t* SST = (bf16_t*)(P.ws + WS_SST); const float* CD = (const float*)(P.ws + WS_CD);
    GSTRIDE(idx, NB * 2 * 8 * 2048) {
        const int e2 = (int)(idx & 2047); const int bdh = __builtin_amdgcn_readfirstlane((int)(idx >> 11));
        const int h = bdh & 7, d = (bdh >> 3) & 1, b = bdh >> 4;
        unsigned Sv[ssd::NCH];
#pragma unroll
        for (int k = 0; k < ssd::NCH; ++k) { const int c = d == 0 ? k : (k < 2 ? 1 - k : 67 - k); const size_t ci = (((size_t)b * ssd::NCH + c) * 2 + d) * 8 + h; Sv[k] = *(const unsigned*)(SST + ci * 4096 + 2 * e2); }
        float h0 = 0.f, h1 = 0.f;
#pragma unroll
        for (int k = 0; k < ssd::NCH; ++k) { const int c = d == 0 ? k : (k < 2 ? 1 - k : 67 - k); const size_t ci = (((size_t)b * ssd::NCH + c) * 2 + d) * 8 + h;
            if (k >= 2) *(unsigned*)(SST + ci * 4096 + 2 * e2) = pk2f(h0, h1);
            const float dec = CD[ci];
            h0 = h0 * dec + __uint_as_float(Sv[k] << 16); h1 = h1 * dec + __uint_as_float(Sv[k] & 0xffff0000u); }
    }
}
__device__ __forceinline__ void ph_ssd_out(const Ptrs& P, unsigned char* lds);
template <int VAR> __device__ __forceinline__ void ph_attn_mfma(const Ptrs& P, unsigned char* lds) {
    const bf16_t* Q = (const bf16_t*)(P.ws + WS_Q); const bf16_t* Kb = (const bf16_t*)(P.ws + WS_K); const bf16_t* Vb = (const bf16_t*)(P.ws + WS_V);
    const bf16_t* PR = (const bf16_t*)(P.ws + WS_PROJ); bf16_t* CAT = (bf16_t*)P.out;
    const int G = gridDim.x, c = blockIdx.x; const int vcu = (G % 8 == 0) ? (c % 8) * (G / 8) + c / 8 : c;
    for (int unit = vcu; unit < NB * 8 * 32; unit += G) {
        const int bh = unit >> 5, qb = unit & 31; const int b = bh >> 3, h = bh & 7; const int row0 = b * SEQ + qb * 256;
        attn::attn_unit_st<VAR>(Q + ((size_t)bh * SEQ + qb * 256) * 96, Kb + (size_t)bh * NKEY * 96, Vb + (size_t)bh * NKEY * 64, NKEY,
                        CAT + (size_t)row0 * DM + h * 64, DM, PR + (size_t)row0 * PN + C_GA + h * 64, PN, (char*)lds, (LAS unsigned char*)lds);
    }
}

__device__ __forceinline__ void merge_rows(const Ptrs& P, int row_begin, int row_end, int gw, int NGW) {
    const bf16_t* Y = (const bf16_t*)(P.ws + WS_H); const bf16_t* U = (const bf16_t*)(P.ws + WS_U); const bf16_t* PR = (const bf16_t*)(P.ws + WS_PROJ); bf16_t* CAT = (bf16_t*)P.out;
    int lane = lane_id_(); asm volatile("" : "+v"(lane));
    typedef unsigned v4u_ __attribute__((ext_vector_type(4)));
    const int h = lane >> 3; const float sk = P.d_skip[h] + P.d_skip[8 + h];
    for (int row = row_begin + 4 * gw; row < row_end; row += 4 * NGW) {
        v4u_ yv[4], xv[4], zv[4];
#pragma unroll
        for (int q = 0; q < 4; ++q) { const size_t r = (size_t)(row + q);
            yv[q] = *(const v4u_*)(Y + r * 512 + 8 * lane); xv[q] = *(const v4u_*)(U + r * 768 + 8 * lane); zv[q] = *(const v4u_*)(PR + r * PN + C_Z + 8 * lane); }
#pragma unroll
        for (int q = 0; q < 4; ++q) { float v[8]; float ss = 0.f;
#pragma unroll
            for (int i = 0; i < 4; ++i) {
                const float y0 = __uint_as_float(yv[q][i] << 16), y1 = __uint_as_float(yv[q][i] & 0xffff0000u), x0 = __uint_as_float(xv[q][i] << 16), x1 = __uint_as_float(xv[q][i] & 0xffff0000u);
                const float z0 = __uint_as_float(zv[q][i] << 16), z1 = __uint_as_float(zv[q][i] & 0xffff0000u);
                v[2 * i] = (y0 + sk * x0) * siluf(z0); v[2 * i + 1] = (y1 + sk * x1) * siluf(z1); ss += v[2 * i] * v[2 * i] + v[2 * i + 1] * v[2 * i + 1]; }
            ss = wave_sum(ss);
            const float rstd = rsqrtf(ss * (1.f / 512.f) + RMS_EPS);
            v4u_ o;
#pragma unroll
            for (int i = 0; i < 4; ++i) o[i] = pk2f(v[2 * i] * rstd, v[2 * i + 1] * rstd);
            *(v4u_*)(CAT + (size_t)(row + q) * DM + 512 + 8 * lane) = o; }
    }
}
__device__ __forceinline__ void ph_merge(const Ptrs& P) { const int tid = TIDX; merge_rows(P, 0, ML, blockIdx.x * (NT / 64) + (tid >> 6), gridDim.x * (NT / 64)); }

__device__ __forceinline__ void ph_ssd_out(const Ptrs& P, unsigned char* lds) {
    const bf16_t* U = (const bf16_t*)(P.ws + WS_U); const float* DTS = (const float*)(P.ws + WS_DTS);
    for (int it = blockIdx.x; it < NB * 64; it += gridDim.x) { const int b = it >> 6, j = it & 63;
#pragma unroll 1
        for (int g = 0; g < 2; ++g) ssd::out_item(U, DTS, P.a_log, (const bf16_t*)(P.ws + WS_SST), (bf16_t*)(P.ws + WS_H), b, j, g, (char*)lds);
        asm volatile("s_waitcnt vmcnt(0)" ::: "memory"); __syncthreads();
        const int row0 = b * SEQ + j * ssd::LC; merge_rows(P, row0, row0 + ssd::LC, TIDX >> 6, NT / 64); }
}

template <int W, int R> __device__ __forceinline__ void pool_item(const bf16_t* __restrict__ UG, bf16_t* __restrict__ MP, int row0, int t0, int ch) {
    typedef unsigned v4u_ __attribute__((ext_vector_type(4)));
    constexpr int NR = R + W - 1, LO = W / 2;
    v4u_ v[NR];
#pragma unroll
    for (int r = 0; r < NR; ++r) { const int t = t0 - LO + r; v[r] = (t >= 0 && t < SEQ) ? *(const v4u_*)(UG + (size_t)(row0 - LO + r) * 2048 + ch) : (v4u_){0u, 0u, 0u, 0u}; }
    float S[8];
#pragma unroll
    for (int i = 0; i < 8; ++i) S[i] = 0.f;
#pragma unroll
    for (int r = 0; r < W; ++r)
#pragma unroll
        for (int i = 0; i < 4; ++i) { S[2 * i] += __uint_as_float(v[r][i] << 16); S[2 * i + 1] += __uint_as_float(v[r][i] & 0xffff0000u); }
#pragma unroll
    for (int r = 0; r < R; ++r) { const int t = t0 + r; int lo = t - LO; if (lo < 0) lo = 0; int hi = t + (W - LO - 1); if (hi > SEQ - 1) hi = SEQ - 1;
        const float inv = 1.f / (float)(hi - lo + 1); v4u_ o;
#pragma unroll
        for (int i = 0; i < 4; ++i) { const float u0 = __uint_as_float(v[r + LO][i] << 16), u1 = __uint_as_float(v[r + LO][i] & 0xffff0000u);
            o[i] = pk2(S[2 * i] * inv - u0, S[2 * i + 1] * inv - u1); }
        *(v4u_*)(MP + (size_t)(row0 + r) * 1024 + ch) = o;
        if (r < R - 1) {
#pragma unroll
            for (int i = 0; i < 4; ++i) { S[2 * i] += __uint_as_float(v[r + W][i] << 16) - __uint_as_float(v[r][i] << 16); S[2 * i + 1] += __uint_as_float(v[r + W][i] & 0xffff0000u) - __uint_as_float(v[r][i] & 0xffff0000u); } } }
}
__device__ __forceinline__ void ph_pool(const Ptrs& P) {
    const bf16_t* UG = (const bf16_t*)(P.ws + WS_Q); bf16_t* MP = (bf16_t*)(P.ws + WS_H);
    GSTRIDE(idx, (long)(ML / 32) * 4 * 64) {
        const int cg = (int)(idx & 31), rsub = (int)((idx >> 5) & 1), g = (int)((idx >> 6) & 3), rp = (int)(idx >> 8);
        const int row0 = rp * 32 + rsub * 16, t0 = row0 & (SEQ - 1), ch = g * 256 + cg * 8;
        if (g == 0) pool_item<2, 16>(UG, MP, row0, t0, ch); else if (g == 1) pool_item<4, 16>(UG, MP, row0, t0, ch); else if (g == 2) pool_item<8, 16>(UG, MP, row0, t0, ch);
        else { pool_item<16, 8>(UG, MP, row0, t0, ch); asm volatile("" ::: "memory"); pool_item<16, 8>(UG, MP, row0 + 8, t0 + 8, ch); }
    }
}
__device__ __forceinline__ void ph_final(const Ptrs& P) {
    const int lane = TIDX & 63, gw = blockIdx.x * (NT / 64) + (TIDX >> 6), NGW = gridDim.x * (NT / 64);
    f32x4 nx[4]; f32x4 fw[4];
#pragma unroll
    for (int j = 0; j < 4; ++j) fw[j] = *(const f32x4*)(P.final_norm + 4 * lane + 256 * j);
    if (gw < ML) {
#pragma unroll
        for (int j = 0; j < 4; ++j) nx[j] = *(const f32x4*)(P.out + (size_t)gw * DM + 4 * lane + 256 * j); }
    for (int row = gw; row < ML; row += NGW) {
        float* xr = P.out + (size_t)row * DM; f32x4 xv[4]; float ss = 0.f;
#pragma unroll
        for (int j = 0; j < 4; ++j) xv[j] = nx[j];
        if (row + NGW < ML) {
#pragma unroll
            for (int j = 0; j < 4; ++j) nx[j] = *(const f32x4*)(xr + (size_t)NGW * DM + 4 * lane + 256 * j); }
#pragma unroll
        for (int j = 0; j < 4; ++j) ss += (xv[j].x * xv[j].x + xv[j].y * xv[j].y) + (xv[j].z * xv[j].z + xv[j].w * xv[j].w);
        ss = wave_sum(ss);
        const float rstd = rsqrtf(ss * (1.f / DM) + RMS_EPS);
#pragma unroll
        for (int j = 0; j < 4; ++j) { const int k = 4 * lane + 256 * j; *(f32x4*)(xr + k) = xv[j] * rstd * fw[j]; }
    }
}


template <int W, int R> __device__ __forceinline__ void pool_to_lds(const bf16_t* __restrict__ UG, int grow0, int t0, int ch, LAS unsigned char* dst, int r0, int cc) {
    typedef unsigned v4u_ __attribute__((ext_vector_type(4)));
    constexpr int NR = R + W - 1, LO = W / 2;
    v4u_ v[NR];
#pragma unroll
    for (int r = 0; r < NR; ++r) { const int t = t0 - LO + r; v[r] = (t >= 0 && t < SEQ) ? *(const v4u_*)(UG + (size_t)(grow0 - LO + r) * 2048 + ch) : (v4u_){0u, 0u, 0u, 0u}; }
    float S[8];
#pragma unroll
    for (int i = 0; i < 8; ++i) S[i] = 0.f;
#pragma unroll
    for (int r = 0; r < W; ++r)
#pragma unroll
        for (int i = 0; i < 4; ++i) { S[2 * i] += __uint_as_float(v[r][i] << 16); S[2 * i + 1] += __uint_as_float(v[r][i] & 0xffff0000u); }
#pragma unroll
    for (int r = 0; r < R; ++r) { const int t = t0 + r; int lo = t - LO; if (lo < 0) lo = 0; int hi = t + (W - LO - 1); if (hi > SEQ - 1) hi = SEQ - 1;
        const float inv = 1.f / (float)(hi - lo + 1); v4u_ o;
#pragma unroll
        for (int i = 0; i < 4; ++i) { const float u0 = __uint_as_float(v[r + LO][i] << 16), u1 = __uint_as_float(v[r + LO][i] & 0xffff0000u);
            o[i] = pk2f(S[2 * i] * inv - u0, S[2 * i + 1] * inv - u1); }
        *(LAS v4u_*)(dst + pg8::lds_byte(r0 + r, cc)) = o;
        if (r < R - 1) {
#pragma unroll
            for (int i = 0; i < 4; ++i) { S[2 * i] += __uint_as_float(v[r + W][i] << 16) - __uint_as_float(v[r][i] << 16); S[2 * i + 1] += __uint_as_float(v[r + W][i] & 0xffff0000u) - __uint_as_float(v[r][i] & 0xffff0000u); } } }
}
__device__ __forceinline__ void ph_pool_lin_fused(const Ptrs& P, LAS unsigned char* L) {
    using pg8::f32x4; using pg8::bf16x8;
    const bf16_t* UG = (const bf16_t*)(P.ws + WS_Q); const bf16_t* Wtl = (const bf16_t*)(P.ws + WS_WTL); bf16_t* T = (bf16_t*)(P.ws + WS_U);
    pg8::StaticOrder S; S.init(ML, 1024, (int)gridDim.x, (int)blockIdx.x);
    const pg8::EpiPL E{T, UG};
    pg8::Unit u;
    for (int ui = 0; S.next(ui, u); ++ui) {
        int tid_ = TIDX; asm volatile("" : "+v"(tid_));
        const int tid = tid_, wid = __builtin_amdgcn_readfirstlane(tid >> 6), lane = tid & 63, wr = wid >> 2, wc = wid & 3, fr = lane & 15, fq = lane >> 4;
        const int g = u.pn;
        { const int chunk = tid & 31, run = tid >> 5; const int kt = chunk >> 3, cc = (chunk & 7) * 8, ai = run >> 3, r0 = (run & 7) * 16;
          const int grow0 = u.pm * 256 + run * 16, t0 = grow0 & (SEQ - 1), ch = g * 256 + chunk * 8;
          LAS unsigned char* dst = L + (ai * 4 + kt) * 16384;
          if (g == 0) pool_to_lds<2, 16>(UG, grow0, t0, ch, dst, r0, cc); else if (g == 1) pool_to_lds<4, 16>(UG, grow0, t0, ch, dst, r0, cc); else if (g == 2) pool_to_lds<8, 16>(UG, grow0, t0, ch, dst, r0, cc);
          else { pool_to_lds<16, 8>(UG, grow0, t0, ch, dst, r0, cc); asm volatile("" ::: "memory"); pool_to_lds<16, 8>(UG, grow0 + 8, t0 + 8, ch, dst, r0 + 8, cc); } }
        __syncthreads();
        f32x4 acc[2][2][4][2];
#pragma unroll
        for (int a = 0; a < 2; ++a)
#pragma unroll
            for (int b = 0; b < 2; ++b)
#pragma unroll
                for (int m = 0; m < 4; ++m)
#pragma unroll
                    for (int n = 0; n < 2; ++n) acc[a][b][m][n] = (f32x4){0.f, 0.f, 0.f, 0.f};
        const int aoff = pg8::lds_byte(wr * 64 + fr, fq * 8);
        const bf16_t* Bg = Wtl + (size_t)(g * 256) * 256 + fq * 8;
        const int brow = 32 * wc + 8 * (fr >> 2) + (fr & 3);
#pragma unroll 1
        for (int kt = 0; kt < 4; ++kt) {
            bf16x8 Bf[2][2][2];
#pragma unroll
            for (int bj = 0; bj < 2; ++bj)
#pragma unroll
                for (int n = 0; n < 2; ++n)
#pragma unroll
                    for (int k = 0; k < 2; ++k) Bf[bj][n][k] = *(const bf16x8*)(Bg + (size_t)(128 * bj + brow + 4 * n) * 256 + kt * 64 + k * 32);
#pragma unroll
            for (int ai = 0; ai < 2; ++ai) { bf16x8 At[4][2];
#pragma unroll
                for (int m = 0; m < 4; ++m)
#pragma unroll
                    for (int k = 0; k < 2; ++k) At[m][k] = *(const LAS bf16x8*)(L + (ai * 4 + kt) * 16384 + aoff + m * 2048 + k * 1024);
#pragma unroll
                for (int bj = 0; bj < 2; ++bj)
#pragma unroll
                    for (int m = 0; m < 4; ++m)
#pragma unroll
                        for (int n = 0; n < 2; ++n)
#pragma unroll
                            for (int k = 0; k < 2; ++k) acc[ai][bj][m][n] = __builtin_amdgcn_mfma_f32_16x16x32_bf16(Bf[bj][n][k], At[m][k], acc[ai][bj][m][n], 0, 0, 0); }
        }
        E(acc, u, wr, wc, fr, fq);
        __syncthreads();
    }
}

#ifndef ATTN_PROBE
#define ATTN_PROBE 0
#endif
struct Args { const float* in[24]; float* out; char* ws; int ph_lo, ph_hi; };
constexpr int N_PHASES = 15;
__global__ void __launch_bounds__(NT, 2) mk_fwd(Args a) {
    unsigned char* lds = g_lds;
    LAS unsigned char* L = (LAS unsigned char*)lds;
    for (int u = threadIdx.x; u < (LDS_BYTES - LDSCTL_OFF) / 4; u += NT) ((LAS unsigned*)(L + LDSCTL_OFF))[u] = 0u;
    __syncthreads();
    if ((threadIdx.x & 63) == 0) ((LAS int*)(L + WIDTAB_OFF))[hw_slot_()] = (int)(threadIdx.x >> 6);
    __syncthreads();
    Ptrs P;
    P.x = a.in[0]; P.c = a.in[1]; P.ctx = a.in[2]; P.c_ctx = a.in[3]; P.mod_w = a.in[4]; P.mod_b = a.in[5]; P.norm_w = a.in[6]; P.w_in_mix = a.in[7];
    P.q_norm = a.in[8]; P.w_uq = a.in[9]; P.kv_norm = a.in[10]; P.w_ukv = a.in[11]; P.conv_w = a.in[12]; P.conv_b = a.in[13]; P.a_log = a.in[14];
    P.dt_bias = a.in[15]; P.d_skip = a.in[16]; P.ssd_norm = a.in[17]; P.w_out_mix = a.in[18]; P.w_in_pool = a.in[19]; P.pool_lin = a.in[20];
    P.pool_scale = a.in[21]; P.w_out_pool = a.in[22]; P.final_norm = a.in[23]; P.out = a.out; P.ws = a.ws;
    unsigned* ctl = (unsigned*)(a.ws + WS_CTL);
    const bool one_launch = (a.ph_hi - a.ph_lo) > 1;
    XcdBarrier bar; bar.bar = ctl + CW_BAR; bar.x = 0; bar.st = nullptr;
    if (one_launch) bar = xcd_barrier_post(ctl + CW_BAR, (volatile LAS unsigned*)(L + MISC_OFF) + 8);
    const int lo = a.ph_lo, hi = a.ph_hi;
#define IN(k) (lo <= (k) && (k) < hi)
#define SEAM(k) do { if (IN(k) && IN((k) + 1)) xcd_barrier(bar); } while (0)
    float* MODV = (float*)(a.ws + WS_MODV);
    bf16_t* H = (bf16_t*)(a.ws + WS_H); bf16_t* PROJ = (bf16_t*)(a.ws + WS_PROJ); float* X1 = (float*)(a.ws + WS_PROJ);
    bf16_t* UG = (bf16_t*)(a.ws + WS_Q); bf16_t* T = (bf16_t*)(a.ws + WS_U); bf16_t* CAT = (bf16_t*)a.out;
    if (IN(0)) { ph_modvec(P, L); } SEAM(0);
    if (IN(1)) { ph_weights(P, L); ph_norm_mod<true>(P.x, P.ctx, MT, P.norm_w, MODV, H); } SEAM(1);
    if (IN(2)) { pg8::Gemm g{H, (const bf16_t*)(a.ws + WS_WT1), MT, 2560, 1024, 1024, 0}; pg8::StaticOrder S; S.init(MT, 2560, (int)gridDim.x, (int)blockIdx.x);
        pg8::EpiProjM E{PROJ, (float*)(a.ws + WS_SS), (float*)(a.ws + WS_DT)};
        pg8::gemm_phase<pg8::EpiProjM, pg8::StaticOrder, true, true>(L, g, S, E); } SEAM(2);
    if (IN(3)) {
        { pg8::Gemm g{PROJ + C_QA, (const bf16_t*)(a.ws + WS_WTQ), ML, 768, 384, PN, 0}; pg8::StaticOrder S; S.init(ML, 768, (int)gridDim.x, (int)blockIdx.x);
          pg8::EpiQ E{(bf16_t*)(a.ws + WS_Q), (const float*)(a.ws + WS_SS), (const float*)(a.ws + WS_COS), (const float*)(a.ws + WS_SIN)};
          pg8::gemm_phase<pg8::EpiQ, pg8::StaticOrder, true, true>(L, g, S, E); }
        { pg8::Gemm g{PROJ + C_KVA, (const bf16_t*)(a.ws + WS_WTKV), MT, 1024, 256, PN, 0}; pg8::StaticOrder S; S.init(MT, 1024, (int)gridDim.x, (int)((blockIdx.x + gridDim.x / 2) % gridDim.x));
          pg8::EpiKV E{(bf16_t*)(a.ws + WS_K), (bf16_t*)(a.ws + WS_V), (const float*)(a.ws + WS_SS)};
          pg8::gemm_phase<pg8::EpiKV, pg8::StaticOrder, true, true>(L, g, S, E); }
        ph_upproj(P); } SEAM(3);
    if (IN(4)) { ph_ssd_states(P, lds); } SEAM(4);
    if (IN(5)) { ph_ssd_chunkscan(P); ph_attn_mfma<ATTN_PROBE>(P, lds); if (ATTN_PROBE != 0) ph_attn_mfma<0>(P, lds); } SEAM(5);
    if (IN(6)) { ph_ssd_out(P, lds); } SEAM(6);
    const bool fusedn = gridDim.x == 256 && one_launch;
    if (IN(8)) {
        if (fusedn) {
#pragma unroll 1
            for (int half = 0; half < 2; ++half) { pg8::Gemm g{CAT + (size_t)half * 16384 * 1024, (const bf16_t*)(a.ws + WS_WTO), 16384, 1024, 1024, 1024, 0}; pg8::StaticOrder S; S.init(16384, 1024, (int)gridDim.x, (int)blockIdx.x);
                pg8::PanelRms st{(unsigned*)(a.ws + WS_XB), ctl + CW_PANEL, half * 64, RMS_EPS};
                pg8::EpiResNorm E{P.x, MODV, (_Float16*)X1, H, P.norm_w + DM, MODV + 5 * 3072, st, SEQ, 0};
                pg8::gemm_phase<pg8::EpiResNorm, pg8::StaticOrder, false, true>(L, g, S, E); __syncthreads(); }
        } else {
            pg8::Gemm g{CAT, (const bf16_t*)(a.ws + WS_WTO), ML, 1024, 1024, 1024, 0}; pg8::StaticOrder S; S.init(ML, 1024, (int)gridDim.x, (int)blockIdx.x);
            pg8::EpiResM E{P.x, MODV, X1, SEQ, 0};
            pg8::gemm_phase<pg8::EpiResM, pg8::StaticOrder, true, true>(L, g, S, E); } } SEAM(8);
    if (IN(9) && !fusedn) { ph_norm_mod<false>(X1, nullptr, ML, P.norm_w + DM, MODV + 5 * 3072, H); } if (!fusedn) SEAM(9);
    if (IN(10)) { pg8::Gemm g{H, (const bf16_t*)(a.ws + WS_WTP), ML, 2048, 1024, 1024, 0}; pg8::StaticOrder S; S.init(ML, 2048, (int)gridDim.x, (int)blockIdx.x);
        pg8::EpiBf16<0> E{UG, 2048, nullptr, 0, 0, 1.f};
        pg8::gemm_phase<pg8::EpiBf16<0>, pg8::StaticOrder, true, true>(L, g, S, E); } SEAM(10);
    if (IN(11)) { ph_pool_lin_fused(P, L); } SEAM(11);
    if (IN(13)) {
        if (fusedn) {
#pragma unroll 1
            for (int half = 0; half < 2; ++half) { pg8::Gemm g{T + (size_t)half * 16384 * 1024, (const bf16_t*)(a.ws + WS_WTOP), 16384, 1024, 1024, 1024, 0}; pg8::StaticOrder S; S.init(16384, 1024, (int)gridDim.x, (int)blockIdx.x);
                pg8::PanelRms st{(unsigned*)(a.ws + WS_XB) + 32768 * 4, ctl + CW_PANEL + 8192, half * 64, RMS_EPS};
                pg8::EpiResFinal E{(const _Float16*)X1, MODV + 5 * 3072, P.out, P.final_norm, st, SEQ, 0};
                pg8::gemm_phase<pg8::EpiResFinal, pg8::StaticOrder, false, true>(L, g, S, E); __syncthreads(); }
        } else {
            pg8::Gemm g{T, (const bf16_t*)(a.ws + WS_WTOP), ML, 1024, 1024, 1024, 0}; pg8::StaticOrder S; S.init(ML, 1024, (int)gridDim.x, (int)blockIdx.x);
            pg8::EpiResM E{X1, MODV + 5 * 3072, P.out, SEQ, 0};
            pg8::gemm_phase<pg8::EpiResM, pg8::StaticOrder, true, true>(L, g, S, E); } } if (!fusedn) SEAM(13);
    if (IN(14) && !fusedn) { ph_final(P); }
#undef IN
#undef SEAM
}

#ifndef MK_PER_PHASE
#define MK_PER_PHASE 0
#endif
extern "C" void kernel_launch(void* const* d_in, const int* in_sizes, int n_in, void* d_out, int out_size, void* d_ws, size_t ws_size, hipStream_t stream) {
    static int grid = 0;
    if (grid == 0) {
        if (n_in != 24 || out_size != ML * DM || ws_size < WS_END) { fprintf(stderr, "kernel_launch: unexpected shapes n_in %d out %d ws %zu\n", n_in, out_size, ws_size); grid = -1; return; }
        int dev = 0, cus = 0;
        if (hipGetDevice(&dev) != hipSuccess || hipDeviceGetAttribute(&cus, hipDeviceAttributeMultiprocessorCount, dev) != hipSuccess) { grid = -1; return; }
        if (hipFuncSetAttribute((const void*)mk_fwd, hipFuncAttributeMaxDynamicSharedMemorySize, LDS_BYTES) != hipSuccess) { fprintf(stderr, "kernel_launch: hipFuncSetAttribute failed\n"); grid = -1; return; }
        grid = cus;
    }
    if (grid < 0) return;
    (void)hipMemsetAsync((char*)d_ws + WS_CTL, 0, CTL_ZERO_BYTES, stream);
    Args a{};
    for (int i = 0; i < 24; ++i) a.in[i] = (const float*)d_in[i];
    a.out = (float*)d_out; a.ws = (char*)d_ws;
#if MK_PER_PHASE
    for (int p = 0; p < N_PHASES; ++p) { a.ph_lo = p; a.ph_hi = p + 1; hipLaunchKernelGGL(mk_fwd, dim3(grid), dim3(NT), LDS_BYTES, stream, a); }
#else
    a.ph_lo = 0; a.ph_hi = N_PHASES;
    hipLaunchKernelGGL(mk_fwd, dim3(grid), dim3(NT), LDS_BYTES, stream, a);
#endif
}
```

```cpp
#include <hip/hip_runtime.h>
#include <cstdint>
#include <cstdio>

typedef unsigned short bf16_t;
#define LAS __attribute__((address_space(3)))
__device__ __forceinline__ float bf2f(bf16_t v) { return __uint_as_float(((unsigned)v) << 16); }
typedef float f32x2_c __attribute__((ext_vector_type(2))); typedef __bf16 bf16x2_c __attribute__((ext_vector_type(2)));
__device__ __forceinline__ unsigned pk2f(float lo, float hi) { f32x2_c v = {lo, hi}; return __builtin_bit_cast(unsigned, __builtin_convertvector(v, bf16x2_c)); }
__device__ __forceinline__ bf16_t f2bf(float f) { return (bf16_t)(pk2f(f, 0.f) & 0xffffu); }
__device__ __forceinline__ float siluf(float x) { return x * __builtin_amdgcn_rcpf(1.f + __expf(-x)); }
__device__ __forceinline__ float softplusf(float x) { return fmaxf(x, 0.f) + log1pf(__expf(-fabsf(x))); }

constexpr int NB = 4, SEQ = 8192, DM = 1024, CTXL = 256, NKEY = SEQ + CTXL;
constexpr int ML = NB * SEQ, MC = NB * CTXL, MT = ML + MC;
constexpr int PN = 2560;
constexpr int C_QA = 0, C_KVA = 384, C_KPE = 640, C_GA = 672, C_Z = 1184, C_XBC = 1696, C_DT = 2464;
constexpr float RMS_EPS = 1e-6f;
constexpr float QSCALE = 0.10206207261596575f * 1.4426950408889634f;
constexpr int NT = 512;

constexpr size_t MiB = 1u << 20;
constexpr size_t WS_CTL = 0, CTL_ZERO_BYTES = 128 * 1024;
constexpr size_t WS_MODV = 1 * MiB;
constexpr size_t WS_COS = 3 * MiB, WS_SIN = 3 * MiB + 512 * 1024;
constexpr size_t WS_WT1 = 4 * MiB;
constexpr size_t WS_WTQ = 9 * MiB;
constexpr size_t WS_WTKV = 10 * MiB;
constexpr size_t WS_WTO = 11 * MiB;
constexpr size_t WS_WTP = 13 * MiB;
constexpr size_t WS_WTL = 17 * MiB;
constexpr size_t WS_WTOP = 18 * MiB;
constexpr size_t WS_H = 20 * MiB;
constexpr size_t WS_PROJ = 86 * MiB;
constexpr size_t WS_SS = 251 * MiB;
constexpr size_t WS_DT = 254 * MiB;
constexpr size_t WS_Q = 257 * MiB;
constexpr size_t WS_K = 305 * MiB;
constexpr size_t WS_V = 355 * MiB;
constexpr size_t WS_U = 388 * MiB;
constexpr size_t WS_DTS = 438 * MiB;
constexpr size_t WS_SST = 441 * MiB;
constexpr size_t WS_CD = 1 * MiB + 512 * 1024;
constexpr size_t WS_END = 507 * MiB;
constexpr int CW_PANEL = 16384;
constexpr size_t WS_XB = 2 * MiB;
constexpr int CW_BAR = 4096;

constexpr int RING_BYTES = 131072, LDSCTL_OFF = RING_BYTES, MISC_OFF = LDSCTL_OFF + 320, LDS_BYTES = 147456;


extern __shared__ __attribute__((aligned(16))) unsigned char g_lds[];
constexpr int WIDTAB_OFF = LDSCTL_OFF + 64;
__device__ __forceinline__ int lane_id_() { return (int)__builtin_amdgcn_mbcnt_hi(~0u, __builtin_amdgcn_mbcnt_lo(~0u, 0u)); }
__device__ __forceinline__ int hw_slot_() { return (int)(__builtin_amdgcn_s_getreg((5 << 11) | 4) & 0x3Fu); }
__device__ __forceinline__ int wave_id_() { return __builtin_amdgcn_readfirstlane(((volatile LAS int*)((LAS unsigned char*)g_lds + WIDTAB_OFF))[hw_slot_()]); }
#define TIDX (wave_id_() * 64 + lane_id_())

#define XB_TMO      128
#define XB_XCNT(j)  (256  + 64 * (j))
#define XB_XSUB(j)  (1280 + 64 * (j))
#define XB_XGEN(j)  (2304 + 64 * (j))
#define XB_TOP      3328
#define XB_TOPGEN   3392
#define XCD_BAR_WORDS 3456
#define XB_SPIN_CAP (1u << 18)
__device__ __forceinline__ unsigned xb_ld(unsigned* p)              { return __hip_atomic_load(p, __ATOMIC_RELAXED, __HIP_MEMORY_SCOPE_AGENT); }
__device__ __forceinline__ unsigned xb_add(unsigned* p, unsigned v) { return __hip_atomic_fetch_add(p, v, __ATOMIC_RELAXED, __HIP_MEMORY_SCOPE_AGENT); }
__device__ __forceinline__ unsigned xb_xcc_id() { return (unsigned)__builtin_amdgcn_s_getreg((3 << 11) | 20) & 0xFu; }
#define XB_SPIN(cond, bar) do { unsigned _sp = 0; while (cond) { __builtin_amdgcn_s_sleep(1); \
    if ((++_sp & 255u) == 0u) { if (xb_ld(&(bar)[XB_TMO])) break; if (_sp > XB_SPIN_CAP) { atomicAdd(&(bar)[XB_TMO], 1u); break; } } } } while (0)
struct XcdBarrier { unsigned* bar; unsigned x; volatile LAS unsigned* st; };
__device__ __forceinline__ XcdBarrier xcd_barrier_post(unsigned* bar, volatile LAS unsigned* st) {
    XcdBarrier b; b.bar = bar; b.x = xb_xcc_id(); b.st = st;
    if (TIDX == 0) (void)xb_add(&bar[XB_XCNT(b.x)], 1u);
    return b;
}
__device__ __forceinline__ void xcd_barrier_complete(unsigned* bar, unsigned x, unsigned& nloc, unsigned& nx) {
    const unsigned G = gridDim.x * gridDim.y * gridDim.z;
    unsigned sum, cnt, mine, sp = 0u;
    for (;;) {
        sum = 0u; cnt = 0u; mine = 0u;
#pragma unroll
        for (unsigned j = 0; j < 16; ++j) { const unsigned c = xb_ld(&bar[XB_XCNT(j)]); sum += c; cnt += (c > 0u) ? 1u : 0u; mine = (j == x) ? c : mine; }
        if (sum == G) break;
        __builtin_amdgcn_s_sleep(1);
        if ((++sp & 255u) == 0u) { if (xb_ld(&bar[XB_TMO])) break; if (sp > XB_SPIN_CAP) { atomicAdd(&bar[XB_TMO], 1u); break; } }
    }
    nloc = mine > 0u ? mine : 1u; nx = cnt > 0u ? cnt : 1u;
}
__device__ __forceinline__ void xcd_barrier(const XcdBarrier& b) {
    asm volatile("s_waitcnt vmcnt(0)" ::: "memory");
    __syncthreads();
    if (TIDX == 0) {
        unsigned* bar = b.bar;
        __builtin_amdgcn_s_waitcnt(0);
        unsigned nloc = b.st[0], nx = b.st[1];
        if (nloc == 0u) { xcd_barrier_complete(bar, b.x, nloc, nx); b.st[0] = nloc; b.st[1] = nx; }
        const unsigned old = xb_add(&bar[XB_XSUB(b.x)], 1u);
        const unsigned gen = old / nloc;
        if (old + 1u == (gen + 1u) * nloc) {
            __builtin_amdgcn_fence(__ATOMIC_RELEASE, "agent");
            asm volatile("s_waitcnt vmcnt(0)" ::: "memory");
            const unsigned og = xb_add(&bar[XB_TOP], 1u);
            const unsigned tg = og / nx;
            if (og + 1u == (tg + 1u) * nx) xb_add(&bar[XB_TOPGEN], 1u);
            else XB_SPIN(xb_ld(&bar[XB_TOPGEN]) == tg, bar);
            __builtin_amdgcn_fence(__ATOMIC_ACQUIRE, "agent");
            xb_add(&bar[XB_XGEN(b.x)], 1u);
            asm volatile("s_waitcnt vmcnt(0)" ::: "memory");
        } else {
            XB_SPIN(xb_ld(&bar[XB_XGEN(b.x)]) == gen, bar);
            __builtin_amdgcn_fence(__ATOMIC_ACQUIRE, "agent");
            asm volatile("s_waitcnt vmcnt(0)" ::: "memory");
        }
    }
    __syncthreads();
}

__device__ __forceinline__ void row_info(int row, int& b, int& t, bool& isctx) {
    if (row < ML) { b = row / SEQ; t = row % SEQ; isctx = false; } else { int rc = row - ML; b = rc / CTXL; t = rc % CTXL; isctx = true; }
}
__device__ __forceinline__ float wave_sum(float v) {
#define WS_SWZ(x, k) __int_as_float(__builtin_amdgcn_ds_swizzle(__float_as_int(x), 0x1F | ((k) << 10)))
    v += WS_SWZ(v, 1); v += WS_SWZ(v, 2); v += WS_SWZ(v, 4); v += WS_SWZ(v, 8); v += WS_SWZ(v, 16);
#undef WS_SWZ
    auto rr = __builtin_amdgcn_permlane32_swap(__float_as_uint(v), __float_as_uint(v), false, false);
    return __uint_as_float(rr[0]) + __uint_as_float(rr[1]);
}
typedef float f32x4 __attribute__((ext_vector_type(4)));
#define GSTRIDE(idx, n) for (long idx = (long)blockIdx.x * NT + TIDX; idx < (long)(n); idx += (long)gridDim.x * NT)

namespace pg8 {
#define PG8_LAS __attribute__((address_space(3)))
typedef unsigned short bf16_t;
typedef short bf16x8 __attribute__((ext_vector_type(8)));
typedef float f32x4 __attribute__((ext_vector_type(4)));
typedef unsigned u32x4 __attribute__((ext_vector_type(4)));
constexpr int BM = 256, BK = 64, HALF = 128, HTB = HALF * BK * 2  , STAGE_BYTES = 8 * HTB, NXCD = 8, WGM = 8;

__host__ __device__ __forceinline__ int lds_byte(int r, int c) { const int st = (r >> 4) * 2 + (c >> 5), rr = r & 15, cc = c & 31, ob = rr * 64 + cc * 2; return st * 1024 + (ob ^ (((ob >> 9) & 1) << 5)); }
__host__ __device__ __forceinline__ void stage_rc(int b, int& R, int& C) { const int st = b / 1024, sb = b % 1024, swz = sb ^ (((sb >> 9) & 1) << 5); R = (st >> 1) * 16 + swz / 64; C = (st & 1) * 32 + (swz % 64) / 2; }
__host__ __device__ __forceinline__ int perm32(int rho) { const int n = rho >> 4, i = rho & 15; return 8 * (i >> 2) + 4 * n + (i & 3); }

struct Unit { int pm, pn; };
struct Gemm { const bf16_t* A; const bf16_t* Bt; int M, N, K, lda, a_pn_off; };

struct StaticOrder {
    int nM, nN, nwg, G, c;
    __host__ __device__ void init(int M, int N, int G_, int c_) { nM = M / BM; nN = N / BM; nwg = nM * nN; G = G_; c = c_; }
    __host__ __device__ bool next(int i, Unit& u) const {
        const long L = (long)i * G + c; if (L >= nwg) return false;
        int wgid = (int)L; { const int q = nwg / NXCD, r = nwg % NXCD, xcd = wgid % NXCD, off = wgid / NXCD; wgid = (xcd < r ? xcd * (q + 1) : r * (q + 1) + (xcd - r) * q) + off; }
        const int nig = WGM * nN, gid = wgid / nig, fm = gid * WGM, gsz = (nM - fm) < WGM ? (nM - fm) : WGM;
        u.pm = fm + ((wgid % nig) % gsz); u.pn = (wgid % nig) / gsz; return true;
    }
    __device__ __forceinline__ void a_ready(const Unit&) const {}
    __device__ __forceinline__ void done(const Unit&) const {}
};

__device__ __forceinline__ unsigned cvt_pk_bf16(float lo, float hi) { unsigned r; asm volatile("v_cvt_pk_bf16_f32 %0, %1, %2" : "=v"(r) : "v"(lo), "v"(hi)); return r; }
typedef float f32x2 __attribute__((ext_vector_type(2)));
__device__ __forceinline__ f32x2 gelu_pk(f32x2 v) {
    const f32x2 av = __builtin_elementwise_abs(v), d = av * 0.2316418882f + 1.0f;
    f32x2 t; t.x = __builtin_amdgcn_rcpf(d.x); t.y = __builtin_amdgcn_rcpf(d.y);
    f32x2 q = t * 0.5307027145f + (-0.7265760135f); q = q * t + 0.7107068705f; q = q * t + (-0.142248368f); q = q * t + 0.127414796f; q = q * t;
    const f32x2 s = (v * v) * (-0.72134752044f);
    f32x2 e; e.x = __builtin_amdgcn_exp2f(s.x); e.y = __builtin_amdgcn_exp2f(s.y);
    const f32x2 m = v * (q * e), r = v - m;
    f32x2 o; o.x = v.x < 0.f ? m.x : r.x; o.y = v.y < 0.f ? m.y : r.y; return o;
}

template <int ACT  > struct EpiBf16 {
    static constexpr bool PERM = true, AFTER_DRAIN = false; static_assert(ACT == 0 || ACT == 1, "EpiBf16: ACT is 0 (none) or 1 (gelu_pk)");
    bf16_t* O; int ldc; const float* bias; int split_cols; size_t split_stride; float scale0;
    __device__ __forceinline__ void operator()(const f32x4 (&acc)[2][2][4][2], const Unit& u, int wr, int wc, int fr, int fq) const {
        const int row0 = u.pm * BM + wr * 64 + fr; int colt = u.pn * BM; bf16_t* base = O;
        float sc = 1.f; if (split_cols) { const int t = colt / split_cols; base += (size_t)t * split_stride; colt -= t * split_cols; if (t == 0) sc = scale0; }
        const int col0 = colt + wc * 32 + 8 * fq, bcol0 = u.pn * BM + wc * 32 + 8 * fq;
        f32x4 bv[2][2];
#pragma unroll
        for (int bj = 0; bj < 2; ++bj)
#pragma unroll
            for (int n = 0; n < 2; ++n) bv[bj][n] = bias ? *(const f32x4*)(bias + bcol0 + bj * HALF + 4 * n) : (f32x4){0.f, 0.f, 0.f, 0.f};
#pragma unroll
        for (int ai = 0; ai < 2; ++ai)
#pragma unroll
            for (int m = 0; m < 4; ++m) { bf16_t* rowp = base + (size_t)(row0 + ai * HALF + m * 16) * ldc + col0;
#pragma unroll
                for (int bj = 0; bj < 2; ++bj) { f32x4 v0 = acc[ai][bj][m][0] + bv[bj][0], v1 = acc[ai][bj][m][1] + bv[bj][1];
                    if (ACT == 1) { f32x2 a = gelu_pk((f32x2){v0[0], v0[1]}), b = gelu_pk((f32x2){v0[2], v0[3]}), c = gelu_pk((f32x2){v1[0], v1[1]}), d = gelu_pk((f32x2){v1[2], v1[3]});
                        v0 = (f32x4){a.x, a.y, b.x, b.y}; v1 = (f32x4){c.x, c.y, d.x, d.y}; }
                    v0 = v0 * sc; v1 = v1 * sc; u32x4 w; w.x = cvt_pk_bf16(v0[0], v0[1]); w.y = cvt_pk_bf16(v0[2], v0[3]); w.z = cvt_pk_bf16(v1[0], v1[1]); w.w = cvt_pk_bf16(v1[2], v1[3]);
                    *(u32x4*)(rowp + bj * HALF) = w; } }
    }
};

struct EpiProjM { static constexpr bool PERM = true, AFTER_DRAIN = false;
    bf16_t* O; float* SS; float* DT;
    __device__ __forceinline__ void operator()(const f32x4 (&acc)[2][2][4][2], const Unit& u, int wr, int wc, int fr, int fq) const {
        const int row0 = u.pm * BM + wr * 64 + fr, colt = u.pn * BM, col0 = colt + wc * 32 + 8 * fq;
#pragma unroll
        for (int ai = 0; ai < 2; ++ai)
#pragma unroll
            for (int m = 0; m < 4; ++m) { const int row = row0 + ai * HALF + m * 16; bf16_t* rowp = O + (size_t)row * 2560 + col0;
#pragma unroll
                for (int bj = 0; bj < 2; ++bj) { const f32x4 v0 = acc[ai][bj][m][0], v1 = acc[ai][bj][m][1];
                    u32x4 w; w.x = cvt_pk_bf16(v0[0], v0[1]); w.y = cvt_pk_bf16(v0[2], v0[3]); w.z = cvt_pk_bf16(v1[0], v1[1]); w.w = cvt_pk_bf16(v1[2], v1[3]);
                    *(u32x4*)(rowp + bj * HALF) = w;
                    const int cs = colt + bj * HALF + wc * 32;
                    if (cs < 640) { float q = (v0[0] * v0[0] + v0[1] * v0[1]) + (v0[2] * v0[2] + v0[3] * v0[3]) + (v1[0] * v1[0] + v1[1] * v1[1]) + (v1[2] * v1[2] + v1[3] * v1[3]);
                        q += __shfl_xor(q, 16); q += __shfl_xor(q, 32); if (fq == 0) SS[(size_t)row * 20 + (cs >> 5)] = q; }
                    if (cs == 2464 && fq < 2) { *(f32x4*)(DT + (size_t)row * 16 + 8 * fq) = v0; *(f32x4*)(DT + (size_t)row * 16 + 8 * fq + 4) = v1; } } }
    }
};

struct EpiQ { static constexpr bool PERM = true, AFTER_DRAIN = false;
    bf16_t* Q; const float* SS; const float* COS; const float* SIN;
    __device__ __forceinline__ void operator()(const f32x4 (&acc)[2][2][4][2], const Unit& u, int wr, int wc, int fr, int fq) const {
        asm volatile("" : "+v"(fr), "+v"(fq));
        const int row0 = u.pm * BM + wr * 64 + fr, colt = u.pn * BM;
#pragma unroll
        for (int ai = 0; ai < 2; ++ai)
#pragma unroll
            for (int m = 0; m < 4; ++m) { const int row = row0 + ai * HALF + m * 16; const int b = row >> 13, t = row & 8191;
                const f32x4 s0 = *(const f32x4*)(SS + (size_t)row * 20), s1 = *(const f32x4*)(SS + (size_t)row * 20 + 4), s2 = *(const f32x4*)(SS + (size_t)row * 20 + 8);
                const float ssq = ((s0[0] + s0[1]) + (s0[2] + s0[3])) + ((s1[0] + s1[1]) + (s1[2] + s1[3])) + ((s2[0] + s2[1]) + (s2[2] + s2[3]));
                const float rstd = rsqrtf(ssq * (1.f / 384.f) + 1e-6f);
#pragma unroll
                for (int bj = 0; bj < 2; ++bj) { const int cs = colt + bj * HALF + wc * 32, c0 = cs + 8 * fq; const int h = c0 / 96, j = c0 - h * 96;
                    float v[8];
#pragma unroll
                    for (int i = 0; i < 4; ++i) { v[i] = acc[ai][bj][m][0][i] * rstd; v[4 + i] = acc[ai][bj][m][1][i] * rstd; }
                    if ((cs % 96) == 64) {
                        const int jj0 = 8 * (fq & 1);
                        const f32x4 c0v = *(const f32x4*)(COS + t * 16 + jj0), c1v = *(const f32x4*)(COS + t * 16 + jj0 + 4), s0v = *(const f32x4*)(SIN + t * 16 + jj0), s1v = *(const f32x4*)(SIN + t * 16 + jj0 + 4);
#pragma unroll
                        for (int i = 0; i < 8; ++i) { const float pv = __shfl_xor(v[i], 32); const float cc = i < 4 ? c0v[i & 3] : c1v[i & 3], sn = i < 4 ? s0v[i & 3] : s1v[i & 3];
                            v[i] = fq < 2 ? v[i] * cc - pv * sn : v[i] * cc + pv * sn; }
                    }
                    u32x4 w; w.x = cvt_pk_bf16(v[0], v[1]); w.y = cvt_pk_bf16(v[2], v[3]); w.z = cvt_pk_bf16(v[4], v[5]); w.w = cvt_pk_bf16(v[6], v[7]);
                    *(u32x4*)(Q + ((size_t)(b * 8 + h) * 8192 + t) * 96 + j) = w; }
                asm volatile("" ::: "memory"); }
    }
};
struct EpiKV { static constexpr bool PERM = true, AFTER_DRAIN = false;
    bf16_t* Kb; bf16_t* Vb; const float* SS;
    __device__ __forceinline__ void operator()(const f32x4 (&acc)[2][2][4][2], const Unit& u, int wr, int wc, int fr, int fq) const {
        asm volatile("" : "+v"(fr), "+v"(fq));
        const int colt = u.pn * BM; int b, key0; if (u.pm < 128) { b = u.pm >> 5; key0 = 256 + (u.pm & 31) * 256; } else { b = u.pm - 128; key0 = 0; }
        float rs[2][4];
#pragma unroll
        for (int ai = 0; ai < 2; ++ai) { f32x4 t[4][2];
#pragma unroll
            for (int m = 0; m < 4; ++m) { const float* sp = SS + (size_t)(u.pm * BM + wr * 64 + fr + ai * HALF + m * 16) * 20 + 12; t[m][0] = *(const f32x4*)sp; t[m][1] = *(const f32x4*)(sp + 4); }
#pragma unroll
            for (int m = 0; m < 4; ++m) { const f32x4 s0 = t[m][0], s1 = t[m][1];
                const float ssq = ((s0[0] + s0[1]) + (s0[2] + s0[3])) + ((s1[0] + s1[1]) + (s1[2] + s1[3]));
                rs[ai][m] = rsqrtf(ssq * (1.f / 256.f) + 1e-6f); }
            asm volatile("" ::: "memory"); }
#pragma unroll
        for (int ai = 0; ai < 2; ++ai)
#pragma unroll
            for (int m = 0; m < 4; ++m) { const int lr = wr * 64 + fr + ai * HALF + m * 16; const int key = key0 + lr;
                const float rstd = rs[ai][m];
#pragma unroll
                for (int bj = 0; bj < 2; ++bj) { const int c0 = colt + bj * HALF + wc * 32 + 8 * fq; const int h = c0 >> 7, j = c0 & 127; const size_t kr = (size_t)(b * 8 + h) * 8448 + key;
                    const f32x4 v0 = acc[ai][bj][m][0] * rstd, v1 = acc[ai][bj][m][1] * rstd;
                    u32x4 w; w.x = cvt_pk_bf16(v0[0], v0[1]); w.y = cvt_pk_bf16(v0[2], v0[3]); w.z = cvt_pk_bf16(v1[0], v1[1]); w.w = cvt_pk_bf16(v1[2], v1[3]);
                    if (wc < 2) *(u32x4*)(Kb + kr * 96 + j) = w; else *(u32x4*)(Vb + kr * 64 + (j - 64)) = w; }
                asm volatile("" ::: "memory"); }
    }
};
struct EpiPL { static constexpr bool PERM = true, AFTER_DRAIN = false;
    bf16_t* T; const bf16_t* UG;
    __device__ __forceinline__ void operator()(const f32x4 (&acc)[2][2][4][2], const Unit& u, int wr, int wc, int fr, int fq) const {
        const int row0 = u.pm * BM + wr * 64 + fr, col0 = u.pn * BM + wc * 32 + 8 * fq;
        u32x4 g8[2][4][2];
#pragma unroll
        for (int ai = 0; ai < 2; ++ai)
#pragma unroll
            for (int m = 0; m < 4; ++m)
#pragma unroll
                for (int bj = 0; bj < 2; ++bj) g8[ai][m][bj] = *(const u32x4*)(UG + (size_t)(row0 + ai * HALF + m * 16) * 2048 + 1024 + col0 + bj * HALF);
#pragma unroll
        for (int ai = 0; ai < 2; ++ai)
#pragma unroll
            for (int m = 0; m < 4; ++m) { const int row = row0 + ai * HALF + m * 16;
#pragma unroll
                for (int bj = 0; bj < 2; ++bj) { const int c0 = col0 + bj * HALF; const u32x4 gq = g8[ai][m][bj];
                    float v[8];
#pragma unroll
                    for (int i = 0; i < 4; ++i) { const float glo = __uint_as_float(gq[i] << 16), ghi = __uint_as_float(gq[i] & 0xffff0000u);
                        const float a0 = i < 2 ? acc[ai][bj][m][0][2 * i] : acc[ai][bj][m][1][2 * i - 4], a1 = i < 2 ? acc[ai][bj][m][0][2 * i + 1] : acc[ai][bj][m][1][2 * i - 3];
                        v[2 * i] = a0 * (glo * __builtin_amdgcn_rcpf(1.f + __expf(-glo))); v[2 * i + 1] = a1 * (ghi * __builtin_amdgcn_rcpf(1.f + __expf(-ghi))); }
                    u32x4 w; w.x = cvt_pk_bf16(v[0], v[1]); w.y = cvt_pk_bf16(v[2], v[3]); w.z = cvt_pk_bf16(v[4], v[5]); w.w = cvt_pk_bf16(v[6], v[7]);
                    *(u32x4*)(T + (size_t)row * 1024 + c0) = w; } }
    }
};
struct EpiResM { static constexpr bool PERM = false, AFTER_DRAIN = false;
    const float* res; const float* gate; float* out; int rows_per_batch; int pad;
    __device__ __forceinline__ void operator()(const f32x4 (&acc)[2][2][4][2], const Unit& u, int wr, int wc, int fr, int fq) const {
        const int row0 = u.pm * BM + wr * 64 + fr, col0 = u.pn * BM + wc * 32 + 4 * fq; const int b = (u.pm * BM) / rows_per_batch;
        f32x4 gv[2][2];
#pragma unroll
        for (int bj = 0; bj < 2; ++bj)
#pragma unroll
            for (int n = 0; n < 2; ++n) gv[bj][n] = *(const f32x4*)(gate + b * 3072 + 2048 + col0 + bj * HALF + n * 16);
#pragma unroll
        for (int ai = 0; ai < 2; ++ai)
#pragma unroll
            for (int m = 0; m < 4; ++m) { const size_t off = (size_t)(row0 + ai * HALF + m * 16) * 1024 + col0;
#pragma unroll
                for (int bj = 0; bj < 2; ++bj)
#pragma unroll
                    for (int n = 0; n < 2; ++n) { const f32x4 r = *(const f32x4*)(res + off + bj * HALF + n * 16); *(f32x4*)(out + off + bj * HALF + n * 16) = r + gv[bj][n] * acc[ai][bj][m][n]; }
                if (m == 3) asm volatile("" ::: "memory"); }
    }
};

struct PanelRms {
    unsigned* xbuf;
    unsigned* cnt;
    int pm_off; float eps;
    __device__ __forceinline__ void run(const f32x4 (&v)[2][2][4][2], const Unit& u, int wr, int wc, int fr, int fq, PG8_LAS unsigned char* lds, int wid, int lane) const { publish(v, u, wr, wc, fr, fq, lds, wid, lane); collect(u, lds, wid, lane); }
    __device__ __forceinline__ void publish(const f32x4 (&v)[2][2][4][2], const Unit& u, int wr, int wc, int fr, int fq, PG8_LAS unsigned char* lds, int wid, int lane) const {
        PG8_LAS float* Pq = (PG8_LAS float*)lds;
        PG8_LAS float* S = (PG8_LAS float*)(lds + 8192);
        const int gpm = u.pm + pm_off;
#pragma unroll
        for (int ai = 0; ai < 2; ++ai)
#pragma unroll
            for (int m = 0; m < 4; ++m) { float q = 0.f;
#pragma unroll
                for (int bj = 0; bj < 2; ++bj)
#pragma unroll
                    for (int n = 0; n < 2; ++n) { const f32x4 x = v[ai][bj][m][n]; q += (x[0] * x[0] + x[1] * x[1]) + (x[2] * x[2] + x[3] * x[3]); }
                q += __shfl_xor(q, 16); q += __shfl_xor(q, 32);
                if (fq == 0) Pq[(ai * HALF + wr * 64 + m * 16 + fr) * 4 + wc] = q; }
        asm volatile("s_waitcnt lgkmcnt(0)" ::: "memory"); __builtin_amdgcn_s_barrier(); asm volatile("" ::: "memory");
        const int row = wid * 32 + (lane & 31);
        if (lane < 32) { const float sq = (Pq[row * 4 + 0] + Pq[row * 4 + 1]) + (Pq[row * 4 + 2] + Pq[row * 4 + 3]);
            __hip_atomic_store(xbuf + ((size_t)(gpm * BM + row) * 4 + u.pn), __float_as_uint(sq), __ATOMIC_RELAXED, __HIP_MEMORY_SCOPE_AGENT); }
        asm volatile("s_waitcnt vmcnt(0)" ::: "memory");
        if (lane == 0) __hip_atomic_fetch_add(cnt + 64 * gpm, 1u, __ATOMIC_RELAXED, __HIP_MEMORY_SCOPE_AGENT);
    }
    __device__ __forceinline__ void collect(const Unit& u, PG8_LAS unsigned char* lds, int wid, int lane) const {
        PG8_LAS float* S = (PG8_LAS float*)(lds + 8192);
        const int gpm = u.pm + pm_off; const int row = wid * 32 + (lane & 31);
        if (wid == 0) {
            for (unsigned sp = 0; sp < (1u << 22); ++sp) {
                if ((unsigned)__builtin_amdgcn_readfirstlane(__hip_atomic_load(cnt + 64 * gpm, __ATOMIC_RELAXED, __HIP_MEMORY_SCOPE_AGENT)) >= 32u) break;
                __builtin_amdgcn_s_sleep(2); }
            __builtin_amdgcn_fence(__ATOMIC_ACQUIRE, "agent");
        }
        asm volatile("s_waitcnt vmcnt(0) lgkmcnt(0)" ::: "memory"); __builtin_amdgcn_s_barrier(); asm volatile("" ::: "memory");
        if (lane < 32) { const unsigned* slot = xbuf + (size_t)(gpm * BM + row) * 4; float tot = 0.f;
#pragma unroll
            for (int t = 0; t < 4; ++t) tot += __uint_as_float(__hip_atomic_load(slot + t, __ATOMIC_RELAXED, __HIP_MEMORY_SCOPE_AGENT));
            S[row] = rsqrtf(tot * (1.f / 1024.f) + eps); }
        asm volatile("s_waitcnt lgkmcnt(0)" ::: "memory"); __builtin_amdgcn_s_barrier(); asm volatile("" ::: "memory");
    }
};
typedef _Float16 h16x4 __attribute__((ext_vector_type(4)));
struct EpiResNorm { static constexpr bool PERM = false, AFTER_DRAIN = true;
    const float* res; const float* gate; _Float16* X1; bf16_t* Hn; const float* nw; const float* modn; PanelRms st; int rows_per_batch; int pad;
    __device__ __forceinline__ void operator()(const f32x4 (&)[2][2][4][2], const Unit&, int, int, int, int) const {}
    __device__ __forceinline__ void fused(f32x4 (&acc)[2][2][4][2], const Unit& u, int wr, int wc, int fr, int fq, PG8_LAS unsigned char* lds, int wid, int lane) const {
        typedef unsigned u32x2v __attribute__((ext_vector_type(2)));
        const PG8_LAS float* S = (const PG8_LAS float*)(lds + 8192);
        const int grow0 = (u.pm + st.pm_off) * BM, col0 = u.pn * BM + wc * 32 + 4 * fq; const int b = grow0 / rows_per_batch;
#pragma unroll
        for (int bj = 0; bj < 2; ++bj)
#pragma unroll
            for (int n = 0; n < 2; ++n) { const f32x4 gv = *(const f32x4*)(gate + b * 3072 + 2048 + col0 + bj * HALF + n * 16);
#pragma unroll
                for (int ai = 0; ai < 2; ++ai)
#pragma unroll
                    for (int m = 0; m < 4; ++m) acc[ai][bj][m][n] *= gv; }
#pragma unroll
        for (int ai = 0; ai < 2; ++ai)
#pragma unroll
            for (int m = 0; m < 4; ++m) { const size_t off = (size_t)(grow0 + ai * HALF + wr * 64 + m * 16 + fr) * 1024 + col0;
#pragma unroll
                for (int bj = 0; bj < 2; ++bj)
#pragma unroll
                    for (int n = 0; n < 2; ++n) acc[ai][bj][m][n] += *(const f32x4*)(res + off + bj * HALF + n * 16);
                asm volatile("" : "+v"(acc[ai][0][m][0]), "+v"(acc[ai][0][m][1]), "+v"(acc[ai][1][m][0]), "+v"(acc[ai][1][m][1]));
                if (m == 3) asm volatile("" ::: "memory"); }
        f32x4 gn[2][2], shn[2][2];
#pragma unroll
        for (int bj = 0; bj < 2; ++bj)
#pragma unroll
            for (int n = 0; n < 2; ++n) { const int c = col0 + bj * HALF + n * 16;
                gn[bj][n] = *(const f32x4*)(nw + c) * (*(const f32x4*)(modn + b * 3072 + 1024 + c) + 1.f); shn[bj][n] = *(const f32x4*)(modn + b * 3072 + c); }
        st.publish(acc, u, wr, wc, fr, fq, lds, wid, lane);
#pragma unroll
        for (int ai = 0; ai < 2; ++ai)
#pragma unroll
            for (int m = 0; m < 4; ++m) { const size_t off = (size_t)(grow0 + ai * HALF + wr * 64 + m * 16 + fr) * 1024 + col0;
#pragma unroll
                for (int bj = 0; bj < 2; ++bj)
#pragma unroll
                    for (int n = 0; n < 2; ++n) *(h16x4*)(X1 + off + bj * HALF + n * 16) = __builtin_convertvector(acc[ai][bj][m][n], h16x4); }
        st.collect(u, lds, wid, lane);
#pragma unroll
        for (int ai = 0; ai < 2; ++ai)
#pragma unroll
            for (int m = 0; m < 4; ++m) { const int r = ai * HALF + wr * 64 + m * 16 + fr; const float rstd = S[r]; const size_t off = (size_t)(grow0 + r) * 1024 + col0;
#pragma unroll
                for (int bj = 0; bj < 2; ++bj)
#pragma unroll
                    for (int n = 0; n < 2; ++n) { const f32x4 x1 = acc[ai][bj][m][n];
                        const f32x4 o = x1 * rstd * gn[bj][n] + shn[bj][n];
                        u32x2v pk; pk.x = cvt_pk_bf16(o[0], o[1]); pk.y = cvt_pk_bf16(o[2], o[3]);
                        *(u32x2v*)(Hn + off + bj * HALF + n * 16) = pk; }
                asm volatile("" ::: "memory"); }
    }
};
struct EpiResFinal { static constexpr bool PERM = false, AFTER_DRAIN = true;
    const _Float16* res; const float* gate; float* out; const float* fw; PanelRms st; int rows_per_batch; int pad;
    __device__ __forceinline__ void operator()(const f32x4 (&)[2][2][4][2], const Unit&, int, int, int, int) const {}
    __device__ __forceinline__ void fused(f32x4 (&acc)[2][2][4][2], const Unit& u, int wr, int wc, int fr, int fq, PG8_LAS unsigned char* lds, int wid, int lane) const {
        const PG8_LAS float* S = (const PG8_LAS float*)(lds + 8192);
        const int grow0 = (u.pm + st.pm_off) * BM, col0 = u.pn * BM + wc * 32 + 4 * fq; const int b = grow0 / rows_per_batch;
#pragma unroll
        for (int bj = 0; bj < 2; ++bj)
#pragma unroll
            for (int n = 0; n < 2; ++n) { const f32x4 gv = *(const f32x4*)(gate + b * 3072 + 2048 + col0 + bj * HALF + n * 16);
#pragma unroll
                for (int ai = 0; ai < 2; ++ai)
#pragma unroll
                    for (int m = 0; m < 4; ++m) acc[ai][bj][m][n] *= gv; }
#pragma unroll
        for (int ai = 0; ai < 2; ++ai)
#pragma unroll
            for (int m = 0; m < 4; ++m) { const size_t off = (size_t)(grow0 + ai * HALF + wr * 64 + m * 16 + fr) * 1024 + col0;
#pragma unroll
                for (int bj = 0; bj < 2; ++bj)
#pragma unroll
                    for (int n = 0; n < 2; ++n) acc[ai][bj][m][n] += __builtin_convertvector(*(const h16x4*)(res + off + bj * HALF + n * 16), f32x4);
                asm volatile("" : "+v"(acc[ai][0][m][0]), "+v"(acc[ai][0][m][1]), "+v"(acc[ai][1][m][0]), "+v"(acc[ai][1][m][1]));
                if (m == 3) asm volatile("" ::: "memory"); }
        f32x4 fwv[2][2];
#pragma unroll
        for (int bj = 0; bj < 2; ++bj)
#pragma unroll
            for (int n = 0; n < 2; ++n) fwv[bj][n] = *(const f32x4*)(fw + col0 + bj * HALF + n * 16);
        st.run(acc, u, wr, wc, fr, fq, lds, wid, lane);
#pragma unroll
        for (int ai = 0; ai < 2; ++ai)
#pragma unroll
            for (int m = 0; m < 4; ++m) { const int r = ai * HALF + wr * 64 + m * 16 + fr; const float rstd = S[r]; const size_t off = (size_t)(grow0 + r) * 1024 + col0;
#pragma unroll
                for (int bj = 0; bj < 2; ++bj)
#pragma unroll
                    for (int n = 0; n < 2; ++n) *(f32x4*)(out + off + bj * HALF + n * 16) = acc[ai][bj][m][n] * rstd * fwv[bj][n];
                asm volatile("" ::: "memory"); }
    }
};
template <class Epi, class Sched, bool ALIGN_EPI = false, bool SP2 = false>
__device__ __forceinline__ void gemm_phase(PG8_LAS unsigned char* lds, const Gemm g, const Sched& S, const Epi& E) {
    int tid_ = TIDX; asm volatile("" : "+v"(tid_));
    const int tid = tid_, wid = __builtin_amdgcn_readfirstlane(tid >> 6), lane = tid & 63, wr = wid >> 2, wc = wid & 3, fr = lane & 15, fq = lane >> 4;
    const int K = g.K, nt = K / BK;
    unsigned voffA[2], voffB[2];
#pragma unroll
    for (int i = 0; i < 2; ++i) { int R, C; stage_rc(tid * 16 + i * 8192, R, C); const int Rb = Epi::PERM ? ((R & ~31) + perm32(R & 31)) : R;
        voffA[i] = (unsigned)(R * g.lda + C) * 2u; voffB[i] = (unsigned)(Rb * K + C) * 2u; }
    const unsigned kstep = (unsigned)(BK * 2);
    const unsigned hsA = (unsigned)HALF * g.lda * 2u, hsB = (unsigned)HALF * K * 2u;
    const unsigned tsA = 2 * hsA, tsB = 2 * hsB, apo = (unsigned)g.a_pn_off * 2u;
    const unsigned ldsw = (unsigned)wid * 1024u;
    const int aoff = lds_byte(wr * 64 + fr, fq * 8), boff = lds_byte(wc * 32 + fr, fq * 8);
#define PG8_SA(b, h) (((b) * 2 + (h)) * HTB)
#define PG8_SB(b, h) ((4 + (b) * 2 + (h)) * HTB)
#define PG8_STAGEX(rs, bufoff, goff, voff) do { _Pragma("unroll") for (int _i = 0; _i < 2; ++_i) \
        __builtin_amdgcn_raw_ptr_buffer_load_lds((rs), (PG8_LAS void*)(lds + (bufoff) + ldsw + _i * 8192), 16, (int)(voff)[_i], (int)(goff), 0, 0); } while (0)
#define PG8_STAGEA(bufoff, goff, voff) PG8_STAGEX(rsA, bufoff, goff, voff)
#define PG8_STAGEB(bufoff, goff, voff) PG8_STAGEX(rsB, bufoff, goff, voff)
#define PG8_LDA(dst, b, h) do { _Pragma("unroll") for (int m = 0; m < 4; ++m) _Pragma("unroll") for (int k = 0; k < 2; ++k) dst[m][k] = *(const PG8_LAS bf16x8*)(lds + PG8_SA(b, h) + aoff + m * 2048 + k * 1024); } while (0)
#define PG8_LDB(dst, b, h) do { _Pragma("unroll") for (int n = 0; n < 2; ++n) _Pragma("unroll") for (int k = 0; k < 2; ++k) dst[n][k] = *(const PG8_LAS bf16x8*)(lds + PG8_SB(b, h) + boff + n * 2048 + k * 1024); } while (0)
#define PG8_MMA(ai, bj, At, Bt) do { __builtin_amdgcn_s_setprio(1); _Pragma("unroll") for (int m = 0; m < 4; ++m) _Pragma("unroll") for (int n = 0; n < 2; ++n) _Pragma("unroll") for (int k = 0; k < 2; ++k) \
        acc[ai][bj][m][n] = __builtin_amdgcn_mfma_f32_16x16x32_bf16(Bt[n][k], At[m][k], acc[ai][bj][m][n], 0, 0, 0); __builtin_amdgcn_s_setprio(0); } while (0)
#define PG8_WAIT_V(n) asm volatile("s_waitcnt vmcnt(" #n ")" ::: "memory")
#define PG8_WAIT_L(n) asm volatile("s_waitcnt lgkmcnt(" #n ")" ::: "memory")
#define PG8_BAR __builtin_amdgcn_s_barrier()
#define PG8_SCHED __builtin_amdgcn_sched_barrier(0)
    Unit cur, nxt; int ui = 0;
    if (!S.next(0, cur)) return;
    f32x4 acc[2][2][4][2];
#pragma unroll
    for (int a = 0; a < 2; ++a)
#pragma unroll
        for (int b = 0; b < 2; ++b)
#pragma unroll
            for (int m = 0; m < 4; ++m)
#pragma unroll
                for (int n = 0; n < 2; ++n) acc[a][b][m][n] = (f32x4){0.f, 0.f, 0.f, 0.f};
    bf16x8 At[4][2], B0[2][2], B1[2][2];
    const __amdgpu_buffer_rsrc_t rsA = __builtin_amdgcn_make_buffer_rsrc((void*)g.A, 0, 0x7ffffff0, 0x00020000), rsB = __builtin_amdgcn_make_buffer_rsrc((void*)g.Bt, 0, 0x7ffffff0, 0x00020000);
    unsigned cA = (unsigned)cur.pm * tsA + (unsigned)cur.pn * apo, cB = (unsigned)cur.pn * tsB;
    S.a_ready(cur);
    if constexpr (SP2) {
        PG8_STAGEB(PG8_SB(0, 0), cB, voffB); PG8_STAGEB(PG8_SB(0, 1), cB + hsB, voffB); PG8_STAGEA(PG8_SA(0, 0), cA, voffA); PG8_STAGEA(PG8_SA(0, 1), cA + hsA, voffA);
        if (wr == 1) PG8_BAR;
        PG8_WAIT_V(2); PG8_BAR;
        PG8_STAGEB(PG8_SB(1, 0), cB + kstep, voffB); PG8_STAGEA(PG8_SA(1, 0), cA + kstep, voffA); PG8_STAGEB(PG8_SB(1, 1), cB + hsB + kstep, voffB);
        PG8_WAIT_V(6); PG8_BAR;
    } else {
        PG8_STAGEB(PG8_SB(0, 0), cB, voffB); PG8_STAGEA(PG8_SA(0, 0), cA, voffA); PG8_STAGEB(PG8_SB(0, 1), cB + hsB, voffB); PG8_STAGEA(PG8_SA(0, 1), cA + hsA, voffA);
        if (wr == 1) PG8_BAR;
        PG8_WAIT_V(4); PG8_BAR;
        PG8_STAGEB(PG8_SB(1, 0), cB + kstep, voffB); PG8_STAGEA(PG8_SA(1, 0), cA + kstep, voffA); PG8_STAGEB(PG8_SB(1, 1), cB + hsB + kstep, voffB);
        PG8_WAIT_V(6); PG8_BAR;
    }
    for (;;) {
        const bool has_next = S.next(ui + 1, nxt);
        const unsigned nA = has_next ? (unsigned)nxt.pm * tsA + (unsigned)nxt.pn * apo : cA, nB = has_next ? (unsigned)nxt.pn * tsB : cB;
        for (int t = 0; t < nt; t += 2) {
            const bool last = (t == nt - 2);
            const unsigned a1 = cA + (unsigned)(t + 1) * kstep;
            const unsigned a2 = last ? nA : cA + (unsigned)(t + 2) * kstep, b2 = last ? nB : cB + (unsigned)(t + 2) * kstep;
            const unsigned a3 = a2 + kstep, b3 = b2 + kstep;
            if (last && has_next) S.a_ready(nxt);
            if constexpr (SP2) {
            PG8_LDB(B0, 0, 0); PG8_LDB(B1, 0, 1); PG8_SCHED; PG8_LDA(At, 0, 0); PG8_STAGEA(PG8_SA(1, 1), a1 + hsA, voffA);
            PG8_WAIT_V(8); PG8_WAIT_L(0); PG8_BAR; PG8_MMA(0, 0, At, B0); PG8_MMA(0, 1, At, B1); PG8_BAR; PG8_SCHED;
            PG8_LDA(At, 0, 1); PG8_STAGEB(PG8_SB(0, 0), b2, voffB); PG8_STAGEB(PG8_SB(0, 1), b2 + hsB, voffB); PG8_STAGEA(PG8_SA(0, 0), a2, voffA);
            PG8_WAIT_V(8); PG8_WAIT_L(0); PG8_BAR; PG8_MMA(1, 0, At, B0); PG8_MMA(1, 1, At, B1); PG8_BAR; PG8_SCHED;
            PG8_LDB(B0, 1, 0); PG8_LDB(B1, 1, 1); PG8_SCHED; PG8_LDA(At, 1, 0); PG8_STAGEA(PG8_SA(0, 1), a2 + hsA, voffA);
            PG8_WAIT_V(8); PG8_WAIT_L(0); PG8_BAR; PG8_MMA(0, 0, At, B0); PG8_MMA(0, 1, At, B1); PG8_BAR; PG8_SCHED;
            PG8_LDA(At, 1, 1); PG8_STAGEB(PG8_SB(1, 0), b3, voffB); PG8_STAGEB(PG8_SB(1, 1), b3 + hsB, voffB); PG8_STAGEA(PG8_SA(1, 0), a3, voffA);
            PG8_WAIT_V(8); PG8_WAIT_L(0); PG8_BAR; PG8_MMA(1, 0, At, B0); PG8_MMA(1, 1, At, B1); PG8_BAR; PG8_SCHED;
            } else {
            PG8_LDB(B0, 0, 0); PG8_SCHED; PG8_LDA(At, 0, 0); PG8_STAGEA(PG8_SA(1, 1), a1 + hsA, voffA);
            PG8_WAIT_L(8); PG8_BAR; PG8_WAIT_L(0); PG8_MMA(0, 0, At, B0); PG8_BAR; PG8_SCHED;
            PG8_LDB(B1, 0, 1); PG8_STAGEB(PG8_SB(0, 0), b2, voffB);
            PG8_BAR; PG8_WAIT_L(0); PG8_MMA(0, 1, At, B1); PG8_BAR;
            PG8_LDA(At, 0, 1); PG8_STAGEA(PG8_SA(0, 0), a2, voffA);
            PG8_BAR; PG8_WAIT_L(0); PG8_MMA(1, 0, At, B0); PG8_BAR; PG8_SCHED;
            PG8_STAGEB(PG8_SB(0, 1), b2 + hsB, voffB);
            PG8_WAIT_V(6); PG8_BAR; PG8_MMA(1, 1, At, B1); PG8_BAR;
            PG8_LDB(B0, 1, 0); PG8_SCHED; PG8_LDA(At, 1, 0); PG8_STAGEA(PG8_SA(0, 1), a2 + hsA, voffA);
            PG8_WAIT_L(8); PG8_BAR; PG8_WAIT_L(0); PG8_MMA(0, 0, At, B0); PG8_BAR; PG8_SCHED;
            PG8_LDB(B1, 1, 1); PG8_STAGEB(PG8_SB(1, 0), b3, voffB);
            PG8_BAR; PG8_WAIT_L(0); PG8_MMA(0, 1, At, B1); PG8_BAR;
            PG8_LDA(At, 1, 1); PG8_STAGEA(PG8_SA(1, 0), a3, voffA);
            PG8_BAR; PG8_WAIT_L(0); PG8_MMA(1, 0, At, B0); PG8_BAR; PG8_SCHED;
            PG8_STAGEB(PG8_SB(1, 1), b3 + hsB, voffB);
            PG8_WAIT_V(6); PG8_BAR; PG8_MMA(1, 1, At, B1); PG8_BAR;
            }
        }
        if constexpr (ALIGN_EPI) { if (wr == 0) PG8_BAR; }
        if constexpr (!Epi::AFTER_DRAIN) { E(acc, cur, wr, wc, fr, fq); S.done(cur); }
        if (!has_next) break;
#pragma unroll
        for (int a = 0; a < 2; ++a)
#pragma unroll
            for (int b = 0; b < 2; ++b)
#pragma unroll
                for (int m = 0; m < 4; ++m)
#pragma unroll
                    for (int n = 0; n < 2; ++n) acc[a][b][m][n] = (f32x4){0.f, 0.f, 0.f, 0.f};
        cur = nxt; cA = nA; cB = nB; ++ui;
        if constexpr (ALIGN_EPI) { if (wr == 1) PG8_BAR; }
    }
    PG8_WAIT_V(0);
    if constexpr (!ALIGN_EPI) { if (wr == 0) PG8_BAR; }
    PG8_BAR;
    if constexpr (Epi::AFTER_DRAIN) { E.fused(acc, cur, wr, wc, fr, fq, lds, wid, lane); S.done(cur); }
#undef PG8_SA
#undef PG8_SB
#undef PG8_STAGEX
#undef PG8_STAGEA
#undef PG8_STAGEB
#undef PG8_LDA
#undef PG8_LDB
#undef PG8_MMA
#undef PG8_WAIT_V
#undef PG8_WAIT_L
#undef PG8_BAR
#undef PG8_SCHED
}
}


namespace attn {
using bf16x8 = __attribute__((ext_vector_type(8))) short;
using s16x4  = __attribute__((ext_vector_type(4))) short;
using f32x16 = __attribute__((ext_vector_type(16))) float;
using u32x4  = __attribute__((ext_vector_type(4))) unsigned;
constexpr int DQK = 96, DV = 64, NW = 8, QBLK = 32, KVBLK = 64;
constexpr float THR = 8.f;
constexpr int SHM_V = KVBLK * DV * 2, SHM_K = KVBLK * 256;
constexpr int SHM_ATTN = 2 * SHM_V + 2 * SHM_K + NW * 64 * 4;
#define AT_KSWZ(row, colB) ((row) * 256 + ((colB) ^ (((row) & 7) << 4)))
#define AT_SBAR() __builtin_amdgcn_sched_barrier(0)
__device__ __forceinline__ int crow(int r, int hi) { return (r & 3) + 8 * (r >> 2) + 4 * hi; }
__device__ __forceinline__ unsigned cvtpk(float lo, float hi) { unsigned r; asm volatile("v_cvt_pk_bf16_f32 %0, %1, %2" : "=v"(r) : "v"(lo), "v"(hi)); return r; }
__device__ __forceinline__ float rowmax32(const f32x16& p0, const f32x16& p1) {
  float a = fmaxf(fmaxf(p0[0], p0[1]), p1[0]), b = fmaxf(fmaxf(p0[2], p0[3]), p1[1]); a = fmaxf(fmaxf(a, p1[2]), p1[3]);
#pragma unroll
  for (int r = 4; r < 16; r += 4) { a = fmaxf(fmaxf(a, p0[r]), p0[r + 1]); b = fmaxf(fmaxf(b, p0[r + 2]), p0[r + 3]); a = fmaxf(fmaxf(a, p1[r]), p1[r + 1]); b = fmaxf(fmaxf(b, p1[r + 2]), p1[r + 3]); }
  float pm = fmaxf(a, b);
  auto rr = __builtin_amdgcn_permlane32_swap(__float_as_uint(pm), __float_as_uint(pm), false, false);
  return fmaxf(__uint_as_float(rr[0]), __uint_as_float(rr[1]));
}
template <int VAR, bool FIRST> __device__ __forceinline__ void partialSM(f32x16& p0, f32x16& p1, float& m_reg, f32x16& negm, float& alpha) {
  const float pmax = rowmax32(p0, p1);
  alpha = 1.f;
  if (FIRST || !__builtin_expect(__all(pmax <= THR), 1)) {
    const float dl = FIRST ? pmax : fmaxf(pmax, 0.f);
    m_reg += dl; alpha = FIRST ? 0.f : __builtin_amdgcn_exp2f(-dl);
#pragma unroll
    for (int r = 0; r < 16; ++r) { p0[r] -= dl; p1[r] -= dl; negm[r] = -m_reg; }
  }
#pragma unroll
  for (int r = 0; r < 16; ++r) p0[r] = VAR == 2 ? p0[r] * 0.5f : __builtin_amdgcn_exp2f(p0[r]);
}
template <int VAR> __device__ __forceinline__ void finishSM(f32x16& p0, f32x16& p1, float alpha, float& l_reg, bf16x8& pa0, bf16x8& pa1, bf16x8& pa2, bf16x8& pa3) {
#pragma unroll
  for (int r = 0; r < 16; ++r) p1[r] = VAR == 2 ? p1[r] * 0.5f : __builtin_amdgcn_exp2f(p1[r]);
  float ps = 0;
#pragma unroll
  for (int r = 0; r < 16; ++r) ps += p0[r];
#pragma unroll
  for (int r = 0; r < 16; ++r) ps += p1[r];
  { auto rr = __builtin_amdgcn_permlane32_swap(__float_as_uint(ps), __float_as_uint(ps), false, false);
    ps = __uint_as_float(rr[0]) + __uint_as_float(rr[1]); }
  l_reg = l_reg * alpha + ps;
#define AT_PK4(P, BASE, OUT) do { unsigned a0 = cvtpk(P[BASE + 0], P[BASE + 1]), a1 = cvtpk(P[BASE + 2], P[BASE + 3]);   \
    unsigned b0 = cvtpk(P[BASE + 4], P[BASE + 5]), b1 = cvtpk(P[BASE + 6], P[BASE + 7]);                              \
    auto r0 = __builtin_amdgcn_permlane32_swap(a0, b0, false, false); auto r1 = __builtin_amdgcn_permlane32_swap(a1, b1, false, false); \
    u32x4 w = {r0[0], r1[0], r0[1], r1[1]}; OUT = *reinterpret_cast<bf16x8*>(&w); } while (0)
  AT_PK4(p0, 0, pa0); AT_PK4(p0, 8, pa1); AT_PK4(p1, 0, pa2); AT_PK4(p1, 8, pa3);
#undef AT_PK4
}
__device__ __forceinline__ void qkt(f32x16& p0, f32x16& p1, const char* Ks, const bf16x8* qr, int r32, int hi) {
  p0 = f32x16{}; p1 = f32x16{};
#pragma unroll
  for (int d0 = 0; d0 < DQK / 16; ++d0) { int cb = (d0 * 16 + hi * 8) * 2;
    bf16x8 b0 = *reinterpret_cast<const bf16x8*>(Ks + AT_KSWZ(r32, cb));
    bf16x8 b1 = *reinterpret_cast<const bf16x8*>(Ks + AT_KSWZ(32 + r32, cb));
    p0 = __builtin_amdgcn_mfma_f32_32x32x16_bf16(b0, qr[d0], p0, 0, 0, 0);
    p1 = __builtin_amdgcn_mfma_f32_32x32x16_bf16(b1, qr[d0], p1, 0, 0, 0); }
}
__device__ __forceinline__ int v_st(int k, int c) { const int kk = (k & ~0xC) | ((k & 4) << 1) | ((k & 8) >> 1); return ((kk >> 3) * 2 + (c >> 5)) * 512 + ((kk & 7) * 32 + (c & 31)) * 2; }
__device__ __forceinline__ int v_rd_base(int lane) { return ((lane & 3) << 3) | (((lane >> 2) & 3) << 6) | (((lane >> 4) & 1) << 5) | (((lane >> 5) & 1) << 8); }
constexpr int v_rd_off(int d0, int ks, int half) { return d0 * 512 + ks * 2048 + half * 1024; }
template <int OFF> __device__ __forceinline__ s16x4 tr_read(int vb) {
  s16x4 r; asm volatile("ds_read_b64_tr_b16 %0, %1 offset:%2" : "=&v"(r) : "v"(vb), "i"(OFF) : "memory"); return r;
}
template <int D0> __device__ __forceinline__ void pv_one(f32x16& od, int vb, bf16x8 pa0, bf16x8 pa1, bf16x8 pa2, bf16x8 pa3) {
  const s16x4 l0 = tr_read<v_rd_off(D0, 0, 0)>(vb), h0 = tr_read<v_rd_off(D0, 0, 1)>(vb), l1 = tr_read<v_rd_off(D0, 1, 0)>(vb), h1 = tr_read<v_rd_off(D0, 1, 1)>(vb);
  const s16x4 l2 = tr_read<v_rd_off(D0, 2, 0)>(vb), h2 = tr_read<v_rd_off(D0, 2, 1)>(vb), l3 = tr_read<v_rd_off(D0, 3, 0)>(vb), h3 = tr_read<v_rd_off(D0, 3, 1)>(vb);
  asm volatile("s_waitcnt lgkmcnt(0)" ::: "memory"); AT_SBAR();
#define AT_PK(L, H) (bf16x8){L[0], L[1], L[2], L[3], H[0], H[1], H[2], H[3]}
  od = __builtin_amdgcn_mfma_f32_32x32x16_bf16(pa0, AT_PK(l0, h0), od, 0, 0, 0);
  od = __builtin_amdgcn_mfma_f32_32x32x16_bf16(pa1, AT_PK(l1, h1), od, 0, 0, 0);
  od = __builtin_amdgcn_mfma_f32_32x32x16_bf16(pa2, AT_PK(l2, h2), od, 0, 0, 0);
  od = __builtin_amdgcn_mfma_f32_32x32x16_bf16(pa3, AT_PK(l3, h3), od, 0, 0, 0);
}
struct VFrag { s16x4 l[2][4], h[2][4]; };
__device__ __forceinline__ void vfrag_issue(VFrag& f, int vb) {
  f.l[0][0] = tr_read<v_rd_off(0, 0, 0)>(vb); f.h[0][0] = tr_read<v_rd_off(0, 0, 1)>(vb); f.l[1][0] = tr_read<v_rd_off(1, 0, 0)>(vb); f.h[1][0] = tr_read<v_rd_off(1, 0, 1)>(vb);
  f.l[0][1] = tr_read<v_rd_off(0, 1, 0)>(vb); f.h[0][1] = tr_read<v_rd_off(0, 1, 1)>(vb); f.l[1][1] = tr_read<v_rd_off(1, 1, 0)>(vb); f.h[1][1] = tr_read<v_rd_off(1, 1, 1)>(vb);
  f.l[0][2] = tr_read<v_rd_off(0, 2, 0)>(vb); f.h[0][2] = tr_read<v_rd_off(0, 2, 1)>(vb); f.l[1][2] = tr_read<v_rd_off(1, 2, 0)>(vb); f.h[1][2] = tr_read<v_rd_off(1, 2, 1)>(vb);
  f.l[0][3] = tr_read<v_rd_off(0, 3, 0)>(vb); f.h[0][3] = tr_read<v_rd_off(0, 3, 1)>(vb); f.l[1][3] = tr_read<v_rd_off(1, 3, 0)>(vb); f.h[1][3] = tr_read<v_rd_off(1, 3, 1)>(vb);
}
__device__ __forceinline__ void pv_mma(f32x16* o, const VFrag& f, bf16x8 pa0, bf16x8 pa1, bf16x8 pa2, bf16x8 pa3) {
  asm volatile("s_waitcnt lgkmcnt(0)" ::: "memory"); AT_SBAR();
  o[0] = __builtin_amdgcn_mfma_f32_32x32x16_bf16(pa0, AT_PK(f.l[0][0], f.h[0][0]), o[0], 0, 0, 0); o[1] = __builtin_amdgcn_mfma_f32_32x32x16_bf16(pa0, AT_PK(f.l[1][0], f.h[1][0]), o[1], 0, 0, 0);
  o[0] = __builtin_amdgcn_mfma_f32_32x32x16_bf16(pa1, AT_PK(f.l[0][1], f.h[0][1]), o[0], 0, 0, 0); o[1] = __builtin_amdgcn_mfma_f32_32x32x16_bf16(pa1, AT_PK(f.l[1][1], f.h[1][1]), o[1], 0, 0, 0);
  o[0] = __builtin_amdgcn_mfma_f32_32x32x16_bf16(pa2, AT_PK(f.l[0][2], f.h[0][2]), o[0], 0, 0, 0); o[1] = __builtin_amdgcn_mfma_f32_32x32x16_bf16(pa2, AT_PK(f.l[1][2], f.h[1][2]), o[1], 0, 0, 0);
  o[0] = __builtin_amdgcn_mfma_f32_32x32x16_bf16(pa3, AT_PK(f.l[0][3], f.h[0][3]), o[0], 0, 0, 0); o[1] = __builtin_amdgcn_mfma_f32_32x32x16_bf16(pa3, AT_PK(f.l[1][3], f.h[1][3]), o[1], 0, 0, 0);
}
#undef AT_PK
__device__ __forceinline__ void pv_d0(f32x16* o, int vb, bf16x8 pa0, bf16x8 pa1, bf16x8 pa2, bf16x8 pa3) {
  pv_one<0>(o[0], vb, pa0, pa1, pa2, pa3); pv_one<1>(o[1], vb, pa0, pa1, pa2, pa3);
}
constexpr int NSLOT = 4, KROWB = 208, SLOT_KB = 64 * KROWB, SLOT_VB = 8192, SLOT_B = SLOT_KB + SLOT_VB, LDS_WS = NSLOT * SLOT_B;
template <int VAR> __device__ __forceinline__ void attn_unit(const bf16_t* __restrict__ Qb, const bf16_t* __restrict__ Kh, const bf16_t* __restrict__ Vh, int seq,
                                          bf16_t* __restrict__ Ob, int o_pitch, const bf16_t* __restrict__ GA, int ga_pitch, char* lds, LAS unsigned char* L3) {
  int tid_ = TIDX; asm volatile("" : "+v"(tid_));
  const int tid = tid_, lane = tid & 63, r32 = lane & 31, hi = lane >> 5; const int wid = __builtin_amdgcn_readfirstlane(tid >> 6);
  float* ws = (float*)(lds + LDS_WS) + wid * 64; float* li_l = ws; float* al_l = ws + 32;
  float m_reg = 0.f, l_reg = 0; f32x16 o[2] = {}; bf16x8 qr[6]; f32x16 negm = {}; VFrag vf;
  int koff0, koff1, voff;
  { const int s0 = 64 * wid + lane, row0 = s0 / 13, c0 = s0 - row0 * 13; koff0 = row0 * 192 + (c0 < 12 ? c0 : 0) * 16;
    const int s1 = s0 + 512, row1 = s1 / 13, c1 = s1 - row1 * 13; koff1 = row1 * 192 + (c1 < 12 ? c1 : 0) * 16;
    const int sub = s0 >> 5, kk = (sub >> 1) * 8 + ((s0 & 31) >> 2), k = (kk & ~0xC) | ((kk & 4) << 1) | ((kk & 8) >> 1), c = (sub & 1) * 32 + (s0 & 3) * 8; voff = k * 128 + c * 2; }
  const bool k2 = wid < 5;
  const __amdgpu_buffer_rsrc_t rsK = __builtin_amdgcn_make_buffer_rsrc((void*)Kh, 0, 0x7ffffff0, 0x00020000), rsV = __builtin_amdgcn_make_buffer_rsrc((void*)Vh, 0, 0x7ffffff0, 0x00020000);
#define AT_DMA(t) do { const int so_ = ((t) & 3) * SLOT_B; \
    __builtin_amdgcn_raw_ptr_buffer_load_lds(rsK, (LAS void*)(L3 + so_ + wid * 1024), 16, koff0, (t) * (64 * 192), 0, 0); \
    if (k2) __builtin_amdgcn_raw_ptr_buffer_load_lds(rsK, (LAS void*)(L3 + so_ + (wid + 8) * 1024), 16, koff1, (t) * (64 * 192), 0, 0); \
    __builtin_amdgcn_raw_ptr_buffer_load_lds(rsV, (LAS void*)(L3 + so_ + SLOT_KB + wid * 1024), 16, voff, (t) * (64 * 128), 0, 0); } while (0)
#define AT_WAITBAR(n) do { if (k2) asm volatile("s_waitcnt vmcnt(" #n "*3) lgkmcnt(0)" ::: "memory"); else asm volatile("s_waitcnt vmcnt(" #n "*2) lgkmcnt(0)" ::: "memory"); __builtin_amdgcn_s_barrier(); } while (0)
  const int NTL = seq / KVBLK;
  const bf16_t* Qw = Qb + (long)(wid * QBLK + r32) * DQK + hi * 8;
#pragma unroll
  for (int d0 = 0; d0 < 6; ++d0) qr[d0] = *reinterpret_cast<const bf16x8*>(Qw + d0 * 16);
  AT_DMA(0); AT_DMA(1); AT_DMA(2);
  const int kb = r32 * KROWB + hi * 16;
  const int vb0 = (int)(uintptr_t)lds + SLOT_KB + v_rd_base(lane);
#define AT_QKT(P0, P1, t) do { const char* ks_ = lds + ((t) & 3) * SLOT_B + kb; \
    _Pragma("unroll") for (int d0 = 0; d0 < 6; ++d0) { const bf16x8 b0 = *reinterpret_cast<const bf16x8*>(ks_ + d0 * 32), b1 = *reinterpret_cast<const bf16x8*>(ks_ + 32 * KROWB + d0 * 32); \
      if (d0 == 0) { P0 = __builtin_amdgcn_mfma_f32_32x32x16_bf16(b0, qr[0], negm, 0, 0, 0); P1 = __builtin_amdgcn_mfma_f32_32x32x16_bf16(b1, qr[0], negm, 0, 0, 0); } \
      else { P0 = __builtin_amdgcn_mfma_f32_32x32x16_bf16(b0, qr[d0], P0, 0, 0, 0); P1 = __builtin_amdgcn_mfma_f32_32x32x16_bf16(b1, qr[d0], P1, 0, 0, 0); } } } while (0)
#define AT_RESC(a) do { if (__any((a) < 1.f)) { if (hi == 0) al_l[r32] = (a); asm volatile("s_waitcnt lgkmcnt(0)" ::: "memory"); \
    _Pragma("unroll") for (int d = 0; d < 2; ++d) _Pragma("unroll") for (int r = 0; r < 16; ++r) o[d][r] *= al_l[crow(r, hi)]; } } while (0)
  f32x16 pA0, pA1, pB0, pB1; float alA, alB; bf16x8 pa0, pa1, pa2, pa3;
  if (k2) asm volatile("s_waitcnt vmcnt(6)" ::: "memory"); else asm volatile("s_waitcnt vmcnt(4)" ::: "memory");
  __builtin_amdgcn_s_barrier();
  AT_QKT(pA0, pA1, 0); partialSM<VAR, true>(pA0, pA1, m_reg, negm, alA);
  AT_WAITBAR(1);
  for (int j = 1; j + 1 < NTL; j += 2) {
    AT_DMA(j + 2);
    vfrag_issue(vf, vb0 + ((j - 1) & 3) * SLOT_B);
    AT_SBAR(); AT_QKT(pB0, pB1, j);
    finishSM<VAR>(pA0, pA1, alA, l_reg, pa0, pa1, pa2, pa3); AT_SBAR();
    pv_mma(o, vf, pa0, pa1, pa2, pa3); partialSM<VAR, false>(pB0, pB1, m_reg, negm, alB);
    AT_RESC(alB);
    AT_WAITBAR(1);
    if (j + 3 < NTL) AT_DMA(j + 3);
    vfrag_issue(vf, vb0 + (j & 3) * SLOT_B);
    AT_SBAR(); AT_QKT(pA0, pA1, j + 1);
    finishSM<VAR>(pB0, pB1, alB, l_reg, pa0, pa1, pa2, pa3); AT_SBAR();
    pv_mma(o, vf, pa0, pa1, pa2, pa3); partialSM<VAR, false>(pA0, pA1, m_reg, negm, alA);
    AT_RESC(alA);
    if (j + 3 < NTL) AT_WAITBAR(1); else AT_WAITBAR(0);
  }
  vfrag_issue(vf, vb0 + ((NTL - 2) & 3) * SLOT_B);
  AT_SBAR(); AT_QKT(pB0, pB1, NTL - 1);
  finishSM<VAR>(pA0, pA1, alA, l_reg, pa0, pa1, pa2, pa3); AT_SBAR();
  pv_mma(o, vf, pa0, pa1, pa2, pa3); partialSM<VAR, false>(pB0, pB1, m_reg, negm, alB);
  AT_RESC(alB);
  finishSM<VAR>(pB0, pB1, alB, l_reg, pa0, pa1, pa2, pa3); AT_SBAR();
  pv_d0(o, vb0 + ((NTL - 1) & 3) * SLOT_B, pa0, pa1, pa2, pa3);
  if (hi == 0) li_l[r32] = l_reg; asm volatile("s_waitcnt lgkmcnt(0)" ::: "memory");
  float rli[16];
#pragma unroll
  for (int r = 0; r < 16; ++r) rli[r] = __builtin_amdgcn_rcpf(li_l[crow(r, hi)]);
#pragma unroll
  for (int r = 0; r < 16; ++r) { const int orow = wid * QBLK + crow(r, hi);
#pragma unroll
    for (int d0 = 0; d0 < 2; ++d0) { if (VAR != 0 && seq >= 0) continue; const float ga = bf2f(GA[(long)orow * ga_pitch + d0 * 32 + r32]);
      Ob[(long)orow * o_pitch + d0 * 32 + r32] = f2bf(o[d0][r] * rli[r] * (ga * __builtin_amdgcn_rcpf(1.f + __expf(-ga)))); } }
  asm volatile("s_waitcnt vmcnt(0) lgkmcnt(0)" ::: "memory"); __builtin_amdgcn_s_barrier();
#undef AT_DMA
#undef AT_WAITBAR
#undef AT_QKT
#undef AT_RESC
}

__device__ __forceinline__ void pv_mma_nw(f32x16* o, const VFrag& f, bf16x8 pa0, bf16x8 pa1, bf16x8 pa2, bf16x8 pa3) {
#define AT_PK(L, H) (bf16x8){L[0], L[1], L[2], L[3], H[0], H[1], H[2], H[3]}
  o[0] = __builtin_amdgcn_mfma_f32_32x32x16_bf16(pa0, AT_PK(f.l[0][0], f.h[0][0]), o[0], 0, 0, 0); o[1] = __builtin_amdgcn_mfma_f32_32x32x16_bf16(pa0, AT_PK(f.l[1][0], f.h[1][0]), o[1], 0, 0, 0);
  o[0] = __builtin_amdgcn_mfma_f32_32x32x16_bf16(pa1, AT_PK(f.l[0][1], f.h[0][1]), o[0], 0, 0, 0); o[1] = __builtin_amdgcn_mfma_f32_32x32x16_bf16(pa1, AT_PK(f.l[1][1], f.h[1][1]), o[1], 0, 0, 0);
  o[0] = __builtin_amdgcn_mfma_f32_32x32x16_bf16(pa2, AT_PK(f.l[0][2], f.h[0][2]), o[0], 0, 0, 0); o[1] = __builtin_amdgcn_mfma_f32_32x32x16_bf16(pa2, AT_PK(f.l[1][2], f.h[1][2]), o[1], 0, 0, 0);
  o[0] = __builtin_amdgcn_mfma_f32_32x32x16_bf16(pa3, AT_PK(f.l[0][3], f.h[0][3]), o[0], 0, 0, 0); o[1] = __builtin_amdgcn_mfma_f32_32x32x16_bf16(pa3, AT_PK(f.l[1][3], f.h[1][3]), o[1], 0, 0, 0);
#undef AT_PK
}
__device__ __forceinline__ float max3_(float a, float b, float c) { float r; asm("v_max3_f32 %0, %1, %2, %3" : "=v"(r) : "v"(a), "v"(b), "v"(c)); return r; }
__device__ __forceinline__ float rowmax32_fast(const f32x16& p0, const f32x16& p1) {
  float a = max3_(p0[0], p0[1], p1[0]), b = max3_(p0[2], p0[3], p1[1]); a = max3_(a, p1[2], p1[3]);
#pragma unroll
  for (int r = 4; r < 16; r += 4) { a = max3_(a, p0[r], p0[r + 1]); b = max3_(b, p0[r + 2], p0[r + 3]); a = max3_(a, p1[r], p1[r + 1]); b = max3_(b, p1[r + 2], p1[r + 3]); }
  return max3_(a, b, b);
}
__device__ __forceinline__ void softmax_seg(f32x16& p0, f32x16& p1, float& m_reg, f32x16& negm, float& l_reg, f32x16* o, float* al_l, int r32, int hi, bool first,
                                            bf16x8& pa0, bf16x8& pa1, bf16x8& pa2, bf16x8& pa3) {
  const float pm_ = rowmax32_fast(p0, p1);
  float alpha = 1.f;
  if (first || !__builtin_expect(__all(pm_ <= THR), 1)) {
    auto rm_ = __builtin_amdgcn_permlane32_swap(__float_as_uint(pm_), __float_as_uint(pm_), false, false);
    const float pmax = fmaxf(__uint_as_float(rm_[0]), __uint_as_float(rm_[1]));
    const float dl = first ? pmax : fmaxf(pmax, 0.f);
    m_reg += dl; alpha = first ? 0.f : __builtin_amdgcn_exp2f(-dl);
#pragma unroll
    for (int r = 0; r < 16; ++r) { p0[r] -= dl; p1[r] -= dl; negm[r] = -m_reg; }
    if (!first) { if (hi == 0) al_l[r32] = alpha; asm volatile("s_waitcnt lgkmcnt(0)" ::: "memory");
#pragma unroll
      for (int d = 0; d < 2; ++d)
#pragma unroll
        for (int r = 0; r < 16; ++r) o[d][r] *= al_l[crow(r, hi)]; }
  }
#pragma unroll
  for (int r = 0; r < 16; ++r) p0[r] = __builtin_amdgcn_exp2f(p0[r]);
#pragma unroll
  for (int r = 0; r < 16; ++r) p1[r] = __builtin_amdgcn_exp2f(p1[r]);
  float ps = 0;
#pragma unroll
  for (int r = 0; r < 16; ++r) ps += p0[r];
#pragma unroll
  for (int r = 0; r < 16; ++r) ps += p1[r];
  l_reg = l_reg * alpha + ps;
#define AT_PK4(P, BASE, OUT) do { unsigned a0 = cvtpk(P[BASE + 0], P[BASE + 1]), a1 = cvtpk(P[BASE + 2], P[BASE + 3]);   \
    unsigned b0 = cvtpk(P[BASE + 4], P[BASE + 5]), b1 = cvtpk(P[BASE + 6], P[BASE + 7]);                              \
    auto r0 = __builtin_amdgcn_permlane32_swap(a0, b0, false, false); auto r1 = __builtin_amdgcn_permlane32_swap(a1, b1, false, false); \
    u32x4 w = {r0[0], r1[0], r0[1], r1[1]}; OUT = *reinterpret_cast<bf16x8*>(&w); } while (0)
  AT_PK4(p0, 0, pa0); AT_PK4(p0, 8, pa1); AT_PK4(p1, 0, pa2); AT_PK4(p1, 8, pa3);
#undef AT_PK4
}
template <int VAR> __device__ __forceinline__ void attn_unit_st(const bf16_t* __restrict__ Qb, const bf16_t* __restrict__ Kh, const bf16_t* __restrict__ Vh, int seq,
                                          bf16_t* __restrict__ Ob, int o_pitch, const bf16_t* __restrict__ GA, int ga_pitch, char* lds, LAS unsigned char* L3) {
  int tid_ = TIDX; asm volatile("" : "+v"(tid_));
  const int tid = tid_, lane = tid & 63, r32 = lane & 31, hi = lane >> 5; const int wid = __builtin_amdgcn_readfirstlane(tid >> 6);
  const bool grpA = wid < 4;
  float* ws = (float*)(lds + LDS_WS) + wid * 64; float* li_l = ws; float* al_l = ws + 32;
  float m_reg = 0.f, l_reg = 0; f32x16 o[2] = {}; bf16x8 qr[6]; f32x16 negm = {}; VFrag vf; f32x16 p0 = {}, p1 = {}; bf16x8 pa0 = {}, pa1 = {}, pa2 = {}, pa3 = {};
  int koff0, koff1, voff;
  { const int s0 = 64 * wid + lane, row0 = s0 / 13, c0 = s0 - row0 * 13; koff0 = row0 * 192 + (c0 < 12 ? c0 : 0) * 16;
    const int s1 = s0 + 512, row1 = s1 / 13, c1 = s1 - row1 * 13; koff1 = row1 * 192 + (c1 < 12 ? c1 : 0) * 16;
    const int sub = s0 >> 5, kk = (sub >> 1) * 8 + ((s0 & 31) >> 2), k = (kk & ~0xC) | ((kk & 4) << 1) | ((kk & 8) >> 1), c = (sub & 1) * 32 + (s0 & 3) * 8; voff = k * 128 + c * 2; }
  const bool k2 = wid < 5;
  const __amdgpu_buffer_rsrc_t rsK = __builtin_amdgcn_make_buffer_rsrc((void*)Kh, 0, 0x7ffffff0, 0x00020000), rsV = __builtin_amdgcn_make_buffer_rsrc((void*)Vh, 0, 0x7ffffff0, 0x00020000);
#define AT_DMA(t) do { const int so_ = ((t) & 3) * SLOT_B; \
    __builtin_amdgcn_raw_ptr_buffer_load_lds(rsK, (LAS void*)(L3 + so_ + wid * 1024), 16, koff0, (t) * (64 * 192), 0, 0); \
    if (k2) __builtin_amdgcn_raw_ptr_buffer_load_lds(rsK, (LAS void*)(L3 + so_ + (wid + 8) * 1024), 16, koff1, (t) * (64 * 192), 0, 0); \
    __builtin_amdgcn_raw_ptr_buffer_load_lds(rsV, (LAS void*)(L3 + so_ + SLOT_KB + wid * 1024), 16, voff, (t) * (64 * 128), 0, 0); } while (0)
#define AT_WAITBAR(n) do { if (k2) asm volatile("s_waitcnt vmcnt(" #n "*3) lgkmcnt(0)" ::: "memory"); else asm volatile("s_waitcnt vmcnt(" #n "*2) lgkmcnt(0)" ::: "memory"); AT_SBAR(); __builtin_amdgcn_s_barrier(); AT_SBAR(); } while (0)
#define AT_BAR() do { AT_SBAR(); __builtin_amdgcn_s_barrier(); AT_SBAR(); } while (0)
  const int NTL = seq / KVBLK;
  const bf16_t* Qw = Qb + (long)(wid * QBLK + r32) * DQK + hi * 8;
#pragma unroll
  for (int d0 = 0; d0 < 6; ++d0) qr[d0] = *reinterpret_cast<const bf16x8*>(Qw + d0 * 16);
  AT_DMA(0); AT_DMA(1);
  const int kb = r32 * KROWB + hi * 16;
  const int vb0 = (int)(uintptr_t)lds + SLOT_KB + v_rd_base(lane);
#define AT_SEG_M(t) do { const char* ks_ = lds + ((t) & 3) * SLOT_B + kb; bf16x8 kf0[6], kf1[6]; \
    _Pragma("unroll") for (int d0 = 0; d0 < 6; ++d0) { kf0[d0] = *reinterpret_cast<const bf16x8*>(ks_ + d0 * 32); kf1[d0] = *reinterpret_cast<const bf16x8*>(ks_ + 32 * KROWB + d0 * 32); } \
    AT_SBAR(); __builtin_amdgcn_s_setprio(1); if ((t) >= 1) pv_mma_nw(o, vf, pa0, pa1, pa2, pa3); \
    p0 = __builtin_amdgcn_mfma_f32_32x32x16_bf16(kf0[0], qr[0], negm, 0, 0, 0); p1 = __builtin_amdgcn_mfma_f32_32x32x16_bf16(kf1[0], qr[0], negm, 0, 0, 0); \
    _Pragma("unroll") for (int d0 = 1; d0 < 6; ++d0) { p0 = __builtin_amdgcn_mfma_f32_32x32x16_bf16(kf0[d0], qr[d0], p0, 0, 0, 0); p1 = __builtin_amdgcn_mfma_f32_32x32x16_bf16(kf1[d0], qr[d0], p1, 0, 0, 0); } __builtin_amdgcn_s_setprio(0); } while (0)
#define AT_SEG_V(t) do { vfrag_issue(vf, vb0 + ((t) & 3) * SLOT_B); AT_SBAR(); \
    softmax_seg(p0, p1, m_reg, negm, l_reg, o, al_l, r32, hi, (t) == 0, pa0, pa1, pa2, pa3); asm volatile("s_waitcnt lgkmcnt(0)" ::: "memory"); } while (0)
  if (k2) asm volatile("s_waitcnt vmcnt(3)" ::: "memory"); else asm volatile("s_waitcnt vmcnt(2)" ::: "memory");
  AT_BAR();
  if (!grpA) AT_BAR();
  for (int t = 0; t < NTL; ++t) {
    if (t + 2 < NTL) AT_DMA(t + 2);
    AT_SEG_M(t);
    if (t + 2 < NTL) AT_WAITBAR(1); else AT_WAITBAR(0);
    AT_SEG_V(t);
    AT_BAR();
  }
  pv_mma_nw(o, vf, pa0, pa1, pa2, pa3);
  if (grpA) AT_BAR();
  { auto rr = __builtin_amdgcn_permlane32_swap(__float_as_uint(l_reg), __float_as_uint(l_reg), false, false); l_reg = __uint_as_float(rr[0]) + __uint_as_float(rr[1]); }
  if (hi == 0) li_l[r32] = l_reg; asm volatile("s_waitcnt lgkmcnt(0)" ::: "memory");
  float rli[16];
#pragma unroll
  for (int r = 0; r < 16; ++r) rli[r] = __builtin_amdgcn_rcpf(li_l[crow(r, hi)]);
#pragma unroll
  for (int r = 0; r < 16; ++r) { const int orow = wid * QBLK + crow(r, hi);
#pragma unroll
    for (int d0 = 0; d0 < 2; ++d0) { const float ga = bf2f(GA[(long)orow * ga_pitch + d0 * 32 + r32]);
      Ob[(long)orow * o_pitch + d0 * 32 + r32] = f2bf(o[d0][r] * rli[r] * (ga * __builtin_amdgcn_rcpf(1.f + __expf(-ga)))); } }
  asm volatile("s_waitcnt vmcnt(0) lgkmcnt(0)" ::: "memory"); __builtin_amdgcn_s_barrier();
#undef AT_DMA
#undef AT_WAITBAR
#undef AT_BAR
#undef AT_SEG_M
#undef AT_SEG_V
}
#undef AT_KSWZ
#undef AT_SBAR
}


namespace ssd {
using attn::bf16x8; using attn::s16x4; using attn::f32x16; using attn::u32x4;
constexpr int LC = 128, NCH = 66;
constexpr int L_X = 0, L_B = 65536, L_C = 81920, L_CS = 98304, L_DT = L_CS + 4096, L_SC = L_DT + 4096;
constexpr float LOG2E = 1.4426950408889634f;
__device__ __forceinline__ int rimg(int row, int c) { return row * 128 + ((c ^ (row & 7)) << 4); }
__device__ __forceinline__ int chunk_row(int b, int c) { return c < 2 ? ML + b * CTXL + c * LC : b * SEQ + (c - 2) * LC; }
__device__ __forceinline__ float bfbits2f(short v) { return __uint_as_float(((unsigned)(unsigned short)v) << 16); }
template <bool STEP3> __device__ __forceinline__ float load_chunk(const bf16_t* __restrict__ U, const float* __restrict__ DTS, const float* __restrict__ a_log, int rowbase, int g, char* lds) {
    int tid_ = TIDX; asm volatile("" : "+v"(tid_)); const int tid = tid_;
    constexpr int NLD = STEP3 ? 12 : 10, NB2 = NLD / 2;
#pragma unroll
    for (int hb = 0; hb < 2; ++hb) {
        bf16x8 stg[NB2];
#pragma unroll
        for (int q = 0; q < NB2; ++q) { const int it = hb * NB2 + q; const int i = tid + it * NT;
            if (it < 8) { const int s = i >> 5, cc = i & 31; stg[q] = *(const bf16x8*)(U + (size_t)(rowbase + s) * 768 + g * 256 + cc * 8); }
            else if (it < 10) { const int j = i - 4096, s = j >> 3, c = j & 7; stg[q] = *(const bf16x8*)(U + (size_t)(rowbase + s) * 768 + 512 + g * 64 + c * 8); }
            else { const int j = i - 5120, s = j >> 3, c = j & 7; stg[q] = *(const bf16x8*)(U + (size_t)(rowbase + s) * 768 + 640 + g * 64 + c * 8); } }
#pragma unroll
        for (int q = 0; q < NB2; ++q) { const int it = hb * NB2 + q; const int i = tid + it * NT;
            if (it < 8) { const int s = i >> 5, cc = i & 31, hh = cc >> 3, c8 = (cc & 7) * 8; *(bf16x8*)(lds + L_X + hh * 16384 + attn::v_st(s, c8)) = stg[q]; }
            else if (it < 10) { const int j = i - 4096, s = j >> 3, c = j & 7; *(bf16x8*)(lds + L_B + (STEP3 ? rimg(s, c) : attn::v_st(s, c * 8))) = stg[q]; }
            else { const int j = i - 5120, s = j >> 3, c = j & 7; *(bf16x8*)(lds + L_C + rimg(s, c)) = stg[q]; } }
    }
    const int w = tid >> 6, lane = tid & 63, d = w >> 2, hh = w & 3, h = g * 4 + hh;
    const float A2 = -__expf(a_log[d * 8 + h]) * LOG2E;
    const int s0 = d ? 127 - lane : lane, s1 = d ? 63 - lane : 64 + lane;
    const float dt0 = DTS[(size_t)(rowbase + s0) * 16 + d * 8 + h], dt1 = DTS[(size_t)(rowbase + s1) * 16 + d * 8 + h];
    float x0 = dt0 * A2, x1 = dt1 * A2;
    { int ln = lane; asm volatile("" : "+v"(ln));
#pragma unroll
      for (int off = 1; off < 64; off <<= 1) { const int src = (ln - off) << 2;
          const float t0 = __int_as_float(__builtin_amdgcn_ds_bpermute(src, __float_as_int(x0))), t1 = __int_as_float(__builtin_amdgcn_ds_bpermute(src, __float_as_int(x1)));
          if (ln >= off) { x0 += t0; x1 += t1; } } }
    x1 += __int_as_float(__builtin_amdgcn_readlane(__float_as_int(x0), 63)); const float T = __int_as_float(__builtin_amdgcn_readlane(__float_as_int(x1), 63));
    float* CS = (float*)(lds + L_CS) + w * 128; float* DTL = (float*)(lds + L_DT) + w * 128; float* SC = (float*)(lds + L_SC) + w * 128;
    CS[s0] = x0; CS[s1] = x1; DTL[s0] = dt0; DTL[s1] = dt1;
    if (STEP3) { SC[s0] = exp2f(x0); SC[s1] = exp2f(x1); } else { SC[s0] = dt0 * exp2f(T - x0); SC[s1] = dt1 * exp2f(T - x1); }
    return T;
}
#define SSD_SBAR() __builtin_amdgcn_sched_barrier(0)
template <int KS> __device__ __forceinline__ void st1_step(f32x16 (&acc)[2][2], int vbx, int vbb, const float* SCw, int hi) {
    typedef float f32x4v __attribute__((ext_vector_type(4)));
    const f32x4v sA = *(const f32x4v*)(SCw + 16 * KS + 8 * hi), sB = *(const f32x4v*)(SCw + 16 * KS + 8 * hi + 4);
    const s16x4 xl0 = attn::tr_read<attn::v_rd_off(0, KS, 0)>(vbx), xh0 = attn::tr_read<attn::v_rd_off(0, KS, 1)>(vbx);
    const s16x4 xl1 = attn::tr_read<attn::v_rd_off(1, KS, 0)>(vbx), xh1 = attn::tr_read<attn::v_rd_off(1, KS, 1)>(vbx);
    const s16x4 bl0 = attn::tr_read<attn::v_rd_off(0, KS, 0)>(vbb), bh0 = attn::tr_read<attn::v_rd_off(0, KS, 1)>(vbb);
    const s16x4 bl1 = attn::tr_read<attn::v_rd_off(1, KS, 0)>(vbb), bh1 = attn::tr_read<attn::v_rd_off(1, KS, 1)>(vbb);
    asm volatile("s_waitcnt lgkmcnt(0)" ::: "memory"); SSD_SBAR();
#define SSD_SCL(L, H) ({ u32x4 w_; w_.x = attn::cvtpk(bfbits2f(L[0]) * sA[0], bfbits2f(L[1]) * sA[1]); w_.y = attn::cvtpk(bfbits2f(L[2]) * sA[2], bfbits2f(L[3]) * sA[3]); \
        w_.z = attn::cvtpk(bfbits2f(H[0]) * sB[0], bfbits2f(H[1]) * sB[1]); w_.w = attn::cvtpk(bfbits2f(H[2]) * sB[2], bfbits2f(H[3]) * sB[3]); *reinterpret_cast<bf16x8*>(&w_); })
#define SSD_PK(L, H) (bf16x8){L[0], L[1], L[2], L[3], H[0], H[1], H[2], H[3]}
    const bf16x8 a0 = SSD_SCL(xl0, xh0), a1 = SSD_SCL(xl1, xh1), b0 = SSD_PK(bl0, bh0), b1 = SSD_PK(bl1, bh1);
    acc[0][0] = __builtin_amdgcn_mfma_f32_32x32x16_bf16(a0, b0, acc[0][0], 0, 0, 0); acc[0][1] = __builtin_amdgcn_mfma_f32_32x32x16_bf16(a0, b1, acc[0][1], 0, 0, 0);
    acc[1][0] = __builtin_amdgcn_mfma_f32_32x32x16_bf16(a1, b0, acc[1][0], 0, 0, 0); acc[1][1] = __builtin_amdgcn_mfma_f32_32x32x16_bf16(a1, b1, acc[1][1], 0, 0, 0);
#undef SSD_SCL
}
__device__ __forceinline__ void states_item(const bf16_t* U, const float* DTS, const float* a_log, bf16_t* SST, float* CD, int b, int c, int g, char* lds) {
    const float T = load_chunk<false>(U, DTS, a_log, chunk_row(b, c), g, lds);
    __syncthreads();
    const int tid = TIDX, w = tid >> 6, lane = tid & 63, r32 = lane & 31, hi = lane >> 5, d = w >> 2, hh = w & 3, h = g * 4 + hh;
    const int vbx = (int)(uintptr_t)(lds + L_X + hh * 16384) + attn::v_rd_base(lane), vbb = (int)(uintptr_t)(lds + L_B) + attn::v_rd_base(lane);
    const float* SCw = (const float*)(lds + L_SC) + w * 128;
    f32x16 acc[2][2] = {};
    st1_step<0>(acc, vbx, vbb, SCw, hi); st1_step<1>(acc, vbx, vbb, SCw, hi); st1_step<2>(acc, vbx, vbb, SCw, hi); st1_step<3>(acc, vbx, vbb, SCw, hi);
    st1_step<4>(acc, vbx, vbb, SCw, hi); st1_step<5>(acc, vbx, vbb, SCw, hi); st1_step<6>(acc, vbx, vbb, SCw, hi); st1_step<7>(acc, vbx, vbb, SCw, hi);
    const size_t cidx = (((size_t)b * NCH + c) * 2 + d) * 8 + h;
    bf16_t* So = SST + cidx * 4096;
#pragma unroll
    for (int pb = 0; pb < 2; ++pb)
#pragma unroll
        for (int nb = 0; nb < 2; ++nb)
#pragma unroll
            for (int r = 0; r < 16; ++r) So[(pb * 32 + attn::crow(r, hi)) * 64 + nb * 32 + r32] = f2bf(acc[pb][nb][r]);
    if (lane == 0) CD[cidx] = exp2f(T);
    __syncthreads();
}
__device__ __forceinline__ void out_item(const bf16_t* U, const float* DTS, const float* a_log, const bf16_t* HIN, bf16_t* Y, int b, int j, int g, char* lds) {
    typedef float f32x4v __attribute__((ext_vector_type(4)));
    const int rowbase = b * SEQ + j * LC, c = j + 2;
    int tid_ = TIDX; asm volatile("" : "+v"(tid_));
    const int tid = tid_, w = tid >> 6, lane = tid & 63, r32 = lane & 31, hi = lane >> 5, hh = w & 3, lp = w >> 2, h = g * 4 + hh;
    bf16x8 hbn[4][2];
#define SSD_HLOAD(dd) do { const bf16_t* Hp_ = HIN + ((((size_t)b * NCH + c) * 2 + (dd)) * 8 + h) * 4096; \
    _Pragma("unroll") for (int ks = 0; ks < 4; ++ks) { const bf16_t* h0 = Hp_ + r32 * 64 + ks * 16 + hi * 8; hbn[ks][0] = *(const bf16x8*)h0; hbn[ks][1] = *(const bf16x8*)(h0 + 32 * 64); } } while (0)
    SSD_HLOAD(0);
    (void)load_chunk<true>(U, DTS, a_log, rowbase, g, lds);
    __syncthreads();
    const char* BR = lds + L_B; const char* CR = lds + L_C;
    const int vbx = (int)(uintptr_t)(lds + L_X + hh * 16384) + attn::v_rd_base(lane);
#pragma unroll
    for (int lti = 0; lti < 2; ++lti) { const int lt = 2 * lp + lti, l = 32 * lt + r32;
        f32x16 y0 = {}, y1 = {};
#pragma unroll
        for (int d = 0; d < 2; ++d) { const int combo = d * 4 + hh;
            const float* CSw = (const float*)(lds + L_CS) + combo * 128; const float* DTw = (const float*)(lds + L_DT) + combo * 128; const float* ELw = (const float*)(lds + L_SC) + combo * 128;
            f32x16 t0 = {}, t1 = {};
            bf16x8 hb[4][2];
#pragma unroll
            for (int ks = 0; ks < 4; ++ks) { hb[ks][0] = hbn[ks][0]; hb[ks][1] = hbn[ks][1]; }
            if (!(lti == 1 && d == 1)) SSD_HLOAD(1 - d);
#pragma unroll
            for (int ks = 0; ks < 4; ++ks) { const bf16x8 A = *(const bf16x8*)(CR + rimg(l, 2 * ks + hi));
                t0 = __builtin_amdgcn_mfma_f32_32x32x16_bf16(A, hb[ks][0], t0, 0, 0, 0);
                t1 = __builtin_amdgcn_mfma_f32_32x32x16_bf16(A, hb[ks][1], t1, 0, 0, 0); }
#pragma unroll
            for (int k4 = 0; k4 < 4; ++k4) { const f32x4v fv = *(const f32x4v*)(ELw + 32 * lt + 4 * hi + 8 * k4);
#pragma unroll
                for (int i = 0; i < 4; ++i) { t0[4 * k4 + i] *= fv[i]; t1[4 * k4 + i] *= fv[i]; } }
            const float fl = CSw[l];
#pragma unroll
            for (int st = 0; st < 2; ++st) {
                const bool need = d == 0 ? (64 * st <= 32 * lt + 31) : (64 * st + 63 >= 32 * lt);
                if (need) {
                    f32x16 p0 = {}, p1 = {};
#pragma unroll
                    for (int ks = 0; ks < 4; ++ks) { const bf16x8 q = *(const bf16x8*)(CR + rimg(l, 2 * ks + hi));
                        const bf16x8 b0 = *(const bf16x8*)(BR + rimg(64 * st + r32, 2 * ks + hi)), b1 = *(const bf16x8*)(BR + rimg(64 * st + 32 + r32, 2 * ks + hi));
                        p0 = __builtin_amdgcn_mfma_f32_32x32x16_bf16(b0, q, p0, 0, 0, 0); p1 = __builtin_amdgcn_mfma_f32_32x32x16_bf16(b1, q, p1, 0, 0, 0); }
#pragma unroll
                    for (int k4 = 0; k4 < 4; ++k4) {
                        const int sb = 64 * st + 8 * k4 + 4 * hi;
                        const f32x4v c0v = *(const f32x4v*)(CSw + sb), c1v = *(const f32x4v*)(CSw + sb + 32), d0v = *(const f32x4v*)(DTw + sb), d1v = *(const f32x4v*)(DTw + sb + 32);
#pragma unroll
                        for (int i = 0; i < 4; ++i) { const int r = 4 * k4 + i, s0 = sb + i, s1 = s0 + 32;
                            const bool m0 = d == 0 ? (s0 <= l) : (s0 >= l), m1 = d == 0 ? (s1 <= l) : (s1 >= l);
                            p0[r] = m0 ? p0[r] * (__builtin_amdgcn_exp2f(fl - c0v[i]) * d0v[i]) : 0.f; p1[r] = m1 ? p1[r] * (__builtin_amdgcn_exp2f(fl - c1v[i]) * d1v[i]) : 0.f; }
                        asm volatile("" ::: "memory"); }
                    bf16x8 pa0, pa1, pa2, pa3;
#define SSD_PK4(P, BASE, OUT) do { unsigned a0 = attn::cvtpk(P[BASE + 0], P[BASE + 1]), a1 = attn::cvtpk(P[BASE + 2], P[BASE + 3]);   \
    unsigned b0_ = attn::cvtpk(P[BASE + 4], P[BASE + 5]), b1_ = attn::cvtpk(P[BASE + 6], P[BASE + 7]);                              \
    auto r0 = __builtin_amdgcn_permlane32_swap(a0, b0_, false, false); auto r1 = __builtin_amdgcn_permlane32_swap(a1, b1_, false, false); \
    u32x4 w_ = {r0[0], r1[0], r0[1], r1[1]}; OUT = *reinterpret_cast<bf16x8*>(&w_); } while (0)
                    SSD_PK4(p0, 0, pa0); SSD_PK4(p0, 8, pa1); SSD_PK4(p1, 0, pa2); SSD_PK4(p1, 8, pa3);
#undef SSD_PK4
                    SSD_SBAR();
                    attn::pv_one<0>(t0, vbx + st * 8192, pa0, pa1, pa2, pa3); attn::pv_one<1>(t1, vbx + st * 8192, pa0, pa1, pa2, pa3);
                }
            }
            y0 += t0; y1 += t1;
        }
#pragma unroll
        for (int r = 0; r < 16; ++r) { bf16_t* yr = Y + (size_t)(rowbase + 32 * lt + attn::crow(r, hi)) * 512 + h * 64 + r32; yr[0] = f2bf(y0[r]); yr[32] = f2bf(y1[r]); }
    }
    __syncthreads();
#undef SSD_HLOAD
}
#undef SSD_PK
#undef SSD_SBAR
}

struct Ptrs {
    const float *x, *c, *ctx, *c_ctx, *mod_w, *mod_b, *norm_w, *w_in_mix, *q_norm, *w_uq, *kv_norm, *w_ukv, *conv_w, *conv_b, *a_log, *dt_bias, *d_skip, *ssd_norm,
        *w_out_mix, *w_in_pool, *pool_lin, *pool_scale, *w_out_pool, *final_norm;
    float* out; char* ws;
};


__device__ __forceinline__ unsigned pk2(float lo, float hi) { return (unsigned)f2bf(lo) | ((unsigned)f2bf(hi) << 16); }
typedef unsigned v4u __attribute__((ext_vector_type(4)));
__device__ __forceinline__ void tr_item(const float* W, int ldw, int Nsrc, int K, bf16_t* WT, int row_off, const float* kscale, int ks_off, const float* nscale, float gscale,
                                        LAS float* scr, int item, int nblk, int lane) {
    const int kb = item / nblk, nb = item % nblk, k0 = 64 * kb, n0 = 32 * nb;
    const int n4 = n0 + 4 * (lane & 7); const bool nin = n4 < Nsrc;
    f32x4 ns = {gscale, gscale, gscale, gscale};
    if (nscale && nin) { const f32x4 t = *(const f32x4*)(nscale + n4); ns = t * gscale; }
#pragma unroll
    for (int i = 0; i < 8; ++i) { const int kk = 8 * i + (lane >> 3);
        f32x4 w = nin ? *(const f32x4*)(W + (size_t)(k0 + kk) * ldw + n4) : (f32x4){0.f, 0.f, 0.f, 0.f};
        if (kscale && (k0 + kk) >= ks_off) w = w * kscale[k0 + kk - ks_off];
        w = w * ns;
        LAS float* d = scr + kk * 33 + 4 * (lane & 7); d[0] = w[0]; d[1] = w[1]; d[2] = w[2]; d[3] = w[3]; }
    asm volatile("s_waitcnt lgkmcnt(0)" ::: "memory");
    const int c = lane & 7;
#pragma unroll
    for (int j = 0; j < 4; ++j) { const int n = (lane >> 3) + 8 * j; const LAS float* sp = scr + (8 * c) * 33 + n;
        v4u o; o.x = pk2(sp[0 * 33], sp[1 * 33]); o.y = pk2(sp[2 * 33], sp[3 * 33]); o.z = pk2(sp[4 * 33], sp[5 * 33]); o.w = pk2(sp[6 * 33], sp[7 * 33]);
        *(v4u*)(WT + (size_t)(row_off + n0 + n) * K + k0 + 8 * c) = o; }
    asm volatile("s_waitcnt lgkmcnt(0)" ::: "memory");
}
__device__ __forceinline__ void ph_weights(const Ptrs& P, LAS unsigned char* L) {
    const int lane = TIDX & 63, wv = TIDX >> 6;
    LAS float* scr = (LAS float*)(L + wv * 16384);
    const int gw = blockIdx.x * (NT / 64) + wv, NGW = gridDim.x * (NT / 64);
    constexpr int I1 = 16 * 80, I2 = 6 * 24, I3 = 4 * 32, I4 = 16 * 32, I5 = 16 * 64, I6 = 4 * 32, I7 = 16 * 32;
    for (int it = gw; it < I1 + I2 + I3 + I4 + I5 + I6 + I7; it += NGW) {
        int r = it;
        if (r < I1) { tr_item(P.w_in_mix, 2480, 2480, 1024, (bf16_t*)(P.ws + WS_WT1), 0, nullptr, 0, nullptr, 1.f, scr, r, 80, lane); continue; } r -= I1;
        if (r < I2) { tr_item(P.w_uq, 768, 768, 384, (bf16_t*)(P.ws + WS_WTQ), 0, P.q_norm, 0, nullptr, QSCALE, scr, r, 24, lane); continue; } r -= I2;
        if (r < I3) { tr_item(P.w_ukv, 1024, 1024, 256, (bf16_t*)(P.ws + WS_WTKV), 0, P.kv_norm, 0, nullptr, 1.f, scr, r, 32, lane); continue; } r -= I3;
        if (r < I4) { tr_item(P.w_out_mix, 1024, 1024, 1024, (bf16_t*)(P.ws + WS_WTO), 0, P.ssd_norm, 512, nullptr, 1.f, scr, r, 32, lane); continue; } r -= I4;
        if (r < I5) { tr_item(P.w_in_pool, 2048, 2048, 1024, (bf16_t*)(P.ws + WS_WTP), 0, nullptr, 0, nullptr, 1.f, scr, r, 64, lane); continue; } r -= I5;
        if (r < I6) { const int g = r / 32; tr_item(P.pool_lin + (size_t)g * 65536, 256, 256, 256, (bf16_t*)(P.ws + WS_WTL), g * 256, nullptr, 0, P.pool_scale + g * 256, 1.f, scr, r % 32, 8, lane); continue; } r -= I6;
        tr_item(P.w_out_pool, 1024, 1024, 1024, (bf16_t*)(P.ws + WS_WTOP), 0, nullptr, 0, nullptr, 1.f, scr, r, 32, lane);
    }
}

__device__ __forceinline__ void ph_modvec(const Ptrs& P, LAS unsigned char* L) {
    float* modv = (float*)(P.ws + WS_MODV);
    LAS float* sv = (LAS float*)L;
    LAS float* red = (LAS float*)(L + 20480);
    const int tid = TIDX;
    for (int i = tid; i < 5 * 1024; i += NT) { const int v = i >> 10, k = i & 1023; sv[i] = siluf(v < 4 ? P.c[v * 1024 + k] : P.c_ctx[k]); }
    __syncthreads();
    for (int it = blockIdx.x; it < 2 * 128; it += gridDim.x) {
        const int layer = it >> 7, col0 = (it & 127) * 24;
        if (tid < 384) { const int c4 = tid % 6, kg = tid / 6;
            const float* wp = P.mod_w + ((size_t)layer * 1024 + kg * 16) * 3072 + col0 + c4 * 4;
            f32x4 w[16];
#pragma unroll
            for (int r = 0; r < 16; ++r) w[r] = *(const f32x4*)(wp + (size_t)r * 3072);
            f32x4 acc[5];
#pragma unroll
            for (int v = 0; v < 5; ++v) acc[v] = (f32x4){0.f, 0.f, 0.f, 0.f};
#pragma unroll
            for (int r = 0; r < 16; ++r)
#pragma unroll
                for (int v = 0; v < 5; ++v) acc[v] += w[r] * sv[v * 1024 + kg * 16 + r];
#pragma unroll
            for (int v = 0; v < 5; ++v) { LAS float* d = red + (kg * 5 + v) * 24 + c4 * 4; d[0] = acc[v][0]; d[1] = acc[v][1]; d[2] = acc[v][2]; d[3] = acc[v][3]; }
        }
        __syncthreads();
        if (tid < 120) { const int v = tid / 24, cc = tid % 24; float a = 0.f;
#pragma unroll 8
            for (int kg = 0; kg < 64; ++kg) a += red[(kg * 5 + v) * 24 + cc];
            modv[(layer * 5 + v) * 3072 + col0 + cc] = a + P.mod_b[layer * 3072 + col0 + cc]; }
        __syncthreads();
    }
    float* COS = (float*)(P.ws + WS_COS); float* SIN = (float*)(P.ws + WS_SIN);
    GSTRIDE(idx, SEQ * 16) {
        int t = (int)(idx / 16), j = (int)(idx % 16);
        float pos = (float)(j < 8 ? t / 64 : t % 64);
        float invf = 1.0f / powf(10000.0f, (float)(2 * (j & 7)) / 16.0f);
        float ang = pos * invf;
        COS[idx] = cosf(ang); SIN[idx] = sinf(ang);
    }
}
template <bool HAS_CTX> __device__ __forceinline__ void ph_norm_mod(const float* xl, const float* ctx, int nrows, const float* norm_w, const float* modv, bf16_t* H) {
    const int tid = TIDX, lane = tid & 63, gw = blockIdx.x * (NT / 64) + (tid >> 6), NGW = gridDim.x * (NT / 64);
    f32x4 nw[4];
#pragma unroll
    for (int j = 0; j < 4; ++j) nw[j] = *(const f32x4*)(norm_w + 4 * lane + 256 * j);
#define NM_SRC(r) ((!HAS_CTX || (r) < ML) ? xl + (size_t)(r) * DM : ctx + (size_t)((r) - ML) * DM)
    int vc = -1; f32x4 scv[4], shv[4];
    for (int row = 2 * gw; row < nrows; row += 2 * NGW) {
        f32x4 xv[2][4];
#pragma unroll
        for (int q = 0; q < 2; ++q) { const float* src = NM_SRC(row + q);
#pragma unroll
            for (int j = 0; j < 4; ++j) xv[q][j] = *(const f32x4*)(src + 4 * lane + 256 * j); }
        { const int v = (!HAS_CTX || row < ML) ? row / SEQ : 4;
          if (v != vc) { vc = v;
#pragma unroll
              for (int j = 0; j < 4; ++j) { const int k = 4 * lane + 256 * j; shv[j] = *(const f32x4*)(modv + v * 3072 + k); scv[j] = *(const f32x4*)(modv + v * 3072 + 1024 + k) + 1.f; } } }
#pragma unroll
        for (int q = 0; q < 2; ++q) { const int r = row + q; float ss = 0.f;
#pragma unroll
            for (int j = 0; j < 4; ++j) ss += (xv[q][j].x * xv[q][j].x + xv[q][j].y * xv[q][j].y) + (xv[q][j].z * xv[q][j].z + xv[q][j].w * xv[q][j].w);
            ss = wave_sum(ss);
            const float rstd = rsqrtf(ss * (1.f / DM) + RMS_EPS);
#pragma unroll
            for (int j = 0; j < 4; ++j) { const int k = 4 * lane + 256 * j;
                const f32x4 o = xv[q][j] * rstd * nw[j] * scv[j] + shv[j];
                uint2 w; w.x = pk2f(o.x, o.y); w.y = pk2f(o.z, o.w);
                *(uint2*)(H + (size_t)r * DM + k) = w; } }
    }
#undef NM_SRC
}
template <int RT, class Epi>
__device__ __forceinline__ void ph_gemm(const bf16_t* A, int lda, const float* W, int ldw, int M, int N, int K, const float* kscale, int ks_off, const Epi& E) {
    const int ncb = (N + NT - 1) / NT, nitems = ncb * (M / RT);
    for (int it = blockIdx.x; it < nitems; it += gridDim.x) {
        const int cb = it % ncb, rg = it / ncb; const int col = cb * NT + TIDX, row0 = rg * RT;
        float acc[RT];
#pragma unroll
        for (int r = 0; r < RT; ++r) acc[r] = 0.f;
        if (col < N) {
            for (int k = 0; k < K; ++k) {
                float w = W[(size_t)k * ldw + col];
                if (kscale && k >= ks_off) w *= kscale[k - ks_off];
#pragma unroll
                for (int r = 0; r < RT; ++r) acc[r] += bf2f(A[(size_t)(row0 + r) * lda + k]) * w;
            }
#pragma unroll
            for (int r = 0; r < RT; ++r) E(row0 + r, col, acc[r]);
        }
    }
}
struct EpiProj { bf16_t* P; float* DT;
    __device__ void operator()(int row, int col, float a) const { P[(size_t)row * PN + col] = f2bf(a); if (col >= C_DT) DT[row * 16 + col - C_DT] = a; } };
struct EpiRes { const float* res; const float* gate; float* out;
    __device__ void operator()(int row, int col, float a) const { int b = row / SEQ; out[(size_t)row * DM + col] = res[(size_t)row * DM + col] + gate[b * 3072 + 2048 + col] * a; } };
struct EpiBf { bf16_t* O; int ld;
    __device__ void operator()(int row, int col, float a) const { O[(size_t)row * ld + col] = f2bf(a); } };

__device__ __forceinline__ void ph_upproj(const Ptrs& P) {
    const bf16_t* PR = (const bf16_t*)(P.ws + WS_PROJ); const float* COS = (const float*)(P.ws + WS_COS); const float* SIN = (const float*)(P.ws + WS_SIN);
    bf16_t* Q = (bf16_t*)(P.ws + WS_Q); bf16_t* Kb = (bf16_t*)(P.ws + WS_K); bf16_t* Vb = (bf16_t*)(P.ws + WS_V);
    GSTRIDE(idx, MT * 16) {
        int jj = (int)(idx % 16), row = (int)(idx / 16); int b, t; bool isctx; row_info(row, b, t, isctx); int key = isctx ? t : CTXL + t;
        float k1 = bf2f(PR[(size_t)row * PN + C_KPE + jj]), k2 = bf2f(PR[(size_t)row * PN + C_KPE + 16 + jj]);
        float o1 = k1, o2 = k2;
        if (!isctx) { float cs = COS[t * 16 + jj], sn = SIN[t * 16 + jj]; o1 = k1 * cs - k2 * sn; o2 = k2 * cs + k1 * sn; }
        for (int h = 0; h < 8; ++h) { size_t kr = (size_t)(b * 8 + h) * NKEY + key; Kb[kr * 96 + 64 + jj] = f2bf(o1); Kb[kr * 96 + 80 + jj] = f2bf(o2); }
    }
    bf16_t* U = (bf16_t*)(P.ws + WS_U);
    GSTRIDE(idx, (long)(MT / 32) * 96) {
        const int cq = (int)(idx % 96), rb = (int)(idx / 96), row0 = rb * 32; int b, t0; bool isctx; row_info(row0, b, t0, isctx); const int n = isctx ? CTXL : SEQ;
        const bf16_t* p = PR + (size_t)row0 * PN + C_XBC + cq * 8; bf16_t* uo = U + (size_t)row0 * 768 + cq * 8;
        float w0[8], w1[8], w2[8], bs[8];
#pragma unroll
        for (int i = 0; i < 8; ++i) { w0[i] = P.conv_w[cq * 8 + i]; w1[i] = P.conv_w[768 + cq * 8 + i]; w2[i] = P.conv_w[1536 + cq * 8 + i]; bs[i] = P.conv_b[cq * 8 + i]; }
        typedef unsigned v4u_ __attribute__((ext_vector_type(4)));
        v4u_ rows[34];
#pragma unroll
        for (int r = 0; r < 34; ++r) { const int t = t0 - 1 + r; rows[r] = (t >= 0 && t < n) ? *(const v4u_*)(p + (long)(r - 1) * PN) : (v4u_){0u, 0u, 0u, 0u}; }
#pragma unroll
        for (int r = 0; r < 32; ++r) { v4u_ o;
#pragma unroll
            for (int i = 0; i < 4; ++i) {
                const float a0 = __uint_as_float(rows[r][i] << 16), a1 = __uint_as_float(rows[r][i] & 0xffff0000u);
                const float c0 = __uint_as_float(rows[r + 1][i] << 16), c1 = __uint_as_float(rows[r + 1][i] & 0xffff0000u);
                const float n0 = __uint_as_float(rows[r + 2][i] << 16), n1 = __uint_as_float(rows[r + 2][i] & 0xffff0000u);
                const float v0 = bs[2 * i] + w0[2 * i] * a0 + w1[2 * i] * c0 + w2[2 * i] * n0, v1 = bs[2 * i + 1] + w0[2 * i + 1] * a1 + w1[2 * i + 1] * c1 + w2[2 * i + 1] * n1;
                o[i] = pk2(siluf(v0), siluf(v1)); }
            *(v4u_*)(uo + (size_t)r * 768) = o; }
    }
    const float* DT = (const float*)(P.ws + WS_DT); float* DTS = (float*)(P.ws + WS_DTS);
    GSTRIDE(idx, MT * 16) DTS[idx] = softplusf(DT[idx] + P.dt_bias[idx % 16]);
}
__device__ __forceinline__ void ph_ssd_states(const Ptrs& P, unsigned char* lds) {
    const bf16_t* U = (const bf16_t*)(P.ws + WS_U); const float* DTS = (const float*)(P.ws + WS_DTS);
    for (int it = blockIdx.x; it < NB * ssd::NCH * 2; it += gridDim.x) { const int b = it / (ssd::NCH * 2), rem = it % (ssd::NCH * 2);
        ssd::states_item(U, DTS, P.a_log, (bf16_t*)(P.ws + WS_SST), (float*)(P.ws + WS_CD), b, rem >> 1, rem & 1, (char*)lds); }
}
__device__ __forceinline__ void ph_ssd_chunkscan(const Ptrs& P) {
    bf16_t* SST = (bf16_t*)(P.ws + WS_SST); const float* CD = (const float*)(P.ws + WS_CD);
    GSTRIDE(idx, NB * 2 * 8 * 2048) {
        const int e2 = (int)(idx & 2047); const int bdh = __builtin_amdgcn_readfirstlane((int)(idx >> 11));
        const int h = bdh & 7, d = (bdh >> 3) & 1, b = bdh >> 4;
        unsigned Sv[ssd::NCH];
#pragma unroll
        for (int k = 0; k < ssd::NCH; ++k) { const int c = d == 0 ? k : (k < 2 ? 1 - k : 67 - k); const size_t ci = (((size_t)b * ssd::NCH + c) * 2 + d) * 8 + h; Sv[k] = *(const unsigned*)(SST + ci * 4096 + 2 * e2); }
        float h0 = 0.f, h1 = 0.f;
#pragma unroll
        for (int k = 0; k < ssd::NCH; ++k) { const int c = d == 0 ? k : (k < 2 ? 1 - k : 67 - k); const size_t ci = (((size_t)b * ssd::NCH + c) * 2 + d) * 8 + h;
            if (k >= 2) *(unsigned*)(SST + ci * 4096 + 2 * e2) = pk2f(h0, h1);
            const float dec = CD[ci];
            h0 = h0 * dec + __uint_as_float(Sv[k] << 16); h1 = h1 * dec + __uint_as_float(Sv[k] & 0xffff0000u); }
    }
}
__device__ __forceinline__ void ph_ssd_out(const Ptrs& P, unsigned char* lds);
template <int VAR> __device__ __forceinline__ void ph_attn_mfma(const Ptrs& P, unsigned char* lds) {
    const bf16_t* Q = (const bf16_t*)(P.ws + WS_Q); const bf16_t* Kb = (const bf16_t*)(P.ws + WS_K); const bf16_t* Vb = (const bf16_t*)(P.ws + WS_V);
    const bf16_t* PR = (const bf16_t*)(P.ws + WS_PROJ); bf16_t* CAT = (bf16_t*)P.out;
    const int G = gridDim.x, c = blockIdx.x; const int vcu = (G % 8 == 0) ? (c % 8) * (G / 8) + c / 8 : c;
    for (int unit = vcu; unit < NB * 8 * 32; unit += G) {
        const int bh = unit >> 5, qb = unit & 31; const int b = bh >> 3, h = bh & 7; const int row0 = b * SEQ + qb * 256;
        attn::attn_unit_st<VAR>(Q + ((size_t)bh * SEQ + qb * 256) * 96, Kb + (size_t)bh * NKEY * 96, Vb + (size_t)bh * NKEY * 64, NKEY,
                        CAT + (size_t)row0 * DM + h * 64, DM, PR + (size_t)row0 * PN + C_GA + h * 64, PN, (char*)lds, (LAS unsigned char*)lds);
    }
}

__device__ __forceinline__ void merge_rows(const Ptrs& P, int row_begin, int row_end, int gw, int NGW) {
    const bf16_t* Y = (const bf16_t*)(P.ws + WS_H); const bf16_t* U = (const bf16_t*)(P.ws + WS_U); const bf16_t* PR = (const bf16_t*)(P.ws + WS_PROJ); bf16_t* CAT = (bf16_t*)P.out;
    int lane = lane_id_(); asm volatile("" : "+v"(lane));
    typedef unsigned v4u_ __attribute__((ext_vector_type(4)));
    const int h = lane >> 3; const float sk = P.d_skip[h] + P.d_skip[8 + h];
    for (int row = row_begin + 4 * gw; row < row_end; row += 4 * NGW) {
        v4u_ yv[4], xv[4], zv[4];
#pragma unroll
        for (int q = 0; q < 4; ++q) { const size_t r = (size_t)(row + q);
            yv[q] = *(const v4u_*)(Y + r * 512 + 8 * lane); xv[q] = *(const v4u_*)(U + r * 768 + 8 * lane); zv[q] = *(const v4u_*)(PR + r * PN + C_Z + 8 * lane); }
#pragma unroll
        for (int q = 0; q < 4; ++q) { float v[8]; float ss = 0.f;
#pragma unroll
            for (int i = 0; i < 4; ++i) {
                const float y0 = __uint_as_float(yv[q][i] << 16), y1 = __uint_as_float(yv[q][i] & 0xffff0000u), x0 = __uint_as_float(xv[q][i] << 16), x1 = __uint_as_float(xv[q][i] & 0xffff0000u);
                const float z0 = __uint_as_float(zv[q][i] << 16), z1 = __uint_as_float(zv[q][i] & 0xffff0000u);
                v[2 * i] = (y0 + sk * x0) * siluf(z0); v[2 * i + 1] = (y1 + sk * x1) * siluf(z1); ss += v[2 * i] * v[2 * i] + v[2 * i + 1] * v[2 * i + 1]; }
            ss = wave_sum(ss);
            const float rstd = rsqrtf(ss * (1.f / 512.f) + RMS_EPS);
            v4u_ o;
#pragma unroll
            for (int i = 0; i < 4; ++i) o[i] = pk2f(v[2 * i] * rstd, v[2 * i + 1] * rstd);
            *(v4u_*)(CAT + (size_t)(row + q) * DM + 512 + 8 * lane) = o; }
    }
}
__device__ __forceinline__ void ph_merge(const Ptrs& P) { const int tid = TIDX; merge_rows(P, 0, ML, blockIdx.x * (NT / 64) + (tid >> 6), gridDim.x * (NT / 64)); }

__device__ __forceinline__ void ph_ssd_out(const Ptrs& P, unsigned char* lds) {
    const bf16_t* U = (const bf16_t*)(P.ws + WS_U); const float* DTS = (const float*)(P.ws + WS_DTS);
    for (int it = blockIdx.x; it < NB * 64; it += gridDim.x) { const int b = it >> 6, j = it & 63;
#pragma unroll 1
        for (int g = 0; g < 2; ++g) ssd::out_item(U, DTS, P.a_log, (const bf16_t*)(P.ws + WS_SST), (bf16_t*)(P.ws + WS_H), b, j, g, (char*)lds);
        asm volatile("s_waitcnt vmcnt(0)" ::: "memory"); __syncthreads();
        const int row0 = b * SEQ + j * ssd::LC; merge_rows(P, row0, row0 + ssd::LC, TIDX >> 6, NT / 64); }
}

template <int W, int R> __device__ __forceinline__ void pool_item(const bf16_t* __restrict__ UG, bf16_t* __restrict__ MP, int row0, int t0, int ch) {
    typedef unsigned v4u_ __attribute__((ext_vector_type(4)));
    constexpr int NR = R + W - 1, LO = W / 2;
    v4u_ v[NR];
#pragma unroll
    for (int r = 0; r < NR; ++r) { const int t = t0 - LO + r; v[r] = (t >= 0 && t < SEQ) ? *(const v4u_*)(UG + (size_t)(row0 - LO + r) * 2048 + ch) : (v4u_){0u, 0u, 0u, 0u}; }
    float S[8];
#pragma unroll
    for (int i = 0; i < 8; ++i) S[i] = 0.f;
#pragma unroll
    for (int r = 0; r < W; ++r)
#pragma unroll
        for (int i = 0; i < 4; ++i) { S[2 * i] += __uint_as_float(v[r][i] << 16); S[2 * i + 1] += __uint_as_float(v[r][i] & 0xffff0000u); }
#pragma unroll
    for (int r = 0; r < R; ++r) { const int t = t0 + r; int lo = t - LO; if (lo < 0) lo = 0; int hi = t + (W - LO - 1); if (hi > SEQ - 1) hi = SEQ - 1;
        const float inv = 1.f / (float)(hi - lo + 1); v4u_ o;
#pragma unroll
        for (int i = 0; i < 4; ++i) { const float u0 = __uint_as_float(v[r + LO][i] << 16), u1 = __uint_as_float(v[r + LO][i] & 0xffff0000u);
            o[i] = pk2(S[2 * i] * inv - u0, S[2 * i + 1] * inv - u1); }
        *(v4u_*)(MP + (size_t)(row0 + r) * 1024 + ch) = o;
        if (r < R - 1) {
#pragma unroll
            for (int i = 0; i < 4; ++i) { S[2 * i] += __uint_as_float(v[r + W][i] << 16) - __uint_as_float(v[r][i] << 16); S[2 * i + 1] += __uint_as_float(v[r + W][i] & 0xffff0000u) - __uint_as_float(v[r][i] & 0xffff0000u); } } }
}
__device__ __forceinline__ void ph_pool(const Ptrs& P) {
    const bf16_t* UG = (const bf16_t*)(P.ws + WS_Q); bf16_t* MP = (bf16_t*)(P.ws + WS_H);
    GSTRIDE(idx, (long)(ML / 32) * 4 * 64) {
        const int cg = (int)(idx & 31), rsub = (int)((idx >> 5) & 1), g = (int)((idx >> 6) & 3), rp = (int)(idx >> 8);
        const int row0 = rp * 32 + rsub * 16, t0 = row0 & (SEQ - 1), ch = g * 256 + cg * 8;
        if (g == 0) pool_item<2, 16>(UG, MP, row0, t0, ch); else if (g == 1) pool_item<4, 16>(UG, MP, row0, t0, ch); else if (g == 2) pool_item<8, 16>(UG, MP, row0, t0, ch);
        else { pool_item<16, 8>(UG, MP, row0, t0, ch); asm volatile("" ::: "memory"); pool_item<16, 8>(UG, MP, row0 + 8, t0 + 8, ch); }
    }
}
__device__ __forceinline__ void ph_final(const Ptrs& P) {
    const int lane = TIDX & 63, gw = blockIdx.x * (NT / 64) + (TIDX >> 6), NGW = gridDim.x * (NT / 64);
    f32x4 nx[4]; f32x4 fw[4];
#pragma unroll
    for (int j = 0; j < 4; ++j) fw[j] = *(const f32x4*)(P.final_norm + 4 * lane + 256 * j);
    if (gw < ML) {
#pragma unroll
        for (int j = 0; j < 4; ++j) nx[j] = *(const f32x4*)(P.out + (size_t)gw * DM + 4 * lane + 256 * j); }
    for (int row = gw; row < ML; row += NGW) {
        float* xr = P.out + (size_t)row * DM; f32x4 xv[4]; float ss = 0.f;
#pragma unroll
        for (int j = 0; j < 4; ++j) xv[j] = nx[j];
        if (row + NGW < ML) {
#pragma unroll
            for (int j = 0; j < 4; ++j) nx[j] = *(const f32x4*)(xr + (size_t)NGW * DM + 4 * lane + 256 * j); }
#pragma unroll
        for (int j = 0; j < 4; ++j) ss += (xv[j].x * xv[j].x + xv[j].y * xv[j].y) + (xv[j].z * xv[j].z + xv[j].w * xv[j].w);
        ss = wave_sum(ss);
        const float rstd = rsqrtf(ss * (1.f / DM) + RMS_EPS);
#pragma unroll
        for (int j = 0; j < 4; ++j) { const int k = 4 * lane + 256 * j; *(f32x4*)(xr + k) = xv[j] * rstd * fw[j]; }
    }
}


template <int W, int R> __device__ __forceinline__ void pool_to_lds(const bf16_t* __restrict__ UG, int grow0, int t0, int ch, LAS unsigned char* dst, int r0, int cc) {
    typedef unsigned v4u_ __attribute__((ext_vector_type(4)));
    constexpr int NR = R + W - 1, LO = W / 2;
    v4u_ v[NR];
#pragma unroll
    for (int r = 0; r < NR; ++r) { const int t = t0 - LO + r; v[r] = (t >= 0 && t < SEQ) ? *(const v4u_*)(UG + (size_t)(grow0 - LO + r) * 2048 + ch) : (v4u_){0u, 0u, 0u, 0u}; }
    float S[8];
#pragma unroll
    for (int i = 0; i < 8; ++i) S[i] = 0.f;
#pragma unroll
    for (int r = 0; r < W; ++r)
#pragma unroll
        for (int i = 0; i < 4; ++i) { S[2 * i] += __uint_as_float(v[r][i] << 16); S[2 * i + 1] += __uint_as_float(v[r][i] & 0xffff0000u); }
#pragma unroll
    for (int r = 0; r < R; ++r) { const int t = t0 + r; int lo = t - LO; if (lo < 0) lo = 0; int hi = t + (W - LO - 1); if (hi > SEQ - 1) hi = SEQ - 1;
        const float inv = 1.f / (float)(hi - lo + 1); v4u_ o;
#pragma unroll
        for (int i = 0; i < 4; ++i) { const float u0 = __uint_as_float(v[r + LO][i] << 16), u1 = __uint_as_float(v[r + LO][i] & 0xffff0000u);
            o[i] = pk2f(S[2 * i] * inv - u0, S[2 * i + 1] * inv - u1); }
        *(LAS v4u_*)(dst + pg8::lds_byte(r0 + r, cc)) = o;
        if (r < R - 1) {
#pragma unroll
            for (int i = 0; i < 4; ++i) { S[2 * i] += __uint_as_float(v[r + W][i] << 16) - __uint_as_float(v[r][i] << 16); S[2 * i + 1] += __uint_as_float(v[r + W][i] & 0xffff0000u) - __uint_as_float(v[r][i] & 0xffff0000u); } } }
}
__device__ __forceinline__ void ph_pool_lin_fused(const Ptrs& P, LAS unsigned char* L) {
    using pg8::f32x4; using pg8::bf16x8;
    const bf16_t* UG = (const bf16_t*)(P.ws + WS_Q); const bf16_t* Wtl = (const bf16_t*)(P.ws + WS_WTL); bf16_t* T = (bf16_t*)(P.ws + WS_U);
    pg8::StaticOrder S; S.init(ML, 1024, (int)gridDim.x, (int)blockIdx.x);
    const pg8::EpiPL E{T, UG};
    pg8::Unit u;
    for (int ui = 0; S.next(ui, u); ++ui) {
        int tid_ = TIDX; asm volatile("" : "+v"(tid_));
        const int tid = tid_, wid = __builtin_amdgcn_readfirstlane(tid >> 6), lane = tid & 63, wr = wid >> 2, wc = wid & 3, fr = lane & 15, fq = lane >> 4;
        const int g = u.pn;
        { const int chunk = tid & 31, run = tid >> 5; const int kt = chunk >> 3, cc = (chunk & 7) * 8, ai = run >> 3, r0 = (run & 7) * 16;
          const int grow0 = u.pm * 256 + run * 16, t0 = grow0 & (SEQ - 1), ch = g * 256 + chunk * 8;
          LAS unsigned char* dst = L + (ai * 4 + kt) * 16384;
          if (g == 0) pool_to_lds<2, 16>(UG, grow0, t0, ch, dst, r0, cc); else if (g == 1) pool_to_lds<4, 16>(UG, grow0, t0, ch, dst, r0, cc); else if (g == 2) pool_to_lds<8, 16>(UG, grow0, t0, ch, dst, r0, cc);
          else { pool_to_lds<16, 8>(UG, grow0, t0, ch, dst, r0, cc); asm volatile("" ::: "memory"); pool_to_lds<16, 8>(UG, grow0 + 8, t0 + 8, ch, dst, r0 + 8, cc); } }
        __syncthreads();
        f32x4 acc[2][2][4][2];
#pragma unroll
        for (int a = 0; a < 2; ++a)
#pragma unroll
            for (int b = 0; b < 2; ++b)
#pragma unroll
                for (int m = 0; m < 4; ++m)
#pragma unroll
                    for (int n = 0; n < 2; ++n) acc[a][b][m][n] = (f32x4){0.f, 0.f, 0.f, 0.f};
        const int aoff = pg8::lds_byte(wr * 64 + fr, fq * 8);
        const bf16_t* Bg = Wtl + (size_t)(g * 256) * 256 + fq * 8;
        const int brow = 32 * wc + 8 * (fr >> 2) + (fr & 3);
#pragma unroll 1
        for (int kt = 0; kt < 4; ++kt) {
            bf16x8 Bf[2][2][2];
#pragma unroll
            for (int bj = 0; bj < 2; ++bj)
#pragma unroll
                for (int n = 0; n < 2; ++n)
#pragma unroll
                    for (int k = 0; k < 2; ++k) Bf[bj][n][k] = *(const bf16x8*)(Bg + (size_t)(128 * bj + brow + 4 * n) * 256 + kt * 64 + k * 32);
#pragma unroll
            for (int ai = 0; ai < 2; ++ai) { bf16x8 At[4][2];
#pragma unroll
                for (int m = 0; m < 4; ++m)
#pragma unroll
                    for (int k = 0; k < 2; ++k) At[m][k] = *(const LAS bf16x8*)(L + (ai * 4 + kt) * 16384 + aoff + m * 2048 + k * 1024);
#pragma unroll
                for (int bj = 0; bj < 2; ++bj)
#pragma unroll
                    for (int m = 0; m < 4; ++m)
#pragma unroll
                        for (int n = 0; n < 2; ++n)
#pragma unroll
                            for (int k = 0; k < 2; ++k) acc[ai][bj][m][n] = __builtin_amdgcn_mfma_f32_16x16x32_bf16(Bf[bj][n][k], At[m][k], acc[ai][bj][m][n], 0, 0, 0); }
        }
        E(acc, u, wr, wc, fr, fq);
        __syncthreads();
    }
}

#ifndef ATTN_PROBE
#define ATTN_PROBE 0
#endif
struct Args { const float* in[24]; float* out; char* ws; int ph_lo, ph_hi; };
constexpr int N_PHASES = 15;
__global__ void __launch_bounds__(NT, 2) mk_fwd(Args a) {
    unsigned char* lds = g_lds;
    LAS unsigned char* L = (LAS unsigned char*)lds;
    for (int u = threadIdx.x; u < (LDS_BYTES - LDSCTL_OFF) / 4; u += NT) ((LAS unsigned*)(L + LDSCTL_OFF))[u] = 0u;
    __syncthreads();
    if ((threadIdx.x & 63) == 0) ((LAS int*)(L + WIDTAB_OFF))[hw_slot_()] = (int)(threadIdx.x >> 6);
    __syncthreads();
    Ptrs P;
    P.x = a.in[0]; P.c = a.in[1]; P.ctx = a.in[2]; P.c_ctx = a.in[3]; P.mod_w = a.in[4]; P.mod_b = a.in[5]; P.norm_w = a.in[6]; P.w_in_mix = a.in[7];
    P.q_norm = a.in[8]; P.w_uq = a.in[9]; P.kv_norm = a.in[10]; P.w_ukv = a.in[11]; P.conv_w = a.in[12]; P.conv_b = a.in[13]; P.a_log = a.in[14];
    P.dt_bias = a.in[15]; P.d_skip = a.in[16]; P.ssd_norm = a.in[17]; P.w_out_mix = a.in[18]; P.w_in_pool = a.in[19]; P.pool_lin = a.in[20];
    P.pool_scale = a.in[21]; P.w_out_pool = a.in[22]; P.final_norm = a.in[23]; P.out = a.out; P.ws = a.ws;
    unsigned* ctl = (unsigned*)(a.ws + WS_CTL);
    const bool one_launch = (a.ph_hi - a.ph_lo) > 1;
    XcdBarrier bar; bar.bar = ctl + CW_BAR; bar.x = 0; bar.st = nullptr;
    if (one_launch) bar = xcd_barrier_post(ctl + CW_BAR, (volatile LAS unsigned*)(L + MISC_OFF) + 8);
    const int lo = a.ph_lo, hi = a.ph_hi;
#define IN(k) (lo <= (k) && (k) < hi)
#define SEAM(k) do { if (IN(k) && IN((k) + 1)) xcd_barrier(bar); } while (0)
    float* MODV = (float*)(a.ws + WS_MODV);
    bf16_t* H = (bf16_t*)(a.ws + WS_H); bf16_t* PROJ = (bf16_t*)(a.ws + WS_PROJ); float* X1 = (float*)(a.ws + WS_PROJ);
    bf16_t* UG = (bf16_t*)(a.ws + WS_Q); bf16_t* T = (bf16_t*)(a.ws + WS_U); bf16_t* CAT = (bf16_t*)a.out;
    if (IN(0)) { ph_modvec(P, L); } SEAM(0);
    if (IN(1)) { ph_weights(P, L); ph_norm_mod<true>(P.x, P.ctx, MT, P.norm_w, MODV, H); } SEAM(1);
    if (IN(2)) { pg8::Gemm g{H, (const bf16_t*)(a.ws + WS_WT1), MT, 2560, 1024, 1024, 0}; pg8::StaticOrder S; S.init(MT, 2560, (int)gridDim.x, (int)blockIdx.x);
        pg8::EpiProjM E{PROJ, (float*)(a.ws + WS_SS), (float*)(a.ws + WS_DT)};
        pg8::gemm_phase<pg8::EpiProjM, pg8::StaticOrder, true, true>(L, g, S, E); } SEAM(2);
    if (IN(3)) {
        { pg8::Gemm g{PROJ + C_QA, (const bf16_t*)(a.ws + WS_WTQ), ML, 768, 384, PN, 0}; pg8::StaticOrder S; S.init(ML, 768, (int)gridDim.x, (int)blockIdx.x);
          pg8::EpiQ E{(bf16_t*)(a.ws + WS_Q), (const float*)(a.ws + WS_SS), (const float*)(a.ws + WS_COS), (const float*)(a.ws + WS_SIN)};
          pg8::gemm_phase<pg8::EpiQ, pg8::StaticOrder, true, true>(L, g, S, E); }
        { pg8::Gemm g{PROJ + C_KVA, (const bf16_t*)(a.ws + WS_WTKV), MT, 1024, 256, PN, 0}; pg8::StaticOrder S; S.init(MT, 1024, (int)gridDim.x, (int)((blockIdx.x + gridDim.x / 2) % gridDim.x));
          pg8::EpiKV E{(bf16_t*)(a.ws + WS_K), (bf16_t*)(a.ws + WS_V), (const float*)(a.ws + WS_SS)};
          pg8::gemm_phase<pg8::EpiKV, pg8::StaticOrder, true, true>(L, g, S, E); }
        ph_upproj(P); } SEAM(3);
    if (IN(4)) { ph_ssd_states(P, lds); } SEAM(4);
    if (IN(5)) { ph_ssd_chunkscan(P); ph_attn_mfma<ATTN_PROBE>(P, lds); if (ATTN_PROBE != 0) ph_attn_mfma<0>(P, lds); } SEAM(5);
    if (IN(6)) { ph_ssd_out(P, lds); } SEAM(6);
    const bool fusedn = gridDim.x == 256 && one_launch;
    if (IN(8)) {
        if (fusedn) {
#pragma unroll 1
            for (int half = 0; half < 2; ++half) { pg8::Gemm g{CAT + (size_t)half * 16384 * 1024, (const bf16_t*)(a.ws + WS_WTO), 16384, 1024, 1024, 1024, 0}; pg8::StaticOrder S; S.init(16384, 1024, (int)gridDim.x, (int)blockIdx.x);
                pg8::PanelRms st{(unsigned*)(a.ws + WS_XB), ctl + CW_PANEL, half * 64, RMS_EPS};
                pg8::EpiResNorm E{P.x, MODV, (_Float16*)X1, H, P.norm_w + DM, MODV + 5 * 3072, st, SEQ, 0};
                pg8::gemm_phase<pg8::EpiResNorm, pg8::StaticOrder, false, true>(L, g, S, E); __syncthreads(); }
        } else {
            pg8::Gemm g{CAT, (const bf16_t*)(a.ws + WS_WTO), ML, 1024, 1024, 1024, 0}; pg8::StaticOrder S; S.init(ML, 1024, (int)gridDim.x, (int)blockIdx.x);
            pg8::EpiResM E{P.x, MODV, X1, SEQ, 0};
            pg8::gemm_phase<pg8::EpiResM, pg8::StaticOrder, true, true>(L, g, S, E); } } SEAM(8);
    if (IN(9) && !fusedn) { ph_norm_mod<false>(X1, nullptr, ML, P.norm_w + DM, MODV + 5 * 3072, H); } if (!fusedn) SEAM(9);
    if (IN(10)) { pg8::Gemm g{H, (const bf16_t*)(a.ws + WS_WTP), ML, 2048, 1024, 1024, 0}; pg8::StaticOrder S; S.init(ML, 2048, (int)gridDim.x, (int)blockIdx.x);
        pg8::EpiBf16<0> E{UG, 2048, nullptr, 0, 0, 1.f};
        pg8::gemm_phase<pg8::EpiBf16<0>, pg8::StaticOrder, true, true>(L, g, S, E); } SEAM(10);
    if (IN(11)) { ph_pool_lin_fused(P, L); } SEAM(11);
    if (IN(13)) {
        if (fusedn) {
#pragma unroll 1
            for (int half = 0; half < 2; ++half) { pg8::Gemm g{T + (size_t)half * 16384 * 1024, (const bf16_t*)(a.ws + WS_WTOP), 16384, 1024, 1024, 1024, 0}; pg8::StaticOrder S; S.init(16384, 1024, (int)gridDim.x, (int)blockIdx.x);
                pg8::PanelRms st{(unsigned*)(a.ws + WS_XB) + 32768 * 4, ctl + CW_PANEL + 8192, half * 64, RMS_EPS};
                pg8::EpiResFinal E{(const _Float16*)X1, MODV + 5 * 3072, P.out, P.final_norm, st, SEQ, 0};
                pg8::gemm_phase<pg8::EpiResFinal, pg8::StaticOrder, false, true>(L, g, S, E); __syncthreads(); }
        } else {
            pg8::Gemm g{T, (const bf16_t*)(a.ws + WS_WTOP), ML, 1024, 1024, 1024, 0}; pg8::StaticOrder S; S.init(ML, 1024, (int)gridDim.x, (int)blockIdx.x);
            pg8::EpiResM E{X1, MODV + 5 * 3072, P.out, SEQ, 0};
            pg8::gemm_phase<pg8::EpiResM, pg8::StaticOrder, true, true>(L, g, S, E); } } if (!fusedn) SEAM(13);
    if (IN(14) && !fusedn) { ph_final(P); }
#undef IN
#undef SEAM
}

#ifndef MK_PER_PHASE
#define MK_PER_PHASE 0
#endif
extern "C" void kernel_launch(void* const* d_in, const int* in_sizes, int n_in, void* d_out, int out_size, void* d_ws, size_t ws_size, hipStream_t stream) {
    static int grid = 0;
    if (grid == 0) {
        if (n_in != 24 || out_size != ML * DM || ws_size < WS_END) { fprintf(stderr, "kernel_launch: unexpected shapes n_in %d out %d ws %zu\n", n_in, out_size, ws_size); grid = -1; return; }
        int dev = 0, cus = 0;
        if (hipGetDevice(&dev) != hipSuccess || hipDeviceGetAttribute(&cus, hipDeviceAttributeMultiprocessorCount, dev) != hipSuccess) { grid = -1; return; }
        if (hipFuncSetAttribute((const void*)mk_fwd, hipFuncAttributeMaxDynamicSharedMemorySize, LDS_BYTES) != hipSuccess) { fprintf(stderr, "kernel_launch: hipFuncSetAttribute failed\n"); grid = -1; return; }
        grid = cus;
    }
    if (grid < 0) return;
    (void)hipMemsetAsync((char*)d_ws + WS_CTL, 0, CTL_ZERO_BYTES, stream);
    Args a{};
    for (int i = 0; i < 24; ++i) a.in[i] = (const float*)d_in[i];
    a.out = (float*)d_out; a.ws = (char*)d_ws;
#if MK_PER_PHASE
    for (int p = 0; p < N_PHASES; ++p) { a.ph_lo = p; a.ph_hi = p + 1; hipLaunchKernelGGL(mk_fwd, dim3(grid), dim3(NT), LDS_BYTES, stream, a); }
#else
    a.ph_lo = 0; a.ph_hi = N_PHASES;
    hipLaunchKernelGGL(mk_fwd, dim3(grid), dim3(NT), LDS_BYTES, stream, a);
#endif
}
```
